# Optimizing an MI355X kernel written in HIP

```python
import jax, jax.numpy as jnp
from jax import lax
import numpy as np

D_MODEL = 2048
BATCH = 2
SEQ = 8192
DEPTH = 1

MLA_HEADS = 8
MLA_Q_RANK = 512
MLA_KV_RANK = 256
MLA_NOPE_DIM = 128
MLA_ROPE_DIM = 64
MLA_QK_DIM = MLA_NOPE_DIM + MLA_ROPE_DIM
MLA_V_DIM = 128
MLA_WIDTH = MLA_HEADS * MLA_V_DIM
ROPE_THETA = 10000.0
Q_BLOCK = 128
NEG_INF = -1e30

GLA_HEADS = 4
GLA_VALUE_DIM = D_MODEL // 2
GLA_KEY_DIM = GLA_VALUE_DIM // 2
GLA_HEAD_K = GLA_KEY_DIM // GLA_HEADS
GLA_HEAD_V = GLA_VALUE_DIM // GLA_HEADS
GLA_GATE_RANK = 16
GLA_GATE_TAU = 16.0
GLA_CHUNK = 64

MIX_WIDTH = MLA_WIDTH + GLA_VALUE_DIM
IN_SPLITS = (MLA_Q_RANK, MLA_KV_RANK, MLA_ROPE_DIM,
             GLA_KEY_DIM, GLA_KEY_DIM, GLA_VALUE_DIM, GLA_GATE_RANK, GLA_VALUE_DIM)
IN_COLS = sum(IN_SPLITS)

D_FF = -(-8 * D_MODEL // (3 * 256)) * 256
N_MOD = 6
RMS_EPS = 1e-6

kernel_name = "hybrid_mla_gla_sandwich_adaln_block"


def rms_norm(x, w, eps=RMS_EPS):
    xf = x.astype(jnp.float32)
    y = xf * lax.rsqrt(jnp.mean(xf * xf, axis=-1, keepdims=True) + eps)
    return (y * w.astype(jnp.float32)).astype(x.dtype)


def split_cols(z, sizes):
    out, start = [], 0
    for s in sizes:
        out.append(z[..., start:start + s])
        start += s
    return out


def rope_cos_sin(positions, dim):
    inv_freq = 1.0 / (ROPE_THETA ** (jnp.arange(0, dim, 2, dtype=jnp.float32) / dim))
    ang = positions.astype(jnp.float32)[..., None] * inv_freq
    return jnp.cos(ang), jnp.sin(ang)


def apply_rope(x, cos, sin):
    half = x.shape[-1] // 2
    x1 = x[..., :half].astype(jnp.float32)
    x2 = x[..., half:].astype(jnp.float32)
    out = jnp.concatenate([x1 * cos - x2 * sin, x2 * cos + x1 * sin], axis=-1)
    return out.astype(x.dtype)


def mla_mixer(c_q, c_kv, k_rope, positions, g_q, w_uq, g_kv, w_uk, w_uv):
    B, S, _ = c_q.shape
    H = MLA_HEADS
    q = (rms_norm(c_q, g_q) @ w_uq).reshape(B, S, H, MLA_QK_DIM)
    c_kv = rms_norm(c_kv, g_kv)
    k_nope = (c_kv @ w_uk).reshape(B, S, H, MLA_NOPE_DIM)
    v = (c_kv @ w_uv).reshape(B, S, H, MLA_V_DIM)
    cos, sin = rope_cos_sin(positions, MLA_ROPE_DIM)
    q_rope = apply_rope(q[..., MLA_NOPE_DIM:], cos[:, :, None, :], sin[:, :, None, :])
    k_rope = apply_rope(k_rope, cos, sin)
    q = jnp.concatenate([q[..., :MLA_NOPE_DIM], q_rope], axis=-1) * (MLA_QK_DIM ** -0.5)
    k = jnp.concatenate(
        [k_nope, jnp.broadcast_to(k_rope[:, :, None, :], (B, S, H, MLA_ROPE_DIM))], axis=-1)
    q = q.transpose(0, 2, 1, 3)
    k = k.transpose(0, 2, 1, 3)
    v = v.transpose(0, 2, 1, 3)
    nb = S // Q_BLOCK
    q_blocks = q.reshape(B, H, nb, Q_BLOCK, MLA_QK_DIM).transpose(2, 0, 1, 3, 4)
    k_pos = jnp.arange(S)

    def attend(args):
        q_blk, blk = args
        q_pos = blk * Q_BLOCK + jnp.arange(Q_BLOCK)
        s = jnp.einsum('bhqd,bhkd->bhqk', q_blk, k).astype(jnp.float32)
        s = jnp.where(k_pos[None, :] <= q_pos[:, None], s, NEG_INF)
        p = jax.nn.softmax(s, axis=-1).astype(v.dtype)
        return jnp.einsum('bhqk,bhkd->bhqd', p, v)

    o = lax.map(attend, (q_blocks, jnp.arange(nb)))
    return o.transpose(1, 0, 3, 2, 4).reshape(B, S, MLA_WIDTH)


def gla_mixer(q, k, v, a_lr, r, w_gate_up, b_gate, g_gla):
    B, S, _ = q.shape
    H, dk, dv, C = GLA_HEADS, GLA_HEAD_K, GLA_HEAD_V, GLA_CHUNK
    N = S // C
    f32 = jnp.float32
    log_a = jax.nn.log_sigmoid((a_lr @ w_gate_up + b_gate).astype(f32)) / GLA_GATE_TAU

    def chunked(t, d):
        return t.reshape(B, N, C, H, d).transpose(0, 3, 1, 2, 4).astype(f32)

    qc = chunked(q, dk) * (dk ** -0.5)
    kc = chunked(k, dk)
    vc = chunked(v, dv)
    bc = jnp.cumsum(chunked(log_a, dk), axis=3)
    b_last = bc[:, :, :, -1:, :]
    q_dec = qc * jnp.exp(bc)
    k_inv = kc * jnp.exp(-bc)
    k_dec = kc * jnp.exp(b_last - bc)
    causal = jnp.tril(jnp.ones((C, C), dtype=bool))
    attn = jnp.einsum('bhncd,bhnjd->bhncj', q_dec, k_inv)
    attn = jnp.where(causal, attn, 0.0)
    o_intra = jnp.einsum('bhncj,bhnjv->bhncv', attn, vc)
    d_state = jnp.einsum('bhncd,bhncv->bhndv', k_dec, vc)
    decay = jnp.exp(b_last[:, :, :, 0, :])

    def step(state, inp):
        q_n, ds_n, decay_n = inp
        o_n = jnp.einsum('bhcd,bhdv->bhcv', q_n, state)
        state = decay_n[..., None] * state + ds_n
        return state, o_n

    init = jnp.zeros((B, H, dk, dv), f32)
    _, o_inter = lax.scan(step, init, (jnp.moveaxis(q_dec, 2, 0),
                                       jnp.moveaxis(d_state, 2, 0),
                                       jnp.moveaxis(decay, 2, 0)))
    o = o_intra + jnp.moveaxis(o_inter, 0, 2)
    o = o.transpose(0, 2, 3, 1, 4).reshape(B, S, H, dv)
    o = rms_norm(o, g_gla) * jax.nn.silu(r.reshape(B, S, H, dv).astype(f32))
    return o.reshape(B, S, GLA_VALUE_DIM).astype(q.dtype)


def setup_inputs(seed: int = 0) -> dict:
    key = jax.random.key(seed)
    ks = jax.random.split(key, 24)
    f32 = jnp.float32
    L = DEPTH

    def nrm(k, shape, scale):
        return jax.random.normal(k, shape, f32) * scale

    def gain(k, shape):
        return 1.0 + 0.02 * jax.random.normal(k, shape, f32)

    offsets = jax.random.randint(ks[2], (BATCH, 1), 0, 4096, dtype=jnp.int32)
    positions = offsets + jnp.arange(SEQ, dtype=jnp.int32)[None, :]
    return {
        'x': nrm(ks[0], (BATCH, SEQ, D_MODEL), 1.0),
        'c': nrm(ks[1], (BATCH, D_MODEL), 1.0),
        'positions': positions,
        'w_ada': nrm(ks[3], (L, D_MODEL, N_MOD * D_MODEL), D_MODEL ** -0.5),
        'b_ada': nrm(ks[4], (L, N_MOD * D_MODEL), 0.01),
        'g_pre_mix': gain(ks[5], (L, D_MODEL)),
        'g_post_mix': gain(ks[6], (L, D_MODEL)),
        'w_in': nrm(ks[7], (L, D_MODEL, IN_COLS), D_MODEL ** -0.5),
        'g_q': gain(ks[8], (L, MLA_Q_RANK)),
        'w_uq': nrm(ks[9], (L, MLA_Q_RANK, MLA_HEADS * MLA_QK_DIM), MLA_Q_RANK ** -0.5),
        'g_kv': gain(ks[10], (L, MLA_KV_RANK)),
        'w_uk': nrm(ks[11], (L, MLA_KV_RANK, MLA_HEADS * MLA_NOPE_DIM), MLA_KV_RANK ** -0.5),
        'w_uv': nrm(ks[12], (L, MLA_KV_RANK, MLA_HEADS * MLA_V_DIM), MLA_KV_RANK ** -0.5),
        'w_gate_up': nrm(ks[13], (L, GLA_GATE_RANK, GLA_KEY_DIM), GLA_GATE_RANK ** -0.5),
        'b_gate': nrm(ks[14], (L, GLA_KEY_DIM), 0.1),
        'g_gla': gain(ks[15], (L, GLA_HEAD_V)),
        'w_out': nrm(ks[16], (L, MIX_WIDTH, D_MODEL), MIX_WIDTH ** -0.5),
        'g_pre_ffn': gain(ks[17], (L, D_MODEL)),
        'g_post_ffn': gain(ks[18], (L, D_MODEL)),
        'w_ffn_gate': nrm(ks[19], (L, D_MODEL, D_FF), D_MODEL ** -0.5),
        'w_ffn_up': nrm(ks[20], (L, D_MODEL, D_FF), D_MODEL ** -0.5),
        'w_ffn_down': nrm(ks[21], (L, D_FF, D_MODEL), D_FF ** -0.5),
    }


def reference(x, c, positions, w_ada, b_ada, g_pre_mix, g_post_mix, w_in, g_q, w_uq,
              g_kv, w_uk, w_uv, w_gate_up, b_gate, g_gla, w_out, g_pre_ffn, g_post_ffn,
              w_ffn_gate, w_ffn_up, w_ffn_down):
    for l in range(DEPTH):
        ada = jax.nn.silu(c) @ w_ada[l] + b_ada[l]
        shift_m, scale_m, gate_m, shift_f, scale_f, gate_f = [
            t[:, None, :] for t in jnp.split(ada, N_MOD, axis=-1)]

        h = rms_norm(x, g_pre_mix[l]) * (1.0 + scale_m) + shift_m
        z = h @ w_in[l]
        c_q, c_kv, k_rope, q_g, k_g, v_g, a_g, r_g = split_cols(z, IN_SPLITS)
        o_mla = mla_mixer(c_q, c_kv, k_rope, positions, g_q[l], w_uq[l],
                          g_kv[l], w_uk[l], w_uv[l])
        o_gla = gla_mixer(q_g, k_g, v_g, a_g, r_g, w_gate_up[l], b_gate[l], g_gla[l])
        o = jnp.concatenate([o_mla, o_gla], axis=-1) @ w_out[l]
        x = x + gate_m * rms_norm(o, g_post_mix[l])

        h = rms_norm(x, g_pre_ffn[l]) * (1.0 + scale_f) + shift_f
        f = (jax.nn.silu(h @ w_ffn_gate[l]) * (h @ w_ffn_up[l])) @ w_ffn_down[l]
        x = x + gate_f * rms_norm(f, g_post_ffn[l])
    return x
```

```cpp
#include <hip/hip_runtime.h>
#include <hip/hip_cooperative_groups.h>
#include <cstdio>
#include <cstdint>
#include <cmath>
namespace cg = cooperative_groups;
namespace pg8 {
#define PG8_LAS __attribute__((address_space(3)))
typedef unsigned short bf16_t;
typedef short bf16x8 __attribute__((ext_vector_type(8)));
typedef float f32x4 __attribute__((ext_vector_type(4)));
typedef unsigned u32x4 __attribute__((ext_vector_type(4)));
constexpr int BM = 256, BK = 64, HALF = 128, HTB = HALF * BK * 2  , STAGE_BYTES = 8 * HTB, NXCD = 8, WGM = 8;

__host__ __device__ __forceinline__ int lds_byte(int r, int c) { const int st = (r >> 4) * 2 + (c >> 5), rr = r & 15, cc = c & 31, ob = rr * 64 + cc * 2; return st * 1024 + (ob ^ (((ob >> 9) & 1) << 5)); }
__host__ __device__ __forceinline__ void stage_rc(int b, int& R, int& C) { const int st = b / 1024, sb = b % 1024, swz = sb ^ (((sb >> 9) & 1) << 5); R = (st >> 1) * 16 + swz / 64; C = (st & 1) * 32 + (swz % 64) / 2; }
__host__ __device__ __forceinline__ int perm32(int rho) { const int n = rho >> 4, i = rho & 15; return 8 * (i >> 2) + 4 * n + (i & 3); }

struct Unit { int pm, pn; };
struct Gemm { const bf16_t* A; const bf16_t* Bt; int M, N, K, lda, ldb; };

struct StaticOrder {
    int nM, nN, nwg, G, c;
    __host__ __device__ void init(int M, int N, int G_, int c_) { nM = M / BM; nN = N / BM; nwg = nM * nN; G = G_; c = c_; }
    __host__ __device__ bool next(int i, Unit& u) const {
        const long L = (long)i * G + c; if (L >= nwg) return false;
        int wgid = (int)L; { const int q = nwg / NXCD, r = nwg % NXCD, xcd = wgid % NXCD, off = wgid / NXCD; wgid = (xcd < r ? xcd * (q + 1) : r * (q + 1) + (xcd - r) * q) + off; }
        const int nig = WGM * nN, gid = wgid / nig, fm = gid * WGM, gsz = (nM - fm) < WGM ? (nM - fm) : WGM;
        u.pm = fm + ((wgid % nig) % gsz); u.pn = (wgid % nig) / gsz; return true;
    }
    __device__ __forceinline__ void a_ready(const Unit&) const {}
    __device__ __forceinline__ void done(const Unit&) const {}
};

__device__ __forceinline__ unsigned cvt_pk_bf16(float lo, float hi) { unsigned r; asm volatile("v_cvt_pk_bf16_f32 %0, %1, %2" : "=v"(r) : "v"(lo), "v"(hi)); return r; }
typedef float f32x2 __attribute__((ext_vector_type(2)));
template <class Epi, class Sched, bool ALIGN_EPI = false, bool SP2 = false>
__device__ __forceinline__ void gemm_phase(PG8_LAS unsigned char* lds, const Gemm g, const Sched& S, const Epi& E) {
    const int tid = threadIdx.x, wid = __builtin_amdgcn_readfirstlane(tid >> 6), lane = tid & 63, wr = wid >> 2, wc = wid & 3, fr = lane & 15, fq = lane >> 4;
    const int K = g.K, nt = K / BK;
    unsigned voffA[2], voffB[2];
#pragma unroll
    for (int i = 0; i < 2; ++i) { int R, C; stage_rc(tid * 16 + i * 8192, R, C); const int Rb = Epi::PERM ? ((R & ~31) + perm32(R & 31)) : R;
        voffA[i] = (unsigned)(R * g.lda + C) * 2u; voffB[i] = (unsigned)(Rb * g.ldb + C) * 2u; }
    const size_t kstep = (size_t)(BK * 2);
    const size_t hstepA = (size_t)HALF * g.lda * 2, hstepB = (size_t)HALF * g.ldb * 2;
    const size_t tstepA = 2 * hstepA, tstepB = 2 * hstepB;
    const unsigned ldsw = (unsigned)wid * 1024u;
    const int aoff = lds_byte(wr * 64 + fr, fq * 8), boff = lds_byte(wc * 32 + fr, fq * 8);
#define PG8_SA(b, h) (((b) * 2 + (h)) * HTB)
#define PG8_SB(b, h) ((4 + (b) * 2 + (h)) * HTB)
#define PG8_STAGE(bufoff, gbase, voff) do { _Pragma("unroll") for (int _i = 0; _i < 2; ++_i) \
        __builtin_amdgcn_global_load_lds((const unsigned*)((const char*)(gbase) + (voff)[_i]), (PG8_LAS unsigned*)(lds + (bufoff) + ldsw + _i * 8192), 16, 0, 0); } while (0)
#define PG8_LDA(dst, b, h) do { _Pragma("unroll") for (int m = 0; m < 4; ++m) _Pragma("unroll") for (int k = 0; k < 2; ++k) dst[m][k] = *(const PG8_LAS bf16x8*)(lds + PG8_SA(b, h) + aoff + m * 2048 + k * 1024); } while (0)
#define PG8_LDB(dst, b, h) do { _Pragma("unroll") for (int n = 0; n < 2; ++n) _Pragma("unroll") for (int k = 0; k < 2; ++k) dst[n][k] = *(const PG8_LAS bf16x8*)(lds + PG8_SB(b, h) + boff + n * 2048 + k * 1024); } while (0)
#define PG8_MMA(ai, bj, At, Bt) do { __builtin_amdgcn_s_setprio(1); _Pragma("unroll") for (int m = 0; m < 4; ++m) _Pragma("unroll") for (int n = 0; n < 2; ++n) _Pragma("unroll") for (int k = 0; k < 2; ++k) \
        acc[ai][bj][m][n] = __builtin_amdgcn_mfma_f32_16x16x32_bf16(Bt[n][k], At[m][k], acc[ai][bj][m][n], 0, 0, 0); __builtin_amdgcn_s_setprio(0); } while (0)
#define PG8_WAIT_V(n) asm volatile("s_waitcnt vmcnt(" #n ")" ::: "memory")
#define PG8_WAIT_L(n) asm volatile("s_waitcnt lgkmcnt(" #n ")" ::: "memory")
#define PG8_BAR __builtin_amdgcn_s_barrier()
#define PG8_SCHED __builtin_amdgcn_sched_barrier(0)
    Unit cur, nxt; int ui = 0;
    if (!S.next(0, cur)) return;
    f32x4 acc[2][2][4][2];
#pragma unroll
    for (int a = 0; a < 2; ++a)
#pragma unroll
        for (int b = 0; b < 2; ++b)
#pragma unroll
            for (int m = 0; m < 4; ++m)
#pragma unroll
                for (int n = 0; n < 2; ++n) acc[a][b][m][n] = (f32x4){0.f, 0.f, 0.f, 0.f};
    bf16x8 At[4][2], B0[2][2], B1[2][2];
    const char* cA = (const char*)g.A + (size_t)cur.pm * tstepA; const char* cB = (const char*)g.Bt + (size_t)cur.pn * tstepB;
    S.a_ready(cur);
    if constexpr (SP2) {
        PG8_STAGE(PG8_SB(0, 0), cB, voffB); PG8_STAGE(PG8_SB(0, 1), cB + hstepB, voffB); PG8_STAGE(PG8_SA(0, 0), cA, voffA); PG8_STAGE(PG8_SA(0, 1), cA + hstepA, voffA);
        if (wr == 1) PG8_BAR;
        PG8_WAIT_V(2); PG8_BAR;
        PG8_STAGE(PG8_SB(1, 0), cB + kstep, voffB); PG8_STAGE(PG8_SA(1, 0), cA + kstep, voffA); PG8_STAGE(PG8_SB(1, 1), cB + hstepB + kstep, voffB);
        PG8_WAIT_V(6); PG8_BAR;
    } else {
        PG8_STAGE(PG8_SB(0, 0), cB, voffB); PG8_STAGE(PG8_SA(0, 0), cA, voffA); PG8_STAGE(PG8_SB(0, 1), cB + hstepB, voffB); PG8_STAGE(PG8_SA(0, 1), cA + hstepA, voffA);
        if (wr == 1) PG8_BAR;
        PG8_WAIT_V(4); PG8_BAR;
        PG8_STAGE(PG8_SB(1, 0), cB + kstep, voffB); PG8_STAGE(PG8_SA(1, 0), cA + kstep, voffA); PG8_STAGE(PG8_SB(1, 1), cB + hstepB + kstep, voffB);
        PG8_WAIT_V(6); PG8_BAR;
    }
    for (;;) {
        const bool has_next = S.next(ui + 1, nxt);
        const char* nA = has_next ? (const char*)g.A + (size_t)nxt.pm * tstepA : cA; const char* nB = has_next ? (const char*)g.Bt + (size_t)nxt.pn * tstepB : cB;
        for (int t = 0; t < nt; t += 2) {
            const bool last = (t == nt - 2);
            const char* a1 = cA + (size_t)(t + 1) * kstep;
            const char* a2 = last ? nA : cA + (size_t)(t + 2) * kstep; const char* b2 = last ? nB : cB + (size_t)(t + 2) * kstep;
            const char* a3 = a2 + kstep; const char* b3 = b2 + kstep;
            if (last && has_next) S.a_ready(nxt);
            if constexpr (SP2) {
            PG8_LDB(B0, 0, 0); PG8_LDB(B1, 0, 1); PG8_SCHED; PG8_LDA(At, 0, 0); PG8_STAGE(PG8_SA(1, 1), a1 + hstepA, voffA);
            PG8_WAIT_V(8); PG8_WAIT_L(0); PG8_BAR; PG8_MMA(0, 0, At, B0); PG8_MMA(0, 1, At, B1); PG8_BAR; PG8_SCHED;
            PG8_LDA(At, 0, 1); PG8_STAGE(PG8_SB(0, 0), b2, voffB); PG8_STAGE(PG8_SB(0, 1), b2 + hstepB, voffB); PG8_STAGE(PG8_SA(0, 0), a2, voffA);
            PG8_WAIT_V(8); PG8_WAIT_L(0); PG8_BAR; PG8_MMA(1, 0, At, B0); PG8_MMA(1, 1, At, B1); PG8_BAR; PG8_SCHED;
            PG8_LDB(B0, 1, 0); PG8_LDB(B1, 1, 1); PG8_SCHED; PG8_LDA(At, 1, 0); PG8_STAGE(PG8_SA(0, 1), a2 + hstepA, voffA);
            PG8_WAIT_V(8); PG8_WAIT_L(0); PG8_BAR; PG8_MMA(0, 0, At, B0); PG8_MMA(0, 1, At, B1); PG8_BAR; PG8_SCHED;
            PG8_LDA(At, 1, 1); PG8_STAGE(PG8_SB(1, 0), b3, voffB); PG8_STAGE(PG8_SB(1, 1), b3 + hstepB, voffB); PG8_STAGE(PG8_SA(1, 0), a3, voffA);
            PG8_WAIT_V(8); PG8_WAIT_L(0); PG8_BAR; PG8_MMA(1, 0, At, B0); PG8_MMA(1, 1, At, B1); PG8_BAR; PG8_SCHED;
            } else {
            PG8_LDB(B0, 0, 0); PG8_SCHED; PG8_LDA(At, 0, 0); PG8_STAGE(PG8_SA(1, 1), a1 + hstepA, voffA);
            PG8_WAIT_L(8); PG8_BAR; PG8_WAIT_L(0); PG8_MMA(0, 0, At, B0); PG8_BAR; PG8_SCHED;
            PG8_LDB(B1, 0, 1); PG8_STAGE(PG8_SB(0, 0), b2, voffB);
            PG8_BAR; PG8_WAIT_L(0); PG8_MMA(0, 1, At, B1); PG8_BAR;
            PG8_LDA(At, 0, 1); PG8_STAGE(PG8_SA(0, 0), a2, voffA);
            PG8_BAR; PG8_WAIT_L(0); PG8_MMA(1, 0, At, B0); PG8_BAR; PG8_SCHED;
            PG8_STAGE(PG8_SB(0, 1), b2 + hstepB, voffB);
            PG8_WAIT_V(6); PG8_BAR; PG8_MMA(1, 1, At, B1); PG8_BAR;
            PG8_LDB(B0, 1, 0); PG8_SCHED; PG8_LDA(At, 1, 0); PG8_STAGE(PG8_SA(0, 1), a2 + hstepA, voffA);
            PG8_WAIT_L(8); PG8_BAR; PG8_WAIT_L(0); PG8_MMA(0, 0, At, B0); PG8_BAR; PG8_SCHED;
            PG8_LDB(B1, 1, 1); PG8_STAGE(PG8_SB(1, 0), b3, voffB);
            PG8_BAR; PG8_WAIT_L(0); PG8_MMA(0, 1, At, B1); PG8_BAR;
            PG8_LDA(At, 1, 1); PG8_STAGE(PG8_SA(1, 0), a3, voffA);
            PG8_BAR; PG8_WAIT_L(0); PG8_MMA(1, 0, At, B0); PG8_BAR; PG8_SCHED;
            PG8_STAGE(PG8_SB(1, 1), b3 + hstepB, voffB);
            PG8_WAIT_V(6); PG8_BAR; PG8_MMA(1, 1, At, B1); PG8_BAR;
            }
        }
        if constexpr (ALIGN_EPI) { if (wr == 0) PG8_BAR; }
        if constexpr (!Epi::AFTER_DRAIN) { E(acc, cur, wr, wc, fr, fq); S.done(cur); }
        if (!has_next) break;
#pragma unroll
        for (int a = 0; a < 2; ++a)
#pragma unroll
            for (int b = 0; b < 2; ++b)
#pragma unroll
                for (int m = 0; m < 4; ++m)
#pragma unroll
                    for (int n = 0; n < 2; ++n) acc[a][b][m][n] = (f32x4){0.f, 0.f, 0.f, 0.f};
        cur = nxt; cA = nA; cB = nB; ++ui;
        if constexpr (ALIGN_EPI) { if (wr == 1) PG8_BAR; }
    }
    PG8_WAIT_V(0);
    if constexpr (!ALIGN_EPI) { if (wr == 0) PG8_BAR; }
    PG8_BAR;
    if constexpr (Epi::AFTER_DRAIN) { E.fused(acc, cur, wr, wc, fr, fq, lds, wid, lane); S.done(cur); }
#undef PG8_SA
#undef PG8_SB
#undef PG8_STAGE
#undef PG8_LDA
#undef PG8_LDB
#undef PG8_MMA
#undef PG8_WAIT_V
#undef PG8_WAIT_L
#undef PG8_BAR
#undef PG8_SCHED
}
}
namespace pg8 {
__device__ __forceinline__ unsigned cvtpk(float lo, float hi) { typedef float f2_t __attribute__((ext_vector_type(2))); typedef __bf16 b2_t __attribute__((ext_vector_type(2))); f2_t v = {lo, hi}; b2_t b = __builtin_convertvector(v, b2_t); return __builtin_bit_cast(unsigned, b); }
__device__ __forceinline__ u32x4 pack8(const f32x4& v0, const f32x4& v1) { u32x4 w; w.x = cvtpk(v0[0], v0[1]); w.y = cvtpk(v0[2], v0[3]); w.z = cvtpk(v1[0], v1[1]); w.w = cvtpk(v1[2], v1[3]); return w; }
struct EpiPlain {
    static constexpr bool PERM = true, AFTER_DRAIN = false;
    bf16_t* O; int ldc;
    __device__ __forceinline__ void operator()(const f32x4 (&acc)[2][2][4][2], const Unit& u, int wr, int wc, int fr, int fq) const {
        const int row0 = u.pm * BM + wr * 64 + fr, col0 = u.pn * BM + wc * 32 + 8 * fq;
#pragma unroll
        for (int ai = 0; ai < 2; ++ai)
#pragma unroll
            for (int m = 0; m < 4; ++m) { bf16_t* rowp = O + (size_t)(row0 + ai * HALF + m * 16) * ldc + col0;
#pragma unroll
                for (int bj = 0; bj < 2; ++bj) *(u32x4*)(rowp + bj * HALF) = pack8(acc[ai][bj][m][0], acc[ai][bj][m][1]); }
    }
};
struct EpiRowScaleRope {
    static constexpr bool PERM = true, AFTER_DRAIN = false;
    bf16_t* O; int ldc; float mult; int rope_pn0; const float* cs;
    __device__ __forceinline__ void operator()(const f32x4 (&acc)[2][2][4][2], const Unit& u, int wr, int wc, int fr, int fq) const {
        const int row0 = u.pm * BM + wr * 64 + fr, col0 = u.pn * BM + wc * 32 + 8 * fq;
        const bool rope = u.pn >= rope_pn0;
#pragma unroll
        for (int ai = 0; ai < 2; ++ai)
#pragma unroll
            for (int m = 0; m < 4; ++m) { const int row = row0 + ai * HALF + m * 16; const float s = mult;
                f32x4 a0 = acc[ai][0][m][0] * s, a1 = acc[ai][0][m][1] * s, b0 = acc[ai][1][m][0] * s, b1 = acc[ai][1][m][1] * s;
                if (rope) { const f32x4* cp = (const f32x4*)(cs + (size_t)row * 64 + 16 * fq);
                    const f32x4 c0 = cp[0], c1 = cp[1], c2 = cp[2], c3 = cp[3];
                    f32x4 x0, x1, y0, y1;
                    x0[0] = a0[0] * c0[0] - b0[0] * c0[1]; y0[0] = b0[0] * c0[0] + a0[0] * c0[1];
                    x0[1] = a0[1] * c0[2] - b0[1] * c0[3]; y0[1] = b0[1] * c0[2] + a0[1] * c0[3];
                    x0[2] = a0[2] * c1[0] - b0[2] * c1[1]; y0[2] = b0[2] * c1[0] + a0[2] * c1[1];
                    x0[3] = a0[3] * c1[2] - b0[3] * c1[3]; y0[3] = b0[3] * c1[2] + a0[3] * c1[3];
                    x1[0] = a1[0] * c2[0] - b1[0] * c2[1]; y1[0] = b1[0] * c2[0] + a1[0] * c2[1];
                    x1[1] = a1[1] * c2[2] - b1[1] * c2[3]; y1[1] = b1[1] * c2[2] + a1[1] * c2[3];
                    x1[2] = a1[2] * c3[0] - b1[2] * c3[1]; y1[2] = b1[2] * c3[0] + a1[2] * c3[1];
                    x1[3] = a1[3] * c3[2] - b1[3] * c3[3]; y1[3] = b1[3] * c3[2] + a1[3] * c3[3];
                    a0 = x0; a1 = x1; b0 = y0; b1 = y1; }
                bf16_t* rowp = O + (size_t)row * ldc + col0;
                *(u32x4*)(rowp) = pack8(a0, a1); *(u32x4*)(rowp + HALF) = pack8(b0, b1); }
    }
};
struct EpiColScale {
    static constexpr bool PERM = true, AFTER_DRAIN = false;
    bf16_t* O; int ldc; const float* cscale;
    __device__ __forceinline__ void operator()(const f32x4 (&acc)[2][2][4][2], const Unit& u, int wr, int wc, int fr, int fq) const {
        const int row0 = u.pm * BM + wr * 64 + fr, col0 = u.pn * BM + wc * 32 + 8 * fq;
#pragma unroll
        for (int bj = 0; bj < 2; ++bj) { const f32x4 s0 = *(const f32x4*)(cscale + col0 + bj * HALF), s1 = *(const f32x4*)(cscale + col0 + bj * HALF + 4);
#pragma unroll
            for (int ai = 0; ai < 2; ++ai)
#pragma unroll
                for (int m = 0; m < 4; ++m) *(u32x4*)(O + (size_t)(row0 + ai * HALF + m * 16) * ldc + col0 + bj * HALF) = pack8(acc[ai][bj][m][0] * s0, acc[ai][bj][m][1] * s1);
            asm volatile("" ::: "memory"); }
    }
};
struct EpiSwiGLU {
    static constexpr bool PERM = true, AFTER_DRAIN = false;
    bf16_t* O; int ldc;
    __device__ __forceinline__ void operator()(const f32x4 (&acc)[2][2][4][2], const Unit& u, int wr, int wc, int fr, int fq) const {
        const int row0 = u.pm * BM + wr * 64 + fr, col0 = u.pn * HALF + wc * 32 + 8 * fq;
#pragma unroll
        for (int ai = 0; ai < 2; ++ai)
#pragma unroll
            for (int m = 0; m < 4; ++m) { f32x4 r[2];
#pragma unroll
                for (int n = 0; n < 2; ++n) { const f32x4 g = acc[ai][0][m][n], up = acc[ai][1][m][n];
#pragma unroll
                    for (int e = 0; e < 4; ++e) r[n][e] = g[e] * __builtin_amdgcn_rcpf(1.0f + __expf(-g[e])) * up[e]; }
                *(u32x4*)(O + (size_t)(row0 + ai * HALF + m * 16) * ldc + col0) = pack8(r[0], r[1]); }
    }
};
}
#define LAS __attribute__((address_space(3)))
typedef unsigned short bf16_t;
typedef short bf16x8 __attribute__((ext_vector_type(8)));
typedef float f32x4 __attribute__((ext_vector_type(4)));
typedef unsigned u32x4 __attribute__((ext_vector_type(4)));
typedef unsigned u32x2 __attribute__((ext_vector_type(2)));
constexpr int BATCH = 2, SEQ = 8192, DM = 2048, M = BATCH * SEQ, DFF = 5632, NADA = 6 * DM;
constexpr int ZC = 4096;
constexpr int ZO_CQ = 0, ZO_CKV = 512, ZO_QG = 768, ZO_KG = 1280, ZO_VG = 1792, ZO_RG = 2816, ZO_KR = 3840, ZO_AG = 3904;
constexpr int QC = 1536;
constexpr float RMS_EPS = 1e-6f;
constexpr float QSCALE = 0.07216878364870323f * 1.4426950408889634f;
constexpr int KS_ADA = 16;
constexpr size_t MiB = 1u << 20;
constexpr size_t WS_ADAP = 0, WS_ADA = 1536 * 1024, WS_RSTDQ = 1792 * 1024, WS_RSTDKV = 1856 * 1024, WS_DECAY = 2 * MiB, WS_CS = 3 * MiB, WS_KROPE = 7 * MiB;
constexpr size_t WS_WIN = 10 * MiB, WS_WUQ = 26 * MiB, WS_WUK = 28 * MiB, WS_WUV = 29 * MiB, WS_WOUT = 30 * MiB, WS_WGU = 38 * MiB, WS_WD = 82 * MiB;
constexpr size_t WS_XN = 104 * MiB;
constexpr size_t WS_Q = 168 * MiB, WS_KN = 216 * MiB, WS_VT = 248 * MiB, WS_QDEC = 280 * MiB, WS_OI = 296 * MiB, WS_ST = 328 * MiB;
constexpr size_t WS_O = 168 * MiB;
constexpr size_t WS_ACT = 232 * MiB, WS_CQN = 392 * MiB, WS_CKVN = 408 * MiB, WS_END = 416 * MiB;
constexpr int NTHREADS = 512, LDS_BYTES = 147456;

__device__ const double INVF_REV[32] = {
    1.59154943091895346e-01,
    1.19349370211248862e-01,
    8.94994016088910133e-02,
    6.71150830052272551e-02,
    5.03292121044870353e-02,
    3.77415847174197711e-02,
    2.83021958306233987e-02,
    2.12236527647776604e-02,
    1.59154943091895339e-02,
    1.19349370211248862e-02,
    8.94994016088910237e-03,
    6.71150830052272534e-03,
    5.03292121044870370e-03,
    3.77415847174197719e-03,
    2.83021958306233987e-03,
    2.12236527647776622e-03,
    1.59154943091895356e-03,
    1.19349370211248849e-03,
    8.94994016088910237e-04,
    6.71150830052272599e-04,
    5.03292121044870326e-04,
    3.77415847174197741e-04,
    2.83021958306233954e-04,
    2.12236527647776605e-04,
    1.59154943091895351e-04,
    1.19349370211248862e-04,
    8.94994016088910182e-05,
    6.71150830052272545e-05,
    5.03292121044870354e-05,
    3.77415847174197768e-05,
    2.83021958306233961e-05,
    2.12236527647776592e-05

};

struct Params {
    const float *x, *c; const int* pos; const float *w_ada, *b_ada, *g_pre_mix, *g_post_mix, *w_in, *g_q, *w_uq, *g_kv, *w_uk, *w_uv, *w_gate_up, *b_gate, *g_gla, *w_out, *g_pre_ffn, *g_post_ffn, *w_fg, *w_fu, *w_fd;
    float* out; unsigned char* ws;
};

__device__ __forceinline__ float bf2f(unsigned short u) { return __uint_as_float((unsigned)u << 16); }
__device__ __forceinline__ unsigned short f2bf(float f) { unsigned u = __float_as_uint(f); return (unsigned short)((u + 0x7fffu + ((u >> 16) & 1u)) >> 16); }
__device__ __forceinline__ unsigned pk2(float lo, float hi) { return pg8::cvtpk(lo, hi); }
__device__ __forceinline__ float wave_sum(float v) {
#pragma unroll
    for (int o = 1; o < 64; o <<= 1) v += __shfl_xor(v, o);
    return v;
}
__device__ __forceinline__ float silu_f(float v) { return v * __builtin_amdgcn_rcpf(1.0f + __expf(-v)); }
#define MFMA16(a, b, c) __builtin_amdgcn_mfma_f32_16x16x32_bf16((a), (b), (c), 0, 0, 0)

struct MapIn { const float* W;
    __device__ __forceinline__ const float* col(int n, int& ld) const { ld = 3920; int s;
        if (n < 768) s = n; else if (n < 1280) s = 832 + (n - 768); else if (n < 1792) s = 1344 + (n - 1280); else if (n < 2816) s = 1856 + (n - 1792);
        else if (n < 3840) s = 2896 + (n - 2816); else if (n < 3904) s = 768 + (n - 3840); else if (n < 3920) s = 2880 + (n - 3904); else return nullptr;
        return W + s; } };
struct MapUq { const float* W;
    __device__ __forceinline__ const float* col(int n, int& ld) const { ld = 1536; int s;
        if (n < 1024) s = (n >> 7) * 192 + (n & 127);
        else { const int mm = n - 1024, tile = mm >> 8, w = mm & 255, half = w >> 7, hh = (w & 127) >> 5, i = w & 31; s = (tile * 4 + hh) * 192 + 128 + half * 32 + i; }
        return W + s; } };
struct MapId { const float* W; int ldw;
    __device__ __forceinline__ const float* col(int n, int& ld) const { ld = ldw; return W + n; } };
struct MapGU { const float* Wg; const float* Wu;
    __device__ __forceinline__ const float* col(int n, int& ld) const { ld = DFF; const int tile = n >> 8, w = n & 255; return (w < 128) ? (Wg + tile * 128 + w) : (Wu + tile * 128 + (w - 128)); } };
template <class Map>
__device__ __forceinline__ void transpose_item(const Map& mp, const float* gain, int K, bf16_t* WT, LAS float* scr, int item, int nblk, int lane) {
    const int kb = item / nblk, nb = item % nblk, k0 = 64 * kb, n0 = 32 * nb;
    int ld; const float* src = mp.col(n0 + (lane & 31), ld);
#pragma unroll 8
    for (int i = 0; i < 32; ++i) { const int kk = 2 * i + (lane >> 5); float v = src ? src[(size_t)(k0 + kk) * ld] : 0.f; if (gain) v *= gain[k0 + kk]; scr[kk * 33 + (lane & 31)] = v; }
    asm volatile("s_waitcnt lgkmcnt(0)" ::: "memory");
    const int c = lane & 7;
#pragma unroll
    for (int j = 0; j < 4; ++j) { const int n = (lane >> 3) + 8 * j; const LAS float* s = scr + (8 * c) * 33 + n;
        u32x4 o; o.x = pk2(s[0 * 33], s[1 * 33]); o.y = pk2(s[2 * 33], s[3 * 33]); o.z = pk2(s[4 * 33], s[5 * 33]); o.w = pk2(s[6 * 33], s[7 * 33]);
        *(u32x4*)(WT + (size_t)(n0 + n) * K + k0 + 8 * c) = o; }
    asm volatile("s_waitcnt lgkmcnt(0)" ::: "memory");
}

__device__ __forceinline__ void p0_prologue(const Params& P, LAS unsigned char* lds, int G) {
    const int tid = threadIdx.x, lane = tid & 63, wave = tid >> 6;
    unsigned char* ws = P.ws;
    const int gw = wave * G + blockIdx.x, NGW = G * 8;
    float* adap = (float*)(ws + WS_ADAP);
    for (int it = gw; it < 48 * KS_ADA; it += NGW) {
        const int nc = it % 48, ks = it / 48, n0 = nc * 256 + lane * 4;
        f32x4 a0 = {0.f, 0.f, 0.f, 0.f}, a1 = {0.f, 0.f, 0.f, 0.f};
#pragma unroll 8
        for (int kk = 0; kk < 128; ++kk) { const int k = ks * 128 + kk; const f32x4 w = *(const f32x4*)(P.w_ada + (size_t)k * NADA + n0);
            const float s0 = silu_f(P.c[k]), s1 = silu_f(P.c[DM + k]); a0 += w * s0; a1 += w * s1; }
        *(f32x4*)(adap + (size_t)(ks * 2 + 0) * NADA + n0) = a0; *(f32x4*)(adap + (size_t)(ks * 2 + 1) * NADA + n0) = a1;
    }
    LAS float* scr = (LAS float*)(lds + wave * 16384);
    constexpr int I_IN = 32 * 128, I_UQ = 8 * 48, I_UK = 4 * 32, I_UV = 4 * 32, I_OUT = 32 * 64, I_GU = 32 * 352, I_D = 88 * 64;
    constexpr int NITEMS = I_IN + I_UQ + I_UK + I_UV + I_OUT + I_GU + I_D;
    for (int it = gw; it < NITEMS; it += NGW) {
        int r = it;
        if (r < I_IN) { transpose_item(MapIn{P.w_in}, nullptr, 2048, (bf16_t*)(ws + WS_WIN), scr, r, 128, lane); continue; } r -= I_IN;
        if (r < I_UQ) { transpose_item(MapUq{P.w_uq}, P.g_q, 512, (bf16_t*)(ws + WS_WUQ), scr, r, 48, lane); continue; } r -= I_UQ;
        if (r < I_UK) { transpose_item(MapId{P.w_uk, 1024}, P.g_kv, 256, (bf16_t*)(ws + WS_WUK), scr, r, 32, lane); continue; } r -= I_UK;
        if (r < I_UV) { transpose_item(MapId{P.w_uv, 1024}, P.g_kv, 256, (bf16_t*)(ws + WS_WUV), scr, r, 32, lane); continue; } r -= I_UV;
        if (r < I_OUT) { transpose_item(MapId{P.w_out, 2048}, nullptr, 2048, (bf16_t*)(ws + WS_WOUT), scr, r, 64, lane); continue; } r -= I_OUT;
        if (r < I_GU) { transpose_item(MapGU{P.w_fg, P.w_fu}, nullptr, 2048, (bf16_t*)(ws + WS_WGU), scr, r, 352, lane); continue; } r -= I_GU;
        transpose_item(MapId{P.w_fd, 2048}, nullptr, DFF, (bf16_t*)(ws + WS_WD), scr, r, 64, lane);
    }
    float* cs = (float*)(ws + WS_CS);
    for (int idx = blockIdx.x * NTHREADS + tid; idx < M * 32; idx += G * NTHREADS) {
        const int m = idx >> 5, i = idx & 31; const double rev = (double)P.pos[m] * INVF_REV[i]; const float fr = (float)(rev - floor(rev));
        cs[2 * idx] = __builtin_amdgcn_cosf(fr); cs[2 * idx + 1] = __builtin_amdgcn_sinf(fr);
    }
}

__device__ __forceinline__ void p1_rows(const Params& P, LAS unsigned char* lds, int G) {
    const int tid = threadIdx.x, lane = tid & 63, wave = tid >> 6;
    const float* adap = (const float*)(P.ws + WS_ADAP); float* ada = (float*)(P.ws + WS_ADA);
    LAS float* TA = (LAS float*)lds;
    LAS float* TC = TA + 2 * DM;
    for (int idx = tid; idx < 2 * DM; idx += NTHREADS) { const int b = idx >> 11, col = idx & (DM - 1);
        float sh = P.b_ada[col], sc = P.b_ada[DM + col];
        for (int ks = 0; ks < KS_ADA; ++ks) { sh += adap[(size_t)(ks * 2 + b) * NADA + col]; sc += adap[(size_t)(ks * 2 + b) * NADA + DM + col]; }
        TA[idx] = P.g_pre_mix[col] * (1.0f + sc); TC[idx] = sh; }
    for (int idx = blockIdx.x * NTHREADS + tid; idx < 2 * NADA; idx += G * NTHREADS) { const int b = idx / NADA, n = idx % NADA; float v = P.b_ada[n];
        for (int ks = 0; ks < KS_ADA; ++ks) v += adap[(size_t)(ks * 2 + b) * NADA + n];
        ada[idx] = v; }
    __syncthreads();
    bf16_t* XN = (bf16_t*)(P.ws + WS_XN);
    for (int m = blockIdx.x * 8 + wave; m < M; m += G * 8) {
        const int b = m >> 13; const f32x4* xr = (const f32x4*)(P.x + (size_t)m * DM) + lane;
        f32x4 v[8]; float ss = 0.f;
#pragma unroll
        for (int j = 0; j < 8; ++j) { v[j] = xr[64 * j]; ss += (v[j][0] * v[j][0] + v[j][1] * v[j][1]) + (v[j][2] * v[j][2] + v[j][3] * v[j][3]); }
        const float rstd = rsqrtf(wave_sum(ss) * (1.0f / DM) + RMS_EPS);
        u32x2* o = (u32x2*)(XN + (size_t)m * DM) + lane;
#pragma unroll
        for (int j = 0; j < 8; ++j) { const f32x4 a = *(const LAS f32x4*)(TA + b * DM + 256 * j + 4 * lane), c = *(const LAS f32x4*)(TC + b * DM + 256 * j + 4 * lane);
            const f32x4 h = v[j] * rstd * a + c; u32x2 w; w.x = pk2(h[0], h[1]); w.y = pk2(h[2], h[3]); o[64 * j] = w; }
    }
}
__device__ __forceinline__ void p2b_rows(const Params& P, int G) {
    const int tid = threadIdx.x, lane = tid & 63, wave = tid >> 6;
    const bf16_t* Z = (const bf16_t*)P.out; bf16_t* CQN = (bf16_t*)(P.ws + WS_CQN); bf16_t* CKVN = (bf16_t*)(P.ws + WS_CKVN);
    const float* cs = (const float*)(P.ws + WS_CS); bf16_t* KR = (bf16_t*)(P.ws + WS_KROPE);
    for (int m = blockIdx.x * 8 + wave; m < M; m += G * 8) {
        const bf16_t* zr = Z + (size_t)m * ZC;
        const u32x4 a = *(const u32x4*)(zr + ZO_CQ + 8 * lane); const u32x2 k = *(const u32x2*)(zr + ZO_CKV + 4 * lane);
        float s1 = 0.f, s2 = 0.f;
#pragma unroll
        for (int e = 0; e < 4; ++e) { const float lo = __uint_as_float(a[e] << 16), hi = __uint_as_float(a[e] & 0xffff0000u); s1 += lo * lo + hi * hi; }
#pragma unroll
        for (int e = 0; e < 2; ++e) { const float lo = __uint_as_float(k[e] << 16), hi = __uint_as_float(k[e] & 0xffff0000u); s2 += lo * lo + hi * hi; }
        s1 = wave_sum(s1); s2 = wave_sum(s2);
        const float r1 = rsqrtf(s1 * (1.0f / 512.0f) + RMS_EPS), r2 = rsqrtf(s2 * (1.0f / 256.0f) + RMS_EPS);
        { u32x4 w;
#pragma unroll
          for (int e = 0; e < 4; ++e) w[e] = pk2(__uint_as_float(a[e] << 16) * r1, __uint_as_float(a[e] & 0xffff0000u) * r1);
          *(u32x4*)(CQN + (size_t)m * 512 + 8 * lane) = w;
          u32x2 w2;
#pragma unroll
          for (int e = 0; e < 2; ++e) w2[e] = pk2(__uint_as_float(k[e] << 16) * r2, __uint_as_float(k[e] & 0xffff0000u) * r2);
          *(u32x2*)(CKVN + (size_t)m * 256 + 4 * lane) = w2; }
        if (lane < 32) { const float x1 = bf2f(zr[ZO_KR + lane]), x2 = bf2f(zr[ZO_KR + 32 + lane]); const float c = cs[(size_t)m * 64 + 2 * lane], s = cs[(size_t)m * 64 + 2 * lane + 1];
            KR[(size_t)m * 64 + lane] = f2bf(x1 * c - x2 * s); KR[(size_t)m * 64 + 32 + lane] = f2bf(x2 * c + x1 * s); }
    }
}
__device__ __forceinline__ void p7_rows(const Params& P, LAS unsigned char* lds, int G) {
    const int tid = threadIdx.x, lane = tid & 63, wave = tid >> 6;
    const float* ada = (const float*)(P.ws + WS_ADA);
    LAS float* TA = (LAS float*)lds; LAS float* TB = TA + 2 * DM; LAS float* TC = TB + 2 * DM;
    for (int idx = tid; idx < 2 * DM; idx += NTHREADS) { const int b = idx >> 11, col = idx & (DM - 1); const float* ab = ada + (size_t)b * NADA;
        TA[idx] = ab[2 * DM + col] * P.g_post_mix[col]; TB[idx] = P.g_pre_ffn[col] * (1.0f + ab[4 * DM + col]); TC[idx] = ab[3 * DM + col]; }
    __syncthreads();
    const bf16_t* O = (const bf16_t*)(P.ws + WS_O); bf16_t* XN = (bf16_t*)(P.ws + WS_XN);
    for (int m = blockIdx.x * 8 + wave; m < M; m += G * 8) {
        const int b = m >> 13; const f32x4* xr = (const f32x4*)(P.x + (size_t)m * DM) + lane; const u32x2* orow = (const u32x2*)(O + (size_t)m * DM) + lane;
        f32x4 v[8]; float ss = 0.f;
#pragma unroll
        for (int j = 0; j < 8; ++j) { const u32x2 w = orow[64 * j]; v[j][0] = __uint_as_float(w.x << 16); v[j][1] = __uint_as_float(w.x & 0xffff0000u); v[j][2] = __uint_as_float(w.y << 16); v[j][3] = __uint_as_float(w.y & 0xffff0000u);
            ss += (v[j][0] * v[j][0] + v[j][1] * v[j][1]) + (v[j][2] * v[j][2] + v[j][3] * v[j][3]); }
        const float rstd = rsqrtf(wave_sum(ss) * (1.0f / DM) + RMS_EPS);
        float s2 = 0.f; f32x4* outr = (f32x4*)(P.out + (size_t)m * DM) + lane;
#pragma unroll
        for (int j = 0; j < 8; ++j) { const f32x4 a = *(const LAS f32x4*)(TA + b * DM + 256 * j + 4 * lane); const f32x4 x1 = xr[64 * j] + v[j] * rstd * a; v[j] = x1; outr[64 * j] = x1;
            s2 += (x1[0] * x1[0] + x1[1] * x1[1]) + (x1[2] * x1[2] + x1[3] * x1[3]); }
        const float rstd2 = rsqrtf(wave_sum(s2) * (1.0f / DM) + RMS_EPS);
        u32x2* o = (u32x2*)(XN + (size_t)m * DM) + lane;
#pragma unroll
        for (int j = 0; j < 8; ++j) { const f32x4 a = *(const LAS f32x4*)(TB + b * DM + 256 * j + 4 * lane), c = *(const LAS f32x4*)(TC + b * DM + 256 * j + 4 * lane);
            const f32x4 h = v[j] * rstd2 * a + c; u32x2 w; w.x = pk2(h[0], h[1]); w.y = pk2(h[2], h[3]); o[64 * j] = w; }
    }
}
__device__ __forceinline__ void p10_rows(const Params& P, LAS unsigned char* lds, int G) {
    const int tid = threadIdx.x, lane = tid & 63, wave = tid >> 6;
    const float* ada = (const float*)(P.ws + WS_ADA);
    LAS float* TA = (LAS float*)lds;
    for (int idx = tid; idx < 2 * DM; idx += NTHREADS) { const int b = idx >> 11, col = idx & (DM - 1); TA[idx] = ada[(size_t)b * NADA + 5 * DM + col] * P.g_post_ffn[col]; }
    __syncthreads();
    const bf16_t* F = (const bf16_t*)(P.ws + WS_O);
    for (int m = blockIdx.x * 8 + wave; m < M; m += G * 8) {
        const int b = m >> 13; const u32x2* fr = (const u32x2*)(F + (size_t)m * DM) + lane; f32x4* outr = (f32x4*)(P.out + (size_t)m * DM) + lane;
        f32x4 v[8]; float ss = 0.f;
#pragma unroll
        for (int j = 0; j < 8; ++j) { const u32x2 w = fr[64 * j]; v[j][0] = __uint_as_float(w.x << 16); v[j][1] = __uint_as_float(w.x & 0xffff0000u); v[j][2] = __uint_as_float(w.y << 16); v[j][3] = __uint_as_float(w.y & 0xffff0000u);
            ss += (v[j][0] * v[j][0] + v[j][1] * v[j][1]) + (v[j][2] * v[j][2] + v[j][3] * v[j][3]); }
        const float rstd = rsqrtf(wave_sum(ss) * (1.0f / DM) + RMS_EPS);
#pragma unroll
        for (int j = 0; j < 8; ++j) { const f32x4 a = *(const LAS f32x4*)(TA + b * DM + 256 * j + 4 * lane); outr[64 * j] = outr[64 * j] + v[j] * rstd * a; }
    }
}
constexpr int G1_AG = 0, G1_SEG = 4096, G1_QD = 8192, G1_KI = G1_QD + 64 * 272, G1_KDT = G1_KI + 64 * 272, G1_VT = G1_KDT + 128 * 144, G1_AT = G1_VT + 256 * 144, G1_END = G1_AT + 64 * 144;
static_assert(G1_END <= 131072, "G1 LDS");
__device__ __forceinline__ void gla_intra_unit(const Params& P, LAS unsigned char* lds, int unit) {
    const int tid = threadIdx.x, lane = tid & 63, wid = tid >> 6, fr = lane & 15, fq = lane >> 4;
    const int bh = unit >> 7, n = unit & 127, b = bh >> 2, h = bh & 3;
    const size_t t0 = (size_t)b * SEQ + 64 * n;
    const bf16_t* Z = (const bf16_t*)P.out;
    LAS float* ag = (LAS float*)(lds + G1_AG); LAS float* seg = (LAS float*)(lds + G1_SEG);
    LAS bf16_t* qd = (LAS bf16_t*)(lds + G1_QD); LAS bf16_t* ki = (LAS bf16_t*)(lds + G1_KI); LAS bf16_t* kdT = (LAS bf16_t*)(lds + G1_KDT);
    LAS bf16_t* vT = (LAS bf16_t*)(lds + G1_VT); LAS bf16_t* at = (LAS bf16_t*)(lds + G1_AT);
    bf16_t* qdec_g = (bf16_t*)(P.ws + WS_QDEC); float* decay_g = (float*)(P.ws + WS_DECAY); bf16_t* OI = (bf16_t*)(P.ws + WS_OI); bf16_t* DS = (bf16_t*)(P.ws + WS_XN);
    { const int idx = tid * 2, c = idx >> 4, r = idx & 15; const unsigned w = *(const unsigned*)(Z + (t0 + c) * ZC + ZO_AG + r); ag[c * 16 + r] = __uint_as_float(w << 16); ag[c * 16 + r + 1] = __uint_as_float(w & 0xffff0000u); }
#pragma unroll
    for (int i = 0; i < 4; ++i) { const int id = tid + NTHREADS * i, c = id >> 5, vc = id & 31; const u32x4 w = *(const u32x4*)(Z + (t0 + c) * ZC + ZO_VG + 256 * h + 8 * vc);
#pragma unroll
        for (int e = 0; e < 4; ++e) { vT[(8 * vc + 2 * e) * 72 + c] = (bf16_t)(w[e] & 0xffffu); vT[(8 * vc + 2 * e + 1) * 72 + c] = (bf16_t)(w[e] >> 16); } }
    __syncthreads();
    { const int d = tid & 127, cgp = tid >> 7;
      float w[16];
#pragma unroll
      for (int r = 0; r < 16; ++r) w[r] = P.w_gate_up[r * 512 + 128 * h + d];
      const float bias = P.b_gate[128 * h + d];
      float bcv[16]; float run = 0.f;
#pragma unroll
      for (int i = 0; i < 16; ++i) { const int c = cgp * 16 + i; float xg = bias;
#pragma unroll
          for (int r4 = 0; r4 < 4; ++r4) { const f32x4 a = *(const LAS f32x4*)(ag + c * 16 + 4 * r4); xg += a[0] * w[4 * r4] + a[1] * w[4 * r4 + 1] + a[2] * w[4 * r4 + 2] + a[3] * w[4 * r4 + 3]; }
          const float ls = fminf(xg, 0.f) - __logf(1.0f + __expf(-fabsf(xg)));
          run += ls * (1.0f / 16.0f); bcv[i] = run; }
      seg[cgp * 128 + d] = run;
      __syncthreads();
      float off = 0.f, tot = 0.f;
#pragma unroll
      for (int g2 = 0; g2 < 4; ++g2) { const float sv = seg[g2 * 128 + d]; tot += sv; if (g2 < cgp) off += sv; }
#pragma unroll
      for (int i = 0; i < 16; ++i) { const int c = cgp * 16 + i; const float bc = bcv[i] + off;
          const float q = bf2f(Z[(t0 + c) * ZC + ZO_QG + 128 * h + d]), k = bf2f(Z[(t0 + c) * ZC + ZO_KG + 128 * h + d]);
          const bf16_t qv = f2bf(q * 0.08838834764831845f * __expf(bc));
          qd[c * 136 + d] = qv; ki[c * 136 + d] = f2bf(k * __expf(-bc)); kdT[d * 72 + c] = f2bf(k * __expf(tot - bc));
          qdec_g[((size_t)unit * 64 + c) * 128 + d] = qv; }
      if (cgp == 0) decay_g[(size_t)unit * 128 + d] = __expf(tot);
    }
    __syncthreads();
    { const int cb = wid >> 1;
#pragma unroll
      for (int jj = 0; jj < 2; ++jj) { const int jb = (wid & 1) * 2 + jj; f32x4 acc = {0.f, 0.f, 0.f, 0.f};
          if (jb <= cb) {
#pragma unroll
              for (int ks = 0; ks < 4; ++ks) { const bf16x8 a = *(const LAS bf16x8*)(qd + (16 * cb + fr) * 136 + 32 * ks + 8 * fq), bb = *(const LAS bf16x8*)(ki + (16 * jb + fr) * 136 + 32 * ks + 8 * fq); acc = MFMA16(a, bb, acc); } }
#pragma unroll
          for (int e = 0; e < 4; ++e) { const int c = 16 * cb + 4 * fq + e, j = 16 * jb + fr; at[c * 72 + j] = f2bf(j <= c ? acc[e] : 0.f); } }
    }
    __syncthreads();
#pragma unroll
    for (int vbi = 0; vbi < 2; ++vbi) { const int vb = 2 * wid + vbi;
        bf16x8 vf[2];
#pragma unroll
        for (int ks = 0; ks < 2; ++ks) vf[ks] = *(const LAS bf16x8*)(vT + (16 * vb + fr) * 72 + 32 * ks + 8 * fq);
#pragma unroll
        for (int cb = 0; cb < 4; ++cb) { f32x4 acc = {0.f, 0.f, 0.f, 0.f};
#pragma unroll
            for (int ks = 0; ks < 2; ++ks) acc = MFMA16(vf[ks], *(const LAS bf16x8*)(at + (16 * cb + fr) * 72 + 32 * ks + 8 * fq), acc);
            u32x2 w; w.x = pk2(acc[0], acc[1]); w.y = pk2(acc[2], acc[3]);
            *(u32x2*)(OI + (t0 + 16 * cb + fr) * 1024 + 256 * h + 16 * vb + 4 * fq) = w; }
#pragma unroll
        for (int db = 0; db < 8; ++db) { f32x4 acc = {0.f, 0.f, 0.f, 0.f};
#pragma unroll
            for (int ks = 0; ks < 2; ++ks) acc = MFMA16(*(const LAS bf16x8*)(kdT + (16 * db + fr) * 72 + 32 * ks + 8 * fq), vf[ks], acc);
            u32x2 w; w.x = pk2(acc[0], acc[1]); w.y = pk2(acc[2], acc[3]);
            *(u32x2*)(DS + ((size_t)unit * 256 + 16 * vb + fr) * 128 + 16 * db + 4 * fq) = w; }
    }
    __syncthreads();
}
__device__ __forceinline__ void gla_scan(const Params& P, int G) {
    const bf16_t* DS = (const bf16_t*)(P.ws + WS_XN); bf16_t* ST = (bf16_t*)(P.ws + WS_ST); const float* decay_g = (const float*)(P.ws + WS_DECAY);
    for (int gid = blockIdx.x * NTHREADS + threadIdx.x; gid < 8 * 16384; gid += G * NTHREADS) {
        const int bh = gid >> 14, e2 = gid & 16383, d = (2 * e2) & 127;
        float s0 = 0.f, s1 = 0.f;
#pragma unroll 8
        for (int n = 0; n < 128; ++n) { const size_t unit = (size_t)bh * 128 + n;
            const unsigned w = *(const unsigned*)(DS + unit * 32768 + 2 * e2); const float d0 = decay_g[unit * 128 + d], d1 = decay_g[unit * 128 + d + 1];
            *(unsigned*)(ST + unit * 32768 + 2 * e2) = pk2(s0, s1);
            s0 = d0 * s0 + __uint_as_float(w << 16); s1 = d1 * s1 + __uint_as_float(w & 0xffff0000u); }
    }
}
__device__ __forceinline__ void gla_inter_unit(const Params& P, LAS unsigned char* lds, int unit) {
    const int tid = threadIdx.x, lane = tid & 63, wid = tid >> 6, fr = lane & 15, fq = lane >> 4;
    const int bh = unit >> 7, n = unit & 127, b = bh >> 2, h = bh & 3;
    const size_t t0 = (size_t)b * SEQ + 64 * n;
    const bf16_t* Z = (const bf16_t*)P.out; const bf16_t* qdec_g = (const bf16_t*)(P.ws + WS_QDEC); const bf16_t* OI = (const bf16_t*)(P.ws + WS_OI); const bf16_t* ST = (const bf16_t*)(P.ws + WS_ST);
    bf16_t* AO = (bf16_t*)(P.ws + WS_XN);
    LAS float* red = (LAS float*)lds;
    const int cb = wid & 3, vh = wid >> 2; const size_t trow = t0 + 16 * cb + fr;
    bf16x8 qf[4];
#pragma unroll
    for (int ks = 0; ks < 4; ++ks) qf[ks] = *(const bf16x8*)(qdec_g + ((size_t)unit * 64 + 16 * cb + fr) * 128 + 32 * ks + 8 * fq);
    f32x4 o[8]; float ss = 0.f;
#pragma unroll
    for (int vbi = 0; vbi < 8; ++vbi) { const int vb = vh * 8 + vbi; f32x4 acc = {0.f, 0.f, 0.f, 0.f};
#pragma unroll
        for (int ks = 0; ks < 4; ++ks) acc = MFMA16(*(const bf16x8*)(ST + ((size_t)unit * 256 + 16 * vb + fr) * 128 + 32 * ks + 8 * fq), qf[ks], acc);
        const u32x2 w = *(const u32x2*)(OI + trow * 1024 + 256 * h + 16 * vb + 4 * fq);
        acc[0] += __uint_as_float(w.x << 16); acc[1] += __uint_as_float(w.x & 0xffff0000u); acc[2] += __uint_as_float(w.y << 16); acc[3] += __uint_as_float(w.y & 0xffff0000u);
        o[vbi] = acc; ss += (acc[0] * acc[0] + acc[1] * acc[1]) + (acc[2] * acc[2] + acc[3] * acc[3]); }
    ss += __shfl_xor(ss, 16); ss += __shfl_xor(ss, 32);
    if (fq == 0) red[wid * 16 + fr] = ss;
    __syncthreads();
    const float tot = red[cb * 16 + fr] + red[(cb + 4) * 16 + fr];
    const float rstd = rsqrtf(tot * (1.0f / 256.0f) + RMS_EPS);
#pragma unroll
    for (int vbi = 0; vbi < 8; ++vbi) { const int vcol = 16 * (vh * 8 + vbi) + 4 * fq;
        const f32x4 g = *(const f32x4*)(P.g_gla + vcol); const u32x2 rw = *(const u32x2*)(Z + trow * ZC + ZO_RG + 256 * h + vcol);
        const float r0 = __uint_as_float(rw.x << 16), r1 = __uint_as_float(rw.x & 0xffff0000u), r2 = __uint_as_float(rw.y << 16), r3 = __uint_as_float(rw.y & 0xffff0000u);
        u32x2 w; w.x = pk2(o[vbi][0] * rstd * g[0] * silu_f(r0), o[vbi][1] * rstd * g[1] * silu_f(r1)); w.y = pk2(o[vbi][2] * rstd * g[2] * silu_f(r2), o[vbi][3] * rstd * g[3] * silu_f(r3));
        *(u32x2*)(AO + trow * DM + 1024 + 256 * h + vcol) = w; }
    __syncthreads();
}

constexpr int AT_KB = 64 * 400, AT_VB = 128 * 144, AT_BUF = AT_KB + AT_VB;
__device__ __forceinline__ void attn_unit(const Params& P, LAS unsigned char* lds, int bh, int qb) {
    const int tid = threadIdx.x, lane = tid & 63, wid = __builtin_amdgcn_readfirstlane(tid >> 6), fr = lane & 15, fq = lane >> 4;
    const int b = bh >> 3, h = bh & 7; const size_t rowb = (size_t)b * SEQ; const int q0 = qb * 256 + wid * 32;
    const bf16_t* Q = (const bf16_t*)(P.ws + WS_Q); const bf16_t* KN = (const bf16_t*)(P.ws + WS_KN); const bf16_t* KR = (const bf16_t*)(P.ws + WS_KROPE); const bf16_t* VT = (const bf16_t*)(P.ws + WS_VT);
    bf16_t* AO = (bf16_t*)(P.ws + WS_XN);
    bf16x8 qf[6][2];
#pragma unroll
    for (int qk = 0; qk < 2; ++qk) { const bf16_t* qp = Q + (rowb + q0 + 16 * qk + fr) * QC;
#pragma unroll
        for (int ks = 0; ks < 4; ++ks) qf[ks][qk] = *(const bf16x8*)(qp + 128 * h + 32 * ks + 8 * fq);
        qf[4][qk] = *(const bf16x8*)(qp + 1024 + (h >> 2) * 256 + (h & 3) * 32 + 8 * fq); qf[5][qk] = *(const bf16x8*)(qp + 1024 + (h >> 2) * 256 + 128 + (h & 3) * 32 + 8 * fq); }
    const int NT = (qb + 1) * 4;
    const bf16_t* KNh = KN + rowb * 1024 + 128 * h; const bf16_t* KRb = KR + rowb * 64; const bf16_t* VTh = VT + (size_t)(128 * h) * M + rowb;
#define AT_DMA(t, buf) do { int ln_ = lane; asm volatile("" : "+v"(ln_)); \
        _Pragma("unroll") for (int j_ = 0; j_ < 6; ++j_) { const int c_ = wid + 8 * j_; if (c_ < 43) { const int L_ = 1024 * c_ + 16 * ln_; const bf16_t* src_; \
            if (L_ < AT_KB) { const int row_ = L_ / 400, cb_ = L_ - row_ * 400; int pc_ = cb_ >> 4; if (pc_ >= 24) pc_ = 0; const size_t r_ = (size_t)(64 * (t) + row_); \
                src_ = (pc_ < 16) ? (KNh + r_ * 1024 + 8 * pc_) : (KRb + r_ * 64 + 8 * (pc_ - 16)); } \
            else { const int L2_ = L_ - AT_KB, dv_ = L2_ / 144, cb_ = L2_ - dv_ * 144; int pc_ = cb_ >> 4; if (pc_ >= 8) pc_ = 0; src_ = VTh + (size_t)dv_ * M + 64 * (t) + 8 * pc_; } \
            __builtin_amdgcn_global_load_lds((const unsigned*)src_, (LAS unsigned*)(lds + (buf) * AT_BUF + 1024 * c_), 16, 0, 0); } } } while (0)
    float mrow[2] = {-1e30f, -1e30f}, lrow[2] = {0.f, 0.f};
    f32x4 o[8][2];
#pragma unroll
    for (int dvb = 0; dvb < 8; ++dvb) { o[dvb][0] = (f32x4){0.f, 0.f, 0.f, 0.f}; o[dvb][1] = (f32x4){0.f, 0.f, 0.f, 0.f}; }
    AT_DMA(0, 0);
    asm volatile("s_waitcnt vmcnt(0)" ::: "memory"); __syncthreads();
#pragma clang loop unroll(disable)
    for (int t = 0; t < NT; ++t) {
        const int buf = t & 1; const bool more = (t + 1 < NT);
        if (more) AT_DMA(t + 1, buf ^ 1);
        const LAS unsigned char* Kl = lds + buf * AT_BUF; const LAS unsigned char* Vl = Kl + AT_KB;
#pragma unroll
        for (int hf = 0; hf < 2; ++hf) {
            const int kh = 64 * t + 32 * hf;
            if (kh <= q0) {
                f32x4 s[2][2];
#pragma unroll
                for (int kvb = 0; kvb < 2; ++kvb) { s[kvb][0] = (f32x4){0.f, 0.f, 0.f, 0.f}; s[kvb][1] = (f32x4){0.f, 0.f, 0.f, 0.f}; }
#pragma unroll
                for (int ks = 0; ks < 6; ++ks) {
#pragma unroll
                    for (int kvb = 0; kvb < 2; ++kvb) { const bf16x8 kf = *(const LAS bf16x8*)(Kl + (32 * hf + 16 * kvb + fr) * 400 + 64 * ks + 16 * fq);
                        s[kvb][0] = MFMA16(kf, qf[ks][0], s[kvb][0]); s[kvb][1] = MFMA16(kf, qf[ks][1], s[kvb][1]); }
                    if (ks & 1) __builtin_amdgcn_sched_barrier(0);
                }
                if (kh == q0) {
#pragma unroll
                    for (int kvb = 0; kvb < 2; ++kvb)
#pragma unroll
                        for (int qk = 0; qk < 2; ++qk)
#pragma unroll
                            for (int e = 0; e < 4; ++e) { const int kv = 16 * kvb + 4 * fq + e, q = 16 * qk + fr; if (kv > q) s[kvb][qk][e] = -INFINITY; }
                }
                bf16x8 pf[2];
#pragma unroll
                for (int qk = 0; qk < 2; ++qk) {
                    float mx = fmaxf(fmaxf(fmaxf(s[0][qk][0], s[0][qk][1]), fmaxf(s[0][qk][2], s[0][qk][3])), fmaxf(fmaxf(s[1][qk][0], s[1][qk][1]), fmaxf(s[1][qk][2], s[1][qk][3])));
                    mx = fmaxf(mx, __shfl_xor(mx, 16)); mx = fmaxf(mx, __shfl_xor(mx, 32));
                    const float mn = fmaxf(mrow[qk], mx), alpha = __builtin_amdgcn_exp2f(mrow[qk] - mn); mrow[qk] = mn;
                    float ps = 0.f;
#pragma unroll
                    for (int kvb = 0; kvb < 2; ++kvb)
#pragma unroll
                        for (int e = 0; e < 4; ++e) { const float p = __builtin_amdgcn_exp2f(s[kvb][qk][e] - mn); s[kvb][qk][e] = p; ps += p; }
                    lrow[qk] = lrow[qk] * alpha + ps;
#pragma unroll
                    for (int dvb = 0; dvb < 8; ++dvb) o[dvb][qk] *= alpha;
                    u32x4 w; w.x = pk2(s[0][qk][0], s[0][qk][1]); w.y = pk2(s[0][qk][2], s[0][qk][3]); w.z = pk2(s[1][qk][0], s[1][qk][1]); w.w = pk2(s[1][qk][2], s[1][qk][3]);
                    pf[qk] = __builtin_bit_cast(bf16x8, w);
                }
#pragma unroll
                for (int dvb = 0; dvb < 8; ++dvb) { const LAS unsigned char* vp = Vl + (16 * dvb + fr) * 144 + (32 * hf + 4 * fq) * 2;
                    const u32x2 lo = *(const LAS u32x2*)vp, hi = *(const LAS u32x2*)(vp + 32);
                    u32x4 w; w.x = lo.x; w.y = lo.y; w.z = hi.x; w.w = hi.y; const bf16x8 vf = __builtin_bit_cast(bf16x8, w);
                    o[dvb][0] = MFMA16(vf, pf[0], o[dvb][0]); o[dvb][1] = MFMA16(vf, pf[1], o[dvb][1]); if (dvb & 1) __builtin_amdgcn_sched_barrier(0); }
            }
        }
        asm volatile("s_waitcnt vmcnt(0)" ::: "memory"); __syncthreads();
    }
#pragma unroll
    for (int qk = 0; qk < 2; ++qk) { float l = lrow[qk]; l += __shfl_xor(l, 16); l += __shfl_xor(l, 32); const float rl = 1.0f / l;
        bf16_t* op = AO + (rowb + q0 + 16 * qk + fr) * DM + 128 * h + 4 * fq;
#pragma unroll
        for (int dvb = 0; dvb < 8; ++dvb) { u32x2 w; w.x = pk2(o[dvb][qk][0] * rl, o[dvb][qk][1] * rl); w.y = pk2(o[dvb][qk][2] * rl, o[dvb][qk][3] * rl); *(u32x2*)(op + 16 * dvb) = w; } }
#undef AT_DMA
}

#ifndef PHASES
#define PHASES 0xFFFF
#endif
#define PH(k) ((PHASES >> (k)) & 1)
__global__ void __launch_bounds__(NTHREADS, 2) hybrid_block_fwd(Params P) {
    extern __shared__ __attribute__((aligned(16))) unsigned char lds_raw[];
    LAS unsigned char* lds = (LAS unsigned char*)lds_raw;
    cg::grid_group grid = cg::this_grid();
    const int G = gridDim.x, bx = blockIdx.x;
    unsigned char* ws = P.ws;
    bf16_t* Zb = (bf16_t*)P.out;
    if (PH(0)) p0_prologue(P, lds, G);
    grid.sync();
    if (PH(1)) p1_rows(P, lds, G);
    grid.sync();
    if (PH(2)) { pg8::Gemm g{(const bf16_t*)(ws + WS_XN), (const bf16_t*)(ws + WS_WIN), M, ZC, DM, DM, DM}; pg8::StaticOrder S; S.init(M, ZC, G, bx);
      pg8::EpiPlain E{Zb, ZC}; pg8::gemm_phase<pg8::EpiPlain, pg8::StaticOrder, true, true>(lds, g, S, E); }
    grid.sync();
    if (PH(3)) p2b_rows(P, G);
    grid.sync();
    if (PH(4)) { pg8::Gemm g{(const bf16_t*)(ws + WS_CQN), (const bf16_t*)(ws + WS_WUQ), M, QC, 512, 512, 512}; pg8::StaticOrder S; S.init(M, QC, G, bx);
      pg8::EpiRowScaleRope E{(bf16_t*)(ws + WS_Q), QC, QSCALE, 4, (const float*)(ws + WS_CS)};
      pg8::gemm_phase<pg8::EpiRowScaleRope, pg8::StaticOrder, true, true>(lds, g, S, E); }
    if (PH(5)) { pg8::Gemm g{(const bf16_t*)(ws + WS_CKVN), (const bf16_t*)(ws + WS_WUK), M, 1024, 256, 256, 256}; pg8::StaticOrder S; S.init(M, 1024, G, bx);
      pg8::EpiPlain E{(bf16_t*)(ws + WS_KN), 1024}; pg8::gemm_phase<pg8::EpiPlain, pg8::StaticOrder, true, true>(lds, g, S, E); }
    if (PH(6)) { pg8::Gemm g{(const bf16_t*)(ws + WS_WUV), (const bf16_t*)(ws + WS_CKVN), 1024, M, 256, 256, 256}; pg8::StaticOrder S; S.init(1024, M, G, bx);
      pg8::EpiPlain E{(bf16_t*)(ws + WS_VT), M}; pg8::gemm_phase<pg8::EpiPlain, pg8::StaticOrder, true, true>(lds, g, S, E); }
    if (PH(7)) for (int u = bx; u < 1024; u += G) gla_intra_unit(P, lds, u);
    grid.sync();
    if (PH(8)) gla_scan(P, G);
    grid.sync();
    if (PH(9)) for (int u = bx; u < 1024; u += G) gla_inter_unit(P, lds, u);
    if (PH(10)) { const int vcu = (G % 8 == 0) ? (bx % 8) * (G / 8) + bx / 8 : bx;
      for (int p2 = 2 * vcu; p2 < 512; p2 += 2 * G) {
#pragma clang loop unroll(disable)
          for (int i2 = 0; i2 < 2; ++i2) { const int p = p2 >> 1, bh = p >> 4, s = p & 15; attn_unit(P, lds, bh, i2 ? s : 31 - s); } } }
    grid.sync();
    if (PH(11)) { pg8::Gemm g{(const bf16_t*)(ws + WS_XN), (const bf16_t*)(ws + WS_WOUT), M, DM, DM, DM, DM}; pg8::StaticOrder S; S.init(M, DM, G, bx);
      pg8::EpiPlain E{(bf16_t*)(ws + WS_O), DM}; pg8::gemm_phase<pg8::EpiPlain, pg8::StaticOrder, true, true>(lds, g, S, E); }
    grid.sync();
    if (PH(12)) p7_rows(P, lds, G);
    grid.sync();
    if (PH(13)) { pg8::Gemm g{(const bf16_t*)(ws + WS_XN), (const bf16_t*)(ws + WS_WGU), M, 2 * DFF, DM, DM, DM}; pg8::StaticOrder S; S.init(M, 2 * DFF, G, bx);
      pg8::EpiSwiGLU E{(bf16_t*)(ws + WS_ACT), DFF}; pg8::gemm_phase<pg8::EpiSwiGLU, pg8::StaticOrder, true, true>(lds, g, S, E); }
    grid.sync();
    if (PH(14)) { pg8::Gemm g{(const bf16_t*)(ws + WS_ACT), (const bf16_t*)(ws + WS_WD), M, DM, DFF, DFF, DFF}; pg8::StaticOrder S; S.init(M, DM, G, bx);
      pg8::EpiPlain E{(bf16_t*)(ws + WS_O), DM}; pg8::gemm_phase<pg8::EpiPlain, pg8::StaticOrder, true, true>(lds, g, S, E); }
    grid.sync();
    if (PH(15)) p10_rows(P, lds, G);
}

extern "C" void kernel_launch(void* const* d_in, const int* in_sizes, int n_in, void* d_out, int out_size, void* d_ws, size_t ws_size, hipStream_t stream) {
    static int grid = 0;
    if (grid == 0) {
        if (n_in != 22 || in_sizes[0] != M * DM || out_size != M * DM || ws_size < WS_END) { fprintf(stderr, "kernel_launch: unexpected shapes (n_in %d, in0 %d, out %d, ws %zu)\n", n_in, n_in > 0 ? in_sizes[0] : -1, out_size, ws_size); grid = -1; return; }
        int dev = 0, cus = 0, per_cu = 0;
        (void)hipGetDevice(&dev); (void)hipDeviceGetAttribute(&cus, hipDeviceAttributeMultiprocessorCount, dev);
        if (hipFuncSetAttribute((const void*)hybrid_block_fwd, hipFuncAttributeMaxDynamicSharedMemorySize, LDS_BYTES) != hipSuccess) { fprintf(stderr, "kernel_launch: hipFuncSetAttribute failed\n"); grid = -1; return; }
        if (hipOccupancyMaxActiveBlocksPerMultiprocessor(&per_cu, (const void*)hybrid_block_fwd, NTHREADS, LDS_BYTES) != hipSuccess || per_cu < 1) { fprintf(stderr, "kernel_launch: occupancy query failed (%d)\n", per_cu); (void)hipGetLastError(); grid = -1; return; }
        grid = cus;
    }
    if (grid < 0) return;
    Params p{};
    const float* const* fin = (const float* const*)d_in;
    p.x = fin[0]; p.c = fin[1]; p.pos = (const int*)d_in[2]; p.w_ada = fin[3]; p.b_ada = fin[4]; p.g_pre_mix = fin[5]; p.g_post_mix = fin[6]; p.w_in = fin[7]; p.g_q = fin[8]; p.w_uq = fin[9];
    p.g_kv = fin[10]; p.w_uk = fin[11]; p.w_uv = fin[12]; p.w_gate_up = fin[13]; p.b_gate = fin[14]; p.g_gla = fin[15]; p.w_out = fin[16]; p.g_pre_ffn = fin[17]; p.g_post_ffn = fin[18];
    p.w_fg = fin[19]; p.w_fu = fin[20]; p.w_fd = fin[21]; p.out = (float*)d_out; p.ws = (unsigned char*)d_ws;
    void* args[] = {&p};
    hipError_t e = hipLaunchCooperativeKernel((const void*)hybrid_block_fwd, dim3(grid), dim3(NTHREADS), args, LDS_BYTES, stream);
    if (e != hipSuccess) fprintf(stderr, "cooperative launch failed: %s (grid %d)\n", hipGetErrorString(e), grid);
}
```

```cpp
#include <hip/hip_runtime.h>
#include <hip/hip_cooperative_groups.h>
#include <cstdio>
#include <cstdint>
#include <cmath>
namespace cg = cooperative_groups;
namespace pg8 {
#define PG8_LAS __attribute__((address_space(3)))
typedef unsigned short bf16_t;
typedef short bf16x8 __attribute__((ext_vector_type(8)));
typedef float f32x4 __attribute__((ext_vector_type(4)));
typedef unsigned u32x4 __attribute__((ext_vector_type(4)));
constexpr int BM = 256, BK = 64, HALF = 128, HTB = HALF * BK * 2  , STAGE_BYTES = 8 * HTB, NXCD = 8, WGM = 8;

__host__ __device__ __forceinline__ int lds_byte(int r, int c) { const int st = (r >> 4) * 2 + (c >> 5), rr = r & 15, cc = c & 31, ob = rr * 64 + cc * 2; return st * 1024 + (ob ^ (((ob >> 9) & 1) << 5)); }
__host__ __device__ __forceinline__ void stage_rc(int b, int& R, int& C) { const int st = b / 1024, sb = b % 1024, swz = sb ^ (((sb >> 9) & 1) << 5); R = (st >> 1) * 16 + swz / 64; C = (st & 1) * 32 + (swz % 64) / 2; }
__host__ __device__ __forceinline__ int perm32(int rho) { const int n = rho >> 4, i = rho & 15; return 8 * (i >> 2) + 4 * n + (i & 3); }

struct Unit { int pm, pn; };
struct Gemm { const bf16_t* A; const bf16_t* Bt; int M, N, K, lda, ldb; };

struct StaticOrder {
    int nM, nN, nwg, G, c;
    __host__ __device__ void init(int M, int N, int G_, int c_) { nM = M / BM; nN = N / BM; nwg = nM * nN; G = G_; c = c_; }
    __host__ __device__ bool next(int i, Unit& u) const {
        const long L = (long)i * G + c; if (L >= nwg) return false;
        int wgid = (int)L; { const int q = nwg / NXCD, r = nwg % NXCD, xcd = wgid % NXCD, off = wgid / NXCD; wgid = (xcd < r ? xcd * (q + 1) : r * (q + 1) + (xcd - r) * q) + off; }
        const int nig = WGM * nN, gid = wgid / nig, fm = gid * WGM, gsz = (nM - fm) < WGM ? (nM - fm) : WGM;
        u.pm = fm + ((wgid % nig) % gsz); u.pn = (wgid % nig) / gsz; return true;
    }
    __device__ __forceinline__ void a_ready(const Unit&) const {}
    __device__ __forceinline__ void done(const Unit&) const {}
};

__device__ __forceinline__ unsigned cvt_pk_bf16(float lo, float hi) { unsigned r; asm volatile("v_cvt_pk_bf16_f32 %0, %1, %2" : "=v"(r) : "v"(lo), "v"(hi)); return r; }
typedef float f32x2 __attribute__((ext_vector_type(2)));
template <class Epi, class Sched, bool ALIGN_EPI = false, bool SP2 = false>
__device__ __forceinline__ void gemm_phase(PG8_LAS unsigned char* lds, const Gemm g, const Sched& S, const Epi& E) {
    const int tid = threadIdx.x, wid = __builtin_amdgcn_readfirstlane(tid >> 6), lane = tid & 63, wr = wid >> 2, wc = wid & 3, fr = lane & 15, fq = lane >> 4;
    const int K = g.K, nt = K / BK;
    unsigned voffA[2], voffB[2];
#pragma unroll
    for (int i = 0; i < 2; ++i) { int R, C; stage_rc(tid * 16 + i * 8192, R, C); const int Rb = Epi::PERM ? ((R & ~31) + perm32(R & 31)) : R;
        voffA[i] = (unsigned)(R * g.lda + C) * 2u; voffB[i] = (unsigned)(Rb * g.ldb + C) * 2u; }
    const size_t kstep = (size_t)(BK * 2);
    const size_t hstepA = (size_t)HALF * g.lda * 2, hstepB = (size_t)HALF * g.ldb * 2;
    const size_t tstepA = 2 * hstepA, tstepB = 2 * hstepB;
    const unsigned ldsw = (unsigned)wid * 1024u;
    const int aoff = lds_byte(wr * 64 + fr, fq * 8), boff = lds_byte(wc * 32 + fr, fq * 8);
#define PG8_SA(b, h) (((b) * 2 + (h)) * HTB)
#define PG8_SB(b, h) ((4 + (b) * 2 + (h)) * HTB)
#define PG8_STAGE(bufoff, gbase, voff) do { _Pragma("unroll") for (int _i = 0; _i < 2; ++_i) \
        __builtin_amdgcn_global_load_lds((const unsigned*)((const char*)(gbase) + (voff)[_i]), (PG8_LAS unsigned*)(lds + (bufoff) + ldsw + _i * 8192), 16, 0, 0); } while (0)
#define PG8_LDA(dst, b, h) do { _Pragma("unroll") for (int m = 0; m < 4; ++m) _Pragma("unroll") for (int k = 0; k < 2; ++k) dst[m][k] = *(const PG8_LAS bf16x8*)(lds + PG8_SA(b, h) + aoff + m * 2048 + k * 1024); } while (0)
#define PG8_LDB(dst, b, h) do { _Pragma("unroll") for (int n = 0; n < 2; ++n) _Pragma("unroll") for (int k = 0; k < 2; ++k) dst[n][k] = *(const PG8_LAS bf16x8*)(lds + PG8_SB(b, h) + boff + n * 2048 + k * 1024); } while (0)
#define PG8_MMA(ai, bj, At, Bt) do { __builtin_amdgcn_s_setprio(1); _Pragma("unroll") for (int m = 0; m < 4; ++m) _Pragma("unroll") for (int n = 0; n < 2; ++n) _Pragma("unroll") for (int k = 0; k < 2; ++k) \
        acc[ai][bj][m][n] = __builtin_amdgcn_mfma_f32_16x16x32_bf16(Bt[n][k], At[m][k], acc[ai][bj][m][n], 0, 0, 0); __builtin_amdgcn_s_setprio(0); } while (0)
#define PG8_WAIT_V(n) asm volatile("s_waitcnt vmcnt(" #n ")" ::: "memory")
#define PG8_WAIT_L(n) asm volatile("s_waitcnt lgkmcnt(" #n ")" ::: "memory")
#define PG8_BAR __builtin_amdgcn_s_barrier()
#define PG8_SCHED __builtin_amdgcn_sched_barrier(0)
    Unit cur, nxt; int ui = 0;
    if (!S.next(0, cur)) return;
    f32x4 acc[2][2][4][2];
#pragma unroll
    for (int a = 0; a < 2; ++a)
#pragma unroll
        for (int b = 0; b < 2; ++b)
#pragma unroll
            for (int m = 0; m < 4; ++m)
#pragma unroll
                for (int n = 0; n < 2; ++n) acc[a][b][m][n] = (f32x4){0.f, 0.f, 0.f, 0.f};
    bf16x8 At[4][2], B0[2][2], B1[2][2];
    const char* cA = (const char*)g.A + (size_t)cur.pm * tstepA; const char* cB = (const char*)g.Bt + (size_t)cur.pn * tstepB;
    S.a_ready(cur);
    if constexpr (SP2) {
        PG8_STAGE(PG8_SB(0, 0), cB, voffB); PG8_STAGE(PG8_SB(0, 1), cB + hstepB, voffB); PG8_STAGE(PG8_SA(0, 0), cA, voffA); PG8_STAGE(PG8_SA(0, 1), cA + hstepA, voffA);
        if (wr == 1) PG8_BAR;
        PG8_WAIT_V(2); PG8_BAR;
        PG8_STAGE(PG8_SB(1, 0), cB + kstep, voffB); PG8_STAGE(PG8_SA(1, 0), cA + kstep, voffA); PG8_STAGE(PG8_SB(1, 1), cB + hstepB + kstep, voffB);
        PG8_WAIT_V(6); PG8_BAR;
    } else {
        PG8_STAGE(PG8_SB(0, 0), cB, voffB); PG8_STAGE(PG8_SA(0, 0), cA, voffA); PG8_STAGE(PG8_SB(0, 1), cB + hstepB, voffB); PG8_STAGE(PG8_SA(0, 1), cA + hstepA, voffA);
        if (wr == 1) PG8_BAR;
        PG8_WAIT_V(4); PG8_BAR;
        PG8_STAGE(PG8_SB(1, 0), cB + kstep, voffB); PG8_STAGE(PG8_SA(1, 0), cA + kstep, voffA); PG8_STAGE(PG8_SB(1, 1), cB + hstepB + kstep, voffB);
        PG8_WAIT_V(6); PG8_BAR;
    }
    for (;;) {
        const bool has_next = S.next(ui + 1, nxt);
        const char* nA = has_next ? (const char*)g.A + (size_t)nxt.pm * tstepA : cA; const char* nB = has_next ? (const char*)g.Bt + (size_t)nxt.pn * tstepB : cB;
        for (int t = 0; t < nt; t += 2) {
            const bool last = (t == nt - 2);
            const char* a1 = cA + (size_t)(t + 1) * kstep;
            const char* a2 = last ? nA : cA + (size_t)(t + 2) * kstep; const char* b2 = last ? nB : cB + (size_t)(t + 2) * kstep;
            const char* a3 = a2 + kstep; const char* b3 = b2 + kstep;
            if (last && has_next) S.a_ready(nxt);
            if constexpr (SP2) {
            PG8_LDB(B0, 0, 0); PG8_LDB(B1, 0, 1); PG8_SCHED; PG8_LDA(At, 0, 0); PG8_STAGE(PG8_SA(1, 1), a1 + hstepA, voffA);
            PG8_WAIT_V(8); PG8_WAIT_L(0); PG8_BAR; PG8_MMA(0, 0, At, B0); PG8_MMA(0, 1, At, B1); PG8_BAR; PG8_SCHED;
            PG8_LDA(At, 0, 1); PG8_STAGE(PG8_SB(0, 0), b2, voffB); PG8_STAGE(PG8_SB(0, 1), b2 + hstepB, voffB); PG8_STAGE(PG8_SA(0, 0), a2, voffA);
            PG8_WAIT_V(8); PG8_WAIT_L(0); PG8_BAR; PG8_MMA(1, 0, At, B0); PG8_MMA(1, 1, At, B1); PG8_BAR; PG8_SCHED;
            PG8_LDB(B0, 1, 0); PG8_LDB(B1, 1, 1); PG8_SCHED; PG8_LDA(At, 1, 0); PG8_STAGE(PG8_SA(0, 1), a2 + hstepA, voffA);
            PG8_WAIT_V(8); PG8_WAIT_L(0); PG8_BAR; PG8_MMA(0, 0, At, B0); PG8_MMA(0, 1, At, B1); PG8_BAR; PG8_SCHED;
            PG8_LDA(At, 1, 1); PG8_STAGE(PG8_SB(1, 0), b3, voffB); PG8_STAGE(PG8_SB(1, 1), b3 + hstepB, voffB); PG8_STAGE(PG8_SA(1, 0), a3, voffA);
            PG8_WAIT_V(8); PG8_WAIT_L(0); PG8_BAR; PG8_MMA(1, 0, At, B0); PG8_MMA(1, 1, At, B1); PG8_BAR; PG8_SCHED;
            } else {
            PG8_LDB(B0, 0, 0); PG8_SCHED; PG8_LDA(At, 0, 0); PG8_STAGE(PG8_SA(1, 1), a1 + hstepA, voffA);
            PG8_WAIT_L(8); PG8_BAR; PG8_WAIT_L(0); PG8_MMA(0, 0, At, B0); PG8_BAR; PG8_SCHED;
            PG8_LDB(B1, 0, 1); PG8_STAGE(PG8_SB(0, 0), b2, voffB);
            PG8_BAR; PG8_WAIT_L(0); PG8_MMA(0, 1, At, B1); PG8_BAR;
            PG8_LDA(At, 0, 1); PG8_STAGE(PG8_SA(0, 0), a2, voffA);
            PG8_BAR; PG8_WAIT_L(0); PG8_MMA(1, 0, At, B0); PG8_BAR; PG8_SCHED;
            PG8_STAGE(PG8_SB(0, 1), b2 + hstepB, voffB);
            PG8_WAIT_V(6); PG8_BAR; PG8_MMA(1, 1, At, B1); PG8_BAR;
            PG8_LDB(B0, 1, 0); PG8_SCHED; PG8_LDA(At, 1, 0); PG8_STAGE(PG8_SA(0, 1), a2 + hstepA, voffA);
            PG8_WAIT_L(8); PG8_BAR; PG8_WAIT_L(0); PG8_MMA(0, 0, At, B0); PG8_BAR; PG8_SCHED;
            PG8_LDB(B1, 1, 1); PG8_STAGE(PG8_SB(1, 0), b3, voffB);
            PG8_BAR; PG8_WAIT_L(0); PG8_MMA(0, 1, At, B1); PG8_BAR;
            PG8_LDA(At, 1, 1); PG8_STAGE(PG8_SA(1, 0), a3, voffA);
            PG8_BAR; PG8_WAIT_L(0); PG8_MMA(1, 0, At, B0); PG8_BAR; PG8_SCHED;
            PG8_STAGE(PG8_SB(1, 1), b3 + hstepB, voffB);
            PG8_WAIT_V(6); PG8_BAR; PG8_MMA(1, 1, At, B1); PG8_BAR;
            }
        }
        if constexpr (ALIGN_EPI) { if (wr == 0) PG8_BAR; }
        if constexpr (!Epi::AFTER_DRAIN) { E(acc, cur, wr, wc, fr, fq); S.done(cur); }
        if (!has_next) break;
#pragma unroll
        for (int a = 0; a < 2; ++a)
#pragma unroll
            for (int b = 0; b < 2; ++b)
#pragma unroll
                for (int m = 0; m < 4; ++m)
#pragma unroll
                    for (int n = 0; n < 2; ++n) acc[a][b][m][n] = (f32x4){0.f, 0.f, 0.f, 0.f};
        cur = nxt; cA = nA; cB = nB; ++ui;
        if constexpr (ALIGN_EPI) { if (wr == 1) PG8_BAR; }
    }
    PG8_WAIT_V(0);
    if constexpr (!ALIGN_EPI) { if (wr == 0) PG8_BAR; }
    PG8_BAR;
    if constexpr (Epi::AFTER_DRAIN) { E.fused(acc, cur, wr, wc, fr, fq, lds, wid, lane); S.done(cur); }
#undef PG8_SA
#undef PG8_SB
#undef PG8_STAGE
#undef PG8_LDA
#undef PG8_LDB
#undef PG8_MMA
#undef PG8_WAIT_V
#undef PG8_WAIT_L
#undef PG8_BAR
#undef PG8_SCHED
}
}
namespace pg8 {
__device__ __forceinline__ unsigned cvtpk(float lo, float hi) { typedef float f2_t __attribute__((ext_vector_type(2))); typedef __bf16 b2_t __attribute__((ext_vector_type(2))); f2_t v = {lo, hi}; b2_t b = __builtin_convertvector(v, b2_t); return __builtin_bit_cast(unsigned, b); }
__device__ __forceinline__ u32x4 pack8(const f32x4& v0, const f32x4& v1) { u32x4 w; w.x = cvtpk(v0[0], v0[1]); w.y = cvtpk(v0[2], v0[3]); w.z = cvtpk(v1[0], v1[1]); w.w = cvtpk(v1[2], v1[3]); return w; }
struct EpiPlain {
    static constexpr bool PERM = true, AFTER_DRAIN = false;
    bf16_t* O; int ldc;
    __device__ __forceinline__ void operator()(const f32x4 (&acc)[2][2][4][2], const Unit& u, int wr, int wc, int fr, int fq) const {
        const int row0 = u.pm * BM + wr * 64 + fr, col0 = u.pn * BM + wc * 32 + 8 * fq;
#pragma unroll
        for (int ai = 0; ai < 2; ++ai)
#pragma unroll
            for (int m = 0; m < 4; ++m) { bf16_t* rowp = O + (size_t)(row0 + ai * HALF + m * 16) * ldc + col0;
#pragma unroll
                for (int bj = 0; bj < 2; ++bj) *(u32x4*)(rowp + bj * HALF) = pack8(acc[ai][bj][m][0], acc[ai][bj][m][1]); }
    }
};
struct EpiRowScaleRope {
    static constexpr bool PERM = true, AFTER_DRAIN = false;
    bf16_t* O; int ldc; float mult; int rope_pn0; const float* cs;
    __device__ __forceinline__ void operator()(const f32x4 (&acc)[2][2][4][2], const Unit& u, int wr, int wc, int fr, int fq) const {
        const int row0 = u.pm * BM + wr * 64 + fr, col0 = u.pn * BM + wc * 32 + 8 * fq;
        const bool rope = u.pn >= rope_pn0;
#pragma unroll
        for (int ai = 0; ai < 2; ++ai)
#pragma unroll
            for (int m = 0; m < 4; ++m) { const int row = row0 + ai * HALF + m * 16; const float s = mult;
                f32x4 a0 = acc[ai][0][m][0] * s, a1 = acc[ai][0][m][1] * s, b0 = acc[ai][1][m][0] * s, b1 = acc[ai][1][m][1] * s;
                if (rope) { const f32x4* cp = (const f32x4*)(cs + (size_t)row * 64 + 16 * fq);
                    const f32x4 c0 = cp[0], c1 = cp[1], c2 = cp[2], c3 = cp[3];
                    f32x4 x0, x1, y0, y1;
                    x0[0] = a0[0] * c0[0] - b0[0] * c0[1]; y0[0] = b0[0] * c0[0] + a0[0] * c0[1];
                    x0[1] = a0[1] * c0[2] - b0[1] * c0[3]; y0[1] = b0[1] * c0[2] + a0[1] * c0[3];
                    x0[2] = a0[2] * c1[0] - b0[2] * c1[1]; y0[2] = b0[2] * c1[0] + a0[2] * c1[1];
                    x0[3] = a0[3] * c1[2] - b0[3] * c1[3]; y0[3] = b0[3] * c1[2] + a0[3] * c1[3];
                    x1[0] = a1[0] * c2[0] - b1[0] * c2[1]; y1[0] = b1[0] * c2[0] + a1[0] * c2[1];
                    x1[1] = a1[1] * c2[2] - b1[1] * c2[3]; y1[1] = b1[1] * c2[2] + a1[1] * c2[3];
                    x1[2] = a1[2] * c3[0] - b1[2] * c3[1]; y1[2] = b1[2] * c3[0] + a1[2] * c3[1];
                    x1[3] = a1[3] * c3[2] - b1[3] * c3[3]; y1[3] = b1[3] * c3[2] + a1[3] * c3[3];
                    a0 = x0; a1 = x1; b0 = y0; b1 = y1; }
                bf16_t* rowp = O + (size_t)row * ldc + col0;
                *(u32x4*)(rowp) = pack8(a0, a1); *(u32x4*)(rowp + HALF) = pack8(b0, b1); }
    }
};
struct EpiColScale {
    static constexpr bool PERM = true, AFTER_DRAIN = false;
    bf16_t* O; int ldc; const float* cscale;
    __device__ __forceinline__ void operator()(const f32x4 (&acc)[2][2][4][2], const Unit& u, int wr, int wc, int fr, int fq) const {
        const int row0 = u.pm * BM + wr * 64 + fr, col0 = u.pn * BM + wc * 32 + 8 * fq;
#pragma unroll
        for (int bj = 0; bj < 2; ++bj) { const f32x4 s0 = *(const f32x4*)(cscale + col0 + bj * HALF), s1 = *(const f32x4*)(cscale + col0 + bj * HALF + 4);
#pragma unroll
            for (int ai = 0; ai < 2; ++ai)
#pragma unroll
                for (int m = 0; m < 4; ++m) *(u32x4*)(O + (size_t)(row0 + ai * HALF + m * 16) * ldc + col0 + bj * HALF) = pack8(acc[ai][bj][m][0] * s0, acc[ai][bj][m][1] * s1);
            asm volatile("" ::: "memory"); }
    }
};
struct EpiSwiGLU {
    static constexpr bool PERM = true, AFTER_DRAIN = false;
    bf16_t* O; int ldc;
    __device__ __forceinline__ void operator()(const f32x4 (&acc)[2][2][4][2], const Unit& u, int wr, int wc, int fr, int fq) const {
        const int row0 = u.pm * BM + wr * 64 + fr, col0 = u.pn * HALF + wc * 32 + 8 * fq;
#pragma unroll
        for (int ai = 0; ai < 2; ++ai)
#pragma unroll
            for (int m = 0; m < 4; ++m) { f32x4 r[2];
#pragma unroll
                for (int n = 0; n < 2; ++n) { const f32x4 g = acc[ai][0][m][n], up = acc[ai][1][m][n];
#pragma unroll
                    for (int e = 0; e < 4; ++e) r[n][e] = g[e] * __builtin_amdgcn_rcpf(1.0f + __expf(-g[e])) * up[e]; }
                *(u32x4*)(O + (size_t)(row0 + ai * HALF + m * 16) * ldc + col0) = pack8(r[0], r[1]); }
    }
};
}
#define LAS __attribute__((address_space(3)))
typedef unsigned short bf16_t;
typedef short bf16x8 __attribute__((ext_vector_type(8)));
typedef float f32x4 __attribute__((ext_vector_type(4)));
typedef unsigned u32x4 __attribute__((ext_vector_type(4)));
typedef unsigned u32x2 __attribute__((ext_vector_type(2)));
constexpr int BATCH = 2, SEQ = 8192, DM = 2048, M = BATCH * SEQ, DFF = 5632, NADA = 6 * DM;
constexpr int ZC = 4096;
constexpr int ZO_CQ = 0, ZO_CKV = 512, ZO_QG = 768, ZO_KG = 1280, ZO_VG = 1792, ZO_RG = 2816, ZO_KR = 3840, ZO_AG = 3904;
constexpr int QC = 1536;
constexpr float RMS_EPS = 1e-6f;
constexpr float QSCALE = 0.07216878364870323f * 1.4426950408889634f;
constexpr int KS_ADA = 16;
constexpr size_t MiB = 1u << 20;
constexpr size_t WS_ADAP = 0, WS_ADA = 1536 * 1024, WS_RSTDQ = 1792 * 1024, WS_RSTDKV = 1856 * 1024, WS_DECAY = 2 * MiB, WS_CS = 3 * MiB, WS_KROPE = 7 * MiB;
constexpr size_t WS_WIN = 10 * MiB, WS_WUQ = 26 * MiB, WS_WUK = 28 * MiB, WS_WUV = 29 * MiB, WS_WOUT = 30 * MiB, WS_WGU = 38 * MiB, WS_WD = 82 * MiB;
constexpr size_t WS_XN = 104 * MiB;
constexpr size_t WS_Q = 168 * MiB, WS_KN = 216 * MiB, WS_VT = 248 * MiB, WS_QDEC = 280 * MiB, WS_OI = 296 * MiB, WS_ST = 328 * MiB;
constexpr size_t WS_O = 168 * MiB;
constexpr size_t WS_ACT = 232 * MiB, WS_CQN = 392 * MiB, WS_CKVN = 408 * MiB, WS_END = 416 * MiB;
constexpr int NTHREADS = 512, LDS_BYTES = 147456;

__device__ const double INVF_REV[32] = {
    1.59154943091895346e-01,
    1.19349370211248862e-01,
    8.94994016088910133e-02,
    6.71150830052272551e-02,
    5.03292121044870353e-02,
    3.77415847174197711e-02,
    2.83021958306233987e-02,
    2.12236527647776604e-02,
    1.59154943091895339e-02,
    1.19349370211248862e-02,
    8.94994016088910237e-03,
    6.71150830052272534e-03,
    5.03292121044870370e-03,
    3.77415847174197719e-03,
    2.83021958306233987e-03,
    2.12236527647776622e-03,
    1.59154943091895356e-03,
    1.19349370211248849e-03,
    8.94994016088910237e-04,
    6.71150830052272599e-04,
    5.03292121044870326e-04,
    3.77415847174197741e-04,
    2.83021958306233954e-04,
    2.12236527647776605e-04,
    1.59154943091895351e-04,
    1.19349370211248862e-04,
    8.94994016088910182e-05,
    6.71150830052272545e-05,
    5.03292121044870354e-05,
    3.77415847174197768e-05,
    2.83021958306233961e-05,
    2.12236527647776592e-05

};

struct Params {
    const float *x, *c; const int* pos; const float *w_ada, *b_ada, *g_pre_mix, *g_post_mix, *w_in, *g_q, *w_uq, *g_kv, *w_uk, *w_uv, *w_gate_up, *b_gate, *g_gla, *w_out, *g_pre_ffn, *g_post_ffn, *w_fg, *w_fu, *w_fd;
    float* out; unsigned char* ws;
};

__device__ __forceinline__ float bf2f(unsigned short u) { return __uint_as_float((unsigned)u << 16); }
__device__ __forceinline__ unsigned short f2bf(float f) { unsigned u = __float_as_uint(f); return (unsigned short)((u + 0x7fffu + ((u >> 16) & 1u)) >> 16); }
__device__ __forceinline__ unsigned pk2(float lo, float hi) { return pg8::cvtpk(lo, hi); }
__device__ __forceinline__ float wave_sum(float v) {
#pragma unroll
    for (int o = 1; o < 64; o <<= 1) v += __shfl_xor(v, o);
    return v;
}
__device__ __forceinline__ float silu_f(float v) { return v * __builtin_amdgcn_rcpf(1.0f + __expf(-v)); }
#define MFMA16(a, b, c) __builtin_amdgcn_mfma_f32_16x16x32_bf16((a), (b), (c), 0, 0, 0)

struct MapIn { const float* W;
    __device__ __forceinline__ const float* col(int n, int& ld) const { ld = 3920; int s;
        if (n < 768) s = n; else if (n < 1280) s = 832 + (n - 768); else if (n < 1792) s = 1344 + (n - 1280); else if (n < 2816) s = 1856 + (n - 1792);
        else if (n < 3840) s = 2896 + (n - 2816); else if (n < 3904) s = 768 + (n - 3840); else if (n < 3920) s = 2880 + (n - 3904); else return nullptr;
        return W + s; } };
struct MapUq { const float* W;
    __device__ __forceinline__ const float* col(int n, int& ld) const { ld = 1536; int s;
        if (n < 1024) s = (n >> 7) * 192 + (n & 127);
        else { const int mm = n - 1024, tile = mm >> 8, w = mm & 255, half = w >> 7, hh = (w & 127) >> 5, i = w & 31; s = (tile * 4 + hh) * 192 + 128 + half * 32 + i; }
        return W + s; } };
struct MapId { const float* W; int ldw;
    __device__ __forceinline__ const float* col(int n, int& ld) const { ld = ldw; return W + n; } };
struct MapGU { const float* Wg; const float* Wu;
    __device__ __forceinline__ const float* col(int n, int& ld) const { ld = DFF; const int tile = n >> 8, w = n & 255; return (w < 128) ? (Wg + tile * 128 + w) : (Wu + tile * 128 + (w - 128)); } };
template <class Map>
__device__ __forceinline__ void transpose_item(const Map& mp, const float* gain, int K, bf16_t* WT, int item, int nblk, int lane) {
    const int kb = item / nblk, nb = item % nblk, k0 = 64 * kb, n0 = 64 * nb, kq = lane >> 4, nc = lane & 15;
    int ld; const float* src = mp.col(n0 + 4 * nc, ld);
    f32x4 v[16];
    if (src) { src += (size_t)(k0 + 16 * kq) * ld;
#pragma unroll
        for (int i = 0; i < 16; ++i) v[i] = *(const f32x4*)(src + (size_t)i * ld);
    } else {
#pragma unroll
        for (int i = 0; i < 16; ++i) v[i] = (f32x4){0.f, 0.f, 0.f, 0.f};
    }
    if (gain) {
#pragma unroll
        for (int i = 0; i < 16; ++i) v[i] *= gain[k0 + 16 * kq + i];
    }
#pragma unroll
    for (int e = 0; e < 4; ++e) { bf16_t* dst = WT + (size_t)(n0 + 4 * nc + e) * K + k0 + 16 * kq;
        u32x4 w0, w1; w0.x = pk2(v[0][e], v[1][e]); w0.y = pk2(v[2][e], v[3][e]); w0.z = pk2(v[4][e], v[5][e]); w0.w = pk2(v[6][e], v[7][e]);
        w1.x = pk2(v[8][e], v[9][e]); w1.y = pk2(v[10][e], v[11][e]); w1.z = pk2(v[12][e], v[13][e]); w1.w = pk2(v[14][e], v[15][e]);
        *(u32x4*)dst = w0; *(u32x4*)(dst + 8) = w1; }
}

__device__ __forceinline__ void p0_prologue(const Params& P, LAS unsigned char* lds, int G) {
    const int tid = threadIdx.x, lane = tid & 63, wave = tid >> 6;
    unsigned char* ws = P.ws;
    const int gw = wave * G + blockIdx.x, NGW = G * 8;
    float* adap = (float*)(ws + WS_ADAP);
    for (int it = gw; it < 48 * KS_ADA; it += NGW) {
        const int nc = it % 48, ks = it / 48, n0 = nc * 256 + lane * 4;
        f32x4 a0 = {0.f, 0.f, 0.f, 0.f}, a1 = {0.f, 0.f, 0.f, 0.f};
#pragma unroll 16
        for (int kk = 0; kk < 128; ++kk) { const int k = ks * 128 + kk; const f32x4 w = *(const f32x4*)(P.w_ada + (size_t)k * NADA + n0);
            const float s0 = silu_f(P.c[k]), s1 = silu_f(P.c[DM + k]); a0 += w * s0; a1 += w * s1; }
        *(f32x4*)(adap + (size_t)(ks * 2 + 0) * NADA + n0) = a0; *(f32x4*)(adap + (size_t)(ks * 2 + 1) * NADA + n0) = a1;
    }
    constexpr int I_IN = 32 * 64, I_UQ = 8 * 24, I_UK = 4 * 16, I_UV = 4 * 16, I_OUT = 32 * 32, I_GU = 32 * 176, I_D = 88 * 32;
    constexpr int NITEMS = I_IN + I_UQ + I_UK + I_UV + I_OUT + I_GU + I_D;
    for (int it = gw; it < NITEMS; it += NGW) {
        int r = it;
        if (r < I_IN) { transpose_item(MapIn{P.w_in}, nullptr, 2048, (bf16_t*)(ws + WS_WIN), r, 64, lane); continue; } r -= I_IN;
        if (r < I_UQ) { transpose_item(MapUq{P.w_uq}, P.g_q, 512, (bf16_t*)(ws + WS_WUQ), r, 24, lane); continue; } r -= I_UQ;
        if (r < I_UK) { transpose_item(MapId{P.w_uk, 1024}, P.g_kv, 256, (bf16_t*)(ws + WS_WUK), r, 16, lane); continue; } r -= I_UK;
        if (r < I_UV) { transpose_item(MapId{P.w_uv, 1024}, P.g_kv, 256, (bf16_t*)(ws + WS_WUV), r, 16, lane); continue; } r -= I_UV;
        if (r < I_OUT) { transpose_item(MapId{P.w_out, 2048}, nullptr, 2048, (bf16_t*)(ws + WS_WOUT), r, 32, lane); continue; } r -= I_OUT;
        if (r < I_GU) { transpose_item(MapGU{P.w_fg, P.w_fu}, nullptr, 2048, (bf16_t*)(ws + WS_WGU), r, 176, lane); continue; } r -= I_GU;
        transpose_item(MapId{P.w_fd, 2048}, nullptr, DFF, (bf16_t*)(ws + WS_WD), r, 32, lane);
    }
    float* cs = (float*)(ws + WS_CS);
    for (int idx = blockIdx.x * NTHREADS + tid; idx < M * 32; idx += G * NTHREADS) {
        const int m = idx >> 5, i = idx & 31; const double rev = (double)P.pos[m] * INVF_REV[i]; const float fr = (float)(rev - floor(rev));
        cs[2 * idx] = __builtin_amdgcn_cosf(fr); cs[2 * idx + 1] = __builtin_amdgcn_sinf(fr);
    }
}

__device__ __forceinline__ void p1_rows(const Params& P, LAS unsigned char* lds, int G) {
    const int tid = threadIdx.x, lane = tid & 63, wave = tid >> 6;
    const float* adap = (const float*)(P.ws + WS_ADAP); float* ada = (float*)(P.ws + WS_ADA);
    LAS float* TA = (LAS float*)lds;
    LAS float* TC = TA + 2 * DM;
    for (int idx = tid; idx < 2 * DM; idx += NTHREADS) { const int b = idx >> 11, col = idx & (DM - 1);
        float sh = P.b_ada[col], sc = P.b_ada[DM + col];
        for (int ks = 0; ks < KS_ADA; ++ks) { sh += adap[(size_t)(ks * 2 + b) * NADA + col]; sc += adap[(size_t)(ks * 2 + b) * NADA + DM + col]; }
        TA[idx] = P.g_pre_mix[col] * (1.0f + sc); TC[idx] = sh; }
    for (int idx = blockIdx.x * NTHREADS + tid; idx < 2 * NADA; idx += G * NTHREADS) { const int b = idx / NADA, n = idx % NADA; float v = P.b_ada[n];
        for (int ks = 0; ks < KS_ADA; ++ks) v += adap[(size_t)(ks * 2 + b) * NADA + n];
        ada[idx] = v; }
    __syncthreads();
    bf16_t* XN = (bf16_t*)(P.ws + WS_XN);
    for (int m = blockIdx.x * 8 + wave; m < M; m += G * 8) {
        const int b = m >> 13; const f32x4* xr = (const f32x4*)(P.x + (size_t)m * DM) + lane;
        f32x4 v[8]; float ss = 0.f;
#pragma unroll
        for (int j = 0; j < 8; ++j) { v[j] = xr[64 * j]; ss += (v[j][0] * v[j][0] + v[j][1] * v[j][1]) + (v[j][2] * v[j][2] + v[j][3] * v[j][3]); }
        const float rstd = rsqrtf(wave_sum(ss) * (1.0f / DM) + RMS_EPS);
        u32x2* o = (u32x2*)(XN + (size_t)m * DM) + lane;
#pragma unroll
        for (int j = 0; j < 8; ++j) { const f32x4 a = *(const LAS f32x4*)(TA + b * DM + 256 * j + 4 * lane), c = *(const LAS f32x4*)(TC + b * DM + 256 * j + 4 * lane);
            const f32x4 h = v[j] * rstd * a + c; u32x2 w; w.x = pk2(h[0], h[1]); w.y = pk2(h[2], h[3]); o[64 * j] = w; }
    }
}
__device__ __forceinline__ void p2b_rows(const Params& P, int G) {
    const int tid = threadIdx.x, lane = tid & 63, wave = tid >> 6;
    const bf16_t* Z = (const bf16_t*)P.out; bf16_t* CQN = (bf16_t*)(P.ws + WS_CQN); bf16_t* CKVN = (bf16_t*)(P.ws + WS_CKVN);
    const float* cs = (const float*)(P.ws + WS_CS); bf16_t* KR = (bf16_t*)(P.ws + WS_KROPE);
    for (int m = blockIdx.x * 8 + wave; m < M; m += G * 8) {
        const bf16_t* zr = Z + (size_t)m * ZC;
        const u32x4 a = *(const u32x4*)(zr + ZO_CQ + 8 * lane); const u32x2 k = *(const u32x2*)(zr + ZO_CKV + 4 * lane);
        float s1 = 0.f, s2 = 0.f;
#pragma unroll
        for (int e = 0; e < 4; ++e) { const float lo = __uint_as_float(a[e] << 16), hi = __uint_as_float(a[e] & 0xffff0000u); s1 += lo * lo + hi * hi; }
#pragma unroll
        for (int e = 0; e < 2; ++e) { const float lo = __uint_as_float(k[e] << 16), hi = __uint_as_float(k[e] & 0xffff0000u); s2 += lo * lo + hi * hi; }
        s1 = wave_sum(s1); s2 = wave_sum(s2);
        const float r1 = rsqrtf(s1 * (1.0f / 512.0f) + RMS_EPS), r2 = rsqrtf(s2 * (1.0f / 256.0f) + RMS_EPS);
        { u32x4 w;
#pragma unroll
          for (int e = 0; e < 4; ++e) w[e] = pk2(__uint_as_float(a[e] << 16) * r1, __uint_as_float(a[e] & 0xffff0000u) * r1);
          *(u32x4*)(CQN + (size_t)m * 512 + 8 * lane) = w;
          u32x2 w2;
#pragma unroll
          for (int e = 0; e < 2; ++e) w2[e] = pk2(__uint_as_float(k[e] << 16) * r2, __uint_as_float(k[e] & 0xffff0000u) * r2);
          *(u32x2*)(CKVN + (size_t)m * 256 + 4 * lane) = w2; }
        if (lane < 32) { const float x1 = bf2f(zr[ZO_KR + lane]), x2 = bf2f(zr[ZO_KR + 32 + lane]); const float c = cs[(size_t)m * 64 + 2 * lane], s = cs[(size_t)m * 64 + 2 * lane + 1];
            KR[(size_t)m * 64 + lane] = f2bf(x1 * c - x2 * s); KR[(size_t)m * 64 + 32 + lane] = f2bf(x2 * c + x1 * s); }
    }
}
__device__ __forceinline__ void p7_rows(const Params& P, LAS unsigned char* lds, int G) {
    const int tid = threadIdx.x, lane = tid & 63, wave = tid >> 6;
    const float* ada = (const float*)(P.ws + WS_ADA);
    LAS float* TA = (LAS float*)lds; LAS float* TB = TA + 2 * DM; LAS float* TC = TB + 2 * DM;
    for (int idx = tid; idx < 2 * DM; idx += NTHREADS) { const int b = idx >> 11, col = idx & (DM - 1); const float* ab = ada + (size_t)b * NADA;
        TA[idx] = ab[2 * DM + col] * P.g_post_mix[col]; TB[idx] = P.g_pre_ffn[col] * (1.0f + ab[4 * DM + col]); TC[idx] = ab[3 * DM + col]; }
    __syncthreads();
    const bf16_t* O = (const bf16_t*)(P.ws + WS_O); bf16_t* XN = (bf16_t*)(P.ws + WS_XN);
    for (int m = blockIdx.x * 8 + wave; m < M; m += G * 8) {
        const int b = m >> 13; const f32x4* xr = (const f32x4*)(P.x + (size_t)m * DM) + lane; const u32x2* orow = (const u32x2*)(O + (size_t)m * DM) + lane;
        f32x4 v[8]; float ss = 0.f;
#pragma unroll
        for (int j = 0; j < 8; ++j) { const u32x2 w = orow[64 * j]; v[j][0] = __uint_as_float(w.x << 16); v[j][1] = __uint_as_float(w.x & 0xffff0000u); v[j][2] = __uint_as_float(w.y << 16); v[j][3] = __uint_as_float(w.y & 0xffff0000u);
            ss += (v[j][0] * v[j][0] + v[j][1] * v[j][1]) + (v[j][2] * v[j][2] + v[j][3] * v[j][3]); }
        const float rstd = rsqrtf(wave_sum(ss) * (1.0f / DM) + RMS_EPS);
        float s2 = 0.f; f32x4* outr = (f32x4*)(P.out + (size_t)m * DM) + lane;
#pragma unroll
        for (int j = 0; j < 8; ++j) { const f32x4 a = *(const LAS f32x4*)(TA + b * DM + 256 * j + 4 * lane); const f32x4 x1 = xr[64 * j] + v[j] * rstd * a; v[j] = x1; outr[64 * j] = x1;
            s2 += (x1[0] * x1[0] + x1[1] * x1[1]) + (x1[2] * x1[2] + x1[3] * x1[3]); }
        const float rstd2 = rsqrtf(wave_sum(s2) * (1.0f / DM) + RMS_EPS);
        u32x2* o = (u32x2*)(XN + (size_t)m * DM) + lane;
#pragma unroll
        for (int j = 0; j < 8; ++j) { const f32x4 a = *(const LAS f32x4*)(TB + b * DM + 256 * j + 4 * lane), c = *(const LAS f32x4*)(TC + b * DM + 256 * j + 4 * lane);
            const f32x4 h = v[j] * rstd2 * a + c; u32x2 w; w.x = pk2(h[0], h[1]); w.y = pk2(h[2], h[3]); o[64 * j] = w; }
    }
}
__device__ __forceinline__ void p10_rows(const Params& P, LAS unsigned char* lds, int G) {
    const int tid = threadIdx.x, lane = tid & 63, wave = tid >> 6;
    const float* ada = (const float*)(P.ws + WS_ADA);
    LAS float* TA = (LAS float*)lds;
    for (int idx = tid; idx < 2 * DM; idx += NTHREADS) { const int b = idx >> 11, col = idx & (DM - 1); TA[idx] = ada[(size_t)b * NADA + 5 * DM + col] * P.g_post_ffn[col]; }
    __syncthreads();
    const bf16_t* F = (const bf16_t*)(P.ws + WS_O);
    for (int m = blockIdx.x * 8 + wave; m < M; m += G * 8) {
        const int b = m >> 13; const u32x2* fr = (const u32x2*)(F + (size_t)m * DM) + lane; f32x4* outr = (f32x4*)(P.out + (size_t)m * DM) + lane;
        f32x4 v[8]; float ss = 0.f;
#pragma unroll
        for (int j = 0; j < 8; ++j) { const u32x2 w = fr[64 * j]; v[j][0] = __uint_as_float(w.x << 16); v[j][1] = __uint_as_float(w.x & 0xffff0000u); v[j][2] = __uint_as_float(w.y << 16); v[j][3] = __uint_as_float(w.y & 0xffff0000u);
            ss += (v[j][0] * v[j][0] + v[j][1] * v[j][1]) + (v[j][2] * v[j][2] + v[j][3] * v[j][3]); }
        const float rstd = rsqrtf(wave_sum(ss) * (1.0f / DM) + RMS_EPS);
#pragma unroll
        for (int j = 0; j < 8; ++j) { const f32x4 a = *(const LAS f32x4*)(TA + b * DM + 256 * j + 4 * lane); outr[64 * j] = outr[64 * j] + v[j] * rstd * a; }
    }
}
constexpr int G1_AG = 0, G1_SEG = 4096, G1_QD = 8192, G1_KI = G1_QD + 64 * 272, G1_KDT = G1_KI + 64 * 272, G1_VT = G1_KDT + 128 * 144, G1_AT = G1_VT + 256 * 144, G1_END = G1_AT + 64 * 144;
static_assert(G1_END <= 131072, "G1 LDS");
__device__ __forceinline__ void gla_intra_unit(const Params& P, LAS unsigned char* lds, int unit) {
    const int tid = threadIdx.x, lane = tid & 63, wid = tid >> 6, fr = lane & 15, fq = lane >> 4;
    const int bh = unit >> 7, n = unit & 127, b = bh >> 2, h = bh & 3;
    const size_t t0 = (size_t)b * SEQ + 64 * n;
    const bf16_t* Z = (const bf16_t*)P.out;
    LAS float* ag = (LAS float*)(lds + G1_AG); LAS float* seg = (LAS float*)(lds + G1_SEG);
    LAS bf16_t* qd = (LAS bf16_t*)(lds + G1_QD); LAS bf16_t* ki = (LAS bf16_t*)(lds + G1_KI); LAS bf16_t* kdT = (LAS bf16_t*)(lds + G1_KDT);
    LAS bf16_t* vT = (LAS bf16_t*)(lds + G1_VT); LAS bf16_t* at = (LAS bf16_t*)(lds + G1_AT);
    bf16_t* qdec_g = (bf16_t*)(P.ws + WS_QDEC); float* decay_g = (float*)(P.ws + WS_DECAY); bf16_t* OI = (bf16_t*)(P.ws + WS_OI); bf16_t* DS = (bf16_t*)(P.ws + WS_XN);
    { const int idx = tid * 2, c = idx >> 4, r = idx & 15; const unsigned w = *(const unsigned*)(Z + (t0 + c) * ZC + ZO_AG + r); ag[c * 16 + r] = __uint_as_float(w << 16); ag[c * 16 + r + 1] = __uint_as_float(w & 0xffff0000u); }
#pragma unroll
    for (int i = 0; i < 4; ++i) { const int id = tid + NTHREADS * i, c = id >> 5, vc = id & 31; const u32x4 w = *(const u32x4*)(Z + (t0 + c) * ZC + ZO_VG + 256 * h + 8 * vc);
#pragma unroll
        for (int e = 0; e < 4; ++e) { vT[(8 * vc + 2 * e) * 72 + c] = (bf16_t)(w[e] & 0xffffu); vT[(8 * vc + 2 * e + 1) * 72 + c] = (bf16_t)(w[e] >> 16); } }
    __syncthreads();
    { const int d = tid & 127, cgp = tid >> 7;
      float w[16];
#pragma unroll
      for (int r = 0; r < 16; ++r) w[r] = P.w_gate_up[r * 512 + 128 * h + d];
      const float bias = P.b_gate[128 * h + d];
      float bcv[16]; float run = 0.f;
#pragma unroll
      for (int i = 0; i < 16; ++i) { const int c = cgp * 16 + i; float xg = bias;
#pragma unroll
          for (int r4 = 0; r4 < 4; ++r4) { const f32x4 a = *(const LAS f32x4*)(ag + c * 16 + 4 * r4); xg += a[0] * w[4 * r4] + a[1] * w[4 * r4 + 1] + a[2] * w[4 * r4 + 2] + a[3] * w[4 * r4 + 3]; }
          const float ls = fminf(xg, 0.f) - __logf(1.0f + __expf(-fabsf(xg)));
          run += ls * (1.0f / 16.0f); bcv[i] = run; }
      seg[cgp * 128 + d] = run;
      __syncthreads();
      float off = 0.f, tot = 0.f;
#pragma unroll
      for (int g2 = 0; g2 < 4; ++g2) { const float sv = seg[g2 * 128 + d]; tot += sv; if (g2 < cgp) off += sv; }
#pragma unroll
      for (int i = 0; i < 16; ++i) { const int c = cgp * 16 + i; const float bc = bcv[i] + off;
          const float q = bf2f(Z[(t0 + c) * ZC + ZO_QG + 128 * h + d]), k = bf2f(Z[(t0 + c) * ZC + ZO_KG + 128 * h + d]);
          const bf16_t qv = f2bf(q * 0.08838834764831845f * __expf(bc));
          qd[c * 136 + d] = qv; ki[c * 136 + d] = f2bf(k * __expf(-bc)); kdT[d * 72 + c] = f2bf(k * __expf(tot - bc));
          qdec_g[((size_t)unit * 64 + c) * 128 + d] = qv; }
      if (cgp == 0) decay_g[(size_t)unit * 128 + d] = __expf(tot);
    }
    __syncthreads();
    { const int cb = wid >> 1;
#pragma unroll
      for (int jj = 0; jj < 2; ++jj) { const int jb = (wid & 1) * 2 + jj; f32x4 acc = {0.f, 0.f, 0.f, 0.f};
          if (jb <= cb) {
#pragma unroll
              for (int ks = 0; ks < 4; ++ks) { const bf16x8 a = *(const LAS bf16x8*)(qd + (16 * cb + fr) * 136 + 32 * ks + 8 * fq), bb = *(const LAS bf16x8*)(ki + (16 * jb + fr) * 136 + 32 * ks + 8 * fq); acc = MFMA16(a, bb, acc); } }
#pragma unroll
          for (int e = 0; e < 4; ++e) { const int c = 16 * cb + 4 * fq + e, j = 16 * jb + fr; at[c * 72 + j] = f2bf(j <= c ? acc[e] : 0.f); } }
    }
    __syncthreads();
#pragma unroll
    for (int vbi = 0; vbi < 2; ++vbi) { const int vb = 2 * wid + vbi;
        bf16x8 vf[2];
#pragma unroll
        for (int ks = 0; ks < 2; ++ks) vf[ks] = *(const LAS bf16x8*)(vT + (16 * vb + fr) * 72 + 32 * ks + 8 * fq);
#pragma unroll
        for (int cb = 0; cb < 4; ++cb) { f32x4 acc = {0.f, 0.f, 0.f, 0.f};
#pragma unroll
            for (int ks = 0; ks < 2; ++ks) acc = MFMA16(vf[ks], *(const LAS bf16x8*)(at + (16 * cb + fr) * 72 + 32 * ks + 8 * fq), acc);
            u32x2 w; w.x = pk2(acc[0], acc[1]); w.y = pk2(acc[2], acc[3]);
            *(u32x2*)(OI + (t0 + 16 * cb + fr) * 1024 + 256 * h + 16 * vb + 4 * fq) = w; }
#pragma unroll
        for (int db = 0; db < 8; ++db) { f32x4 acc = {0.f, 0.f, 0.f, 0.f};
#pragma unroll
            for (int ks = 0; ks < 2; ++ks) acc = MFMA16(*(const LAS bf16x8*)(kdT + (16 * db + fr) * 72 + 32 * ks + 8 * fq), vf[ks], acc);
            u32x2 w; w.x = pk2(acc[0], acc[1]); w.y = pk2(acc[2], acc[3]);
            *(u32x2*)(DS + ((size_t)unit * 256 + 16 * vb + fr) * 128 + 16 * db + 4 * fq) = w; }
    }
    __syncthreads();
}
__device__ __forceinline__ void gla_scan(const Params& P, int G) {
    const bf16_t* DS = (const bf16_t*)(P.ws + WS_XN); bf16_t* ST = (bf16_t*)(P.ws + WS_ST); const float* decay_g = (const float*)(P.ws + WS_DECAY);
    for (int gid = blockIdx.x * NTHREADS + threadIdx.x; gid < 8 * 16384; gid += G * NTHREADS) {
        const int bh = gid >> 14, e2 = gid & 16383, d = (2 * e2) & 127;
        float s0 = 0.f, s1 = 0.f;
#pragma unroll 8
        for (int n = 0; n < 128; ++n) { const size_t unit = (size_t)bh * 128 + n;
            const unsigned w = *(const unsigned*)(DS + unit * 32768 + 2 * e2); const float d0 = decay_g[unit * 128 + d], d1 = decay_g[unit * 128 + d + 1];
            *(unsigned*)(ST + unit * 32768 + 2 * e2) = pk2(s0, s1);
            s0 = d0 * s0 + __uint_as_float(w << 16); s1 = d1 * s1 + __uint_as_float(w & 0xffff0000u); }
    }
}
__device__ __forceinline__ void gla_inter_unit(const Params& P, LAS unsigned char* lds, int unit) {
    const int tid = threadIdx.x, lane = tid & 63, wid = tid >> 6, fr = lane & 15, fq = lane >> 4;
    const int bh = unit >> 7, n = unit & 127, b = bh >> 2, h = bh & 3;
    const size_t t0 = (size_t)b * SEQ + 64 * n;
    const bf16_t* Z = (const bf16_t*)P.out; const bf16_t* qdec_g = (const bf16_t*)(P.ws + WS_QDEC); const bf16_t* OI = (const bf16_t*)(P.ws + WS_OI); const bf16_t* ST = (const bf16_t*)(P.ws + WS_ST);
    bf16_t* AO = (bf16_t*)(P.ws + WS_XN);
    LAS float* red = (LAS float*)lds;
    const int cb = wid & 3, vh = wid >> 2; const size_t trow = t0 + 16 * cb + fr;
    bf16x8 qf[4];
#pragma unroll
    for (int ks = 0; ks < 4; ++ks) qf[ks] = *(const bf16x8*)(qdec_g + ((size_t)unit * 64 + 16 * cb + fr) * 128 + 32 * ks + 8 * fq);
    f32x4 o[8]; float ss = 0.f;
#pragma unroll
    for (int vbi = 0; vbi < 8; ++vbi) { const int vb = vh * 8 + vbi; f32x4 acc = {0.f, 0.f, 0.f, 0.f};
#pragma unroll
        for (int ks = 0; ks < 4; ++ks) acc = MFMA16(*(const bf16x8*)(ST + ((size_t)unit * 256 + 16 * vb + fr) * 128 + 32 * ks + 8 * fq), qf[ks], acc);
        const u32x2 w = *(const u32x2*)(OI + trow * 1024 + 256 * h + 16 * vb + 4 * fq);
        acc[0] += __uint_as_float(w.x << 16); acc[1] += __uint_as_float(w.x & 0xffff0000u); acc[2] += __uint_as_float(w.y << 16); acc[3] += __uint_as_float(w.y & 0xffff0000u);
        o[vbi] = acc; ss += (acc[0] * acc[0] + acc[1] * acc[1]) + (acc[2] * acc[2] + acc[3] * acc[3]); }
    ss += __shfl_xor(ss, 16); ss += __shfl_xor(ss, 32);
    if (fq == 0) red[wid * 16 + fr] = ss;
    __syncthreads();
    const float tot = red[cb * 16 + fr] + red[(cb + 4) * 16 + fr];
    const float rstd = rsqrtf(tot * (1.0f / 256.0f) + RMS_EPS);
#pragma unroll
    for (int vbi = 0; vbi < 8; ++vbi) { const int vcol = 16 * (vh * 8 + vbi) + 4 * fq;
        const f32x4 g = *(const f32x4*)(P.g_gla + vcol); const u32x2 rw = *(const u32x2*)(Z + trow * ZC + ZO_RG + 256 * h + vcol);
        const float r0 = __uint_as_float(rw.x << 16), r1 = __uint_as_float(rw.x & 0xffff0000u), r2 = __uint_as_float(rw.y << 16), r3 = __uint_as_float(rw.y & 0xffff0000u);
        u32x2 w; w.x = pk2(o[vbi][0] * rstd * g[0] * silu_f(r0), o[vbi][1] * rstd * g[1] * silu_f(r1)); w.y = pk2(o[vbi][2] * rstd * g[2] * silu_f(r2), o[vbi][3] * rstd * g[3] * silu_f(r3));
        *(u32x2*)(AO + trow * DM + 1024 + 256 * h + vcol) = w; }
    __syncthreads();
}

constexpr int AT_KB = 64 * 400, AT_VB = 128 * 144, AT_BUF = AT_KB + AT_VB;
constexpr float AT_THR = 8.0f;
#ifndef AT_SCHED
#define AT_SCHED
#endif
__device__ __forceinline__ void attn_unit(const Params& P, LAS unsigned char* lds, int bh, int qb) {
    const int tid = threadIdx.x, lane = tid & 63, wid = __builtin_amdgcn_readfirstlane(tid >> 6), fr = lane & 15, fq = lane >> 4;
    const int b = bh >> 3, h = bh & 7; const size_t rowb = (size_t)b * SEQ; const int q0 = qb * 256 + wid * 32;
    const bf16_t* Q = (const bf16_t*)(P.ws + WS_Q); const bf16_t* KN = (const bf16_t*)(P.ws + WS_KN); const bf16_t* KR = (const bf16_t*)(P.ws + WS_KROPE); const bf16_t* VT = (const bf16_t*)(P.ws + WS_VT);
    bf16_t* AO = (bf16_t*)(P.ws + WS_XN);
    bf16x8 qf[6][2];
#pragma unroll
    for (int qk = 0; qk < 2; ++qk) { const bf16_t* qp = Q + (rowb + q0 + 16 * qk + fr) * QC;
#pragma unroll
        for (int ks = 0; ks < 4; ++ks) qf[ks][qk] = *(const bf16x8*)(qp + 128 * h + 32 * ks + 8 * fq);
        qf[4][qk] = *(const bf16x8*)(qp + 1024 + (h >> 2) * 256 + (h & 3) * 32 + 8 * fq); qf[5][qk] = *(const bf16x8*)(qp + 1024 + (h >> 2) * 256 + 128 + (h & 3) * 32 + 8 * fq); }
    const int NT = (qb + 1) * 4;
    const bf16_t* KNh = KN + rowb * 1024 + 128 * h; const bf16_t* KRb = KR + rowb * 64; const bf16_t* VTh = VT + (size_t)(128 * h) * M + rowb;
#define AT_DMA(t, buf) do { int ln_ = lane; asm volatile("" : "+v"(ln_)); \
        _Pragma("unroll") for (int j_ = 0; j_ < 6; ++j_) { const int c_ = wid + 8 * j_; if (c_ < 43) { const int L_ = 1024 * c_ + 16 * ln_; const bf16_t* src_; \
            if (L_ < AT_KB) { const int row_ = L_ / 400, cb_ = L_ - row_ * 400; int pc_ = cb_ >> 4; if (pc_ >= 24) pc_ = 0; const size_t r_ = (size_t)(64 * (t) + row_); \
                src_ = (pc_ < 16) ? (KNh + r_ * 1024 + 8 * pc_) : (KRb + r_ * 64 + 8 * (pc_ - 16)); } \
            else { const int L2_ = L_ - AT_KB, dv_ = L2_ / 144, cb_ = L2_ - dv_ * 144; int pc_ = cb_ >> 4; if (pc_ >= 8) pc_ = 0; src_ = VTh + (size_t)dv_ * M + 64 * (t) + 8 * pc_; } \
            __builtin_amdgcn_global_load_lds((const unsigned*)src_, (LAS unsigned*)(lds + (buf) * AT_BUF + 1024 * c_), 16, 0, 0); } } } while (0)
    float mrow[2] = {-1e30f, -1e30f}, lrow[2] = {0.f, 0.f};
    f32x4 o[8][2];
#pragma unroll
    for (int dvb = 0; dvb < 8; ++dvb) { o[dvb][0] = (f32x4){0.f, 0.f, 0.f, 0.f}; o[dvb][1] = (f32x4){0.f, 0.f, 0.f, 0.f}; }
    AT_DMA(0, 0);
    asm volatile("s_waitcnt vmcnt(0)" ::: "memory"); __syncthreads();
#pragma clang loop unroll(disable)
    for (int t = 0; t < NT; ++t) {
        const int buf = t & 1; const bool more = (t + 1 < NT);
        if (more) AT_DMA(t + 1, buf ^ 1);
        const LAS unsigned char* Kl = lds + buf * AT_BUF; const LAS unsigned char* Vl = Kl + AT_KB;
        const int k0 = 64 * t;
        if (k0 <= q0) {
            f32x4 s[4][2];
#pragma unroll
            for (int kvb = 0; kvb < 4; ++kvb) { s[kvb][0] = (f32x4){0.f, 0.f, 0.f, 0.f}; s[kvb][1] = (f32x4){0.f, 0.f, 0.f, 0.f}; }
#pragma unroll
            for (int ks = 0; ks < 6; ++ks) {
#pragma unroll
                for (int kvb = 0; kvb < 4; ++kvb) { const bf16x8 kf = *(const LAS bf16x8*)(Kl + (16 * kvb + fr) * 400 + 64 * ks + 16 * fq);
                    s[kvb][0] = MFMA16(kf, qf[ks][0], s[kvb][0]); s[kvb][1] = MFMA16(kf, qf[ks][1], s[kvb][1]); }
                AT_SCHED;
            }
            if (k0 + 63 > q0) {
#pragma unroll
                for (int kvb = 0; kvb < 4; ++kvb)
#pragma unroll
                    for (int qk = 0; qk < 2; ++qk)
#pragma unroll
                        for (int e = 0; e < 4; ++e) { const int kv = k0 + 16 * kvb + 4 * fq + e, q = q0 + 16 * qk + fr; if (kv > q) s[kvb][qk][e] = -INFINITY; }
            }
            float mx[2];
#pragma unroll
            for (int qk = 0; qk < 2; ++qk) { float m_ = fmaxf(fmaxf(s[0][qk][0], s[0][qk][1]), fmaxf(s[0][qk][2], s[0][qk][3]));
#pragma unroll
                for (int kvb = 1; kvb < 4; ++kvb) m_ = fmaxf(m_, fmaxf(fmaxf(s[kvb][qk][0], s[kvb][qk][1]), fmaxf(s[kvb][qk][2], s[kvb][qk][3])));
                m_ = fmaxf(m_, __shfl_xor(m_, 16)); m_ = fmaxf(m_, __shfl_xor(m_, 32)); mx[qk] = m_; }
            if (__any((mx[0] > mrow[0] + AT_THR) || (mx[1] > mrow[1] + AT_THR))) {
#pragma unroll
                for (int qk = 0; qk < 2; ++qk) { const float mn = fmaxf(mrow[qk], mx[qk]), alpha = __builtin_amdgcn_exp2f(mrow[qk] - mn); mrow[qk] = mn; lrow[qk] *= alpha;
#pragma unroll
                    for (int dvb = 0; dvb < 8; ++dvb) o[dvb][qk] *= alpha; }
            }
            bf16x8 pf[2][2];
#pragma unroll
            for (int qk = 0; qk < 2; ++qk) { float ps = 0.f; const float mn = mrow[qk];
#pragma unroll
                for (int kvb = 0; kvb < 4; ++kvb)
#pragma unroll
                    for (int e = 0; e < 4; ++e) { const float p = __builtin_amdgcn_exp2f(s[kvb][qk][e] - mn); s[kvb][qk][e] = p; ps += p; }
                lrow[qk] += ps;
#pragma unroll
                for (int s2 = 0; s2 < 2; ++s2) { u32x4 w; w.x = pk2(s[2 * s2][qk][0], s[2 * s2][qk][1]); w.y = pk2(s[2 * s2][qk][2], s[2 * s2][qk][3]);
                    w.z = pk2(s[2 * s2 + 1][qk][0], s[2 * s2 + 1][qk][1]); w.w = pk2(s[2 * s2 + 1][qk][2], s[2 * s2 + 1][qk][3]); pf[s2][qk] = __builtin_bit_cast(bf16x8, w); } }
#pragma unroll
            for (int s2 = 0; s2 < 2; ++s2) {
#pragma unroll
                for (int dvb = 0; dvb < 8; ++dvb) { const LAS unsigned char* vp = Vl + (16 * dvb + fr) * 144 + (32 * s2 + 4 * fq) * 2;
                    const u32x2 lo = *(const LAS u32x2*)vp, hi = *(const LAS u32x2*)(vp + 32);
                    u32x4 w; w.x = lo.x; w.y = lo.y; w.z = hi.x; w.w = hi.y; const bf16x8 vf = __builtin_bit_cast(bf16x8, w);
                    o[dvb][0] = MFMA16(vf, pf[s2][0], o[dvb][0]); o[dvb][1] = MFMA16(vf, pf[s2][1], o[dvb][1]); }
                AT_SCHED;
            }
        }
        asm volatile("s_waitcnt vmcnt(0)" ::: "memory"); __syncthreads();
    }
#pragma unroll
    for (int qk = 0; qk < 2; ++qk) { float l = lrow[qk]; l += __shfl_xor(l, 16); l += __shfl_xor(l, 32); const float rl = 1.0f / l;
        bf16_t* op = AO + (rowb + q0 + 16 * qk + fr) * DM + 128 * h + 4 * fq;
#pragma unroll
        for (int dvb = 0; dvb < 8; ++dvb) { u32x2 w; w.x = pk2(o[dvb][qk][0] * rl, o[dvb][qk][1] * rl); w.y = pk2(o[dvb][qk][2] * rl, o[dvb][qk][3] * rl); *(u32x2*)(op + 16 * dvb) = w; } }
#undef AT_DMA
}

#ifndef PHASES
#define PHASES 0xFFFF
#endif
#define PH(k) ((PHASES >> (k)) & 1)
#ifndef REP_ATT
#define REP_ATT 1
#endif
#ifndef REP_P0
#define REP_P0 1
#endif
#ifndef REP_GLA
#define REP_GLA 1
#endif
__global__ void __launch_bounds__(NTHREADS, 2) hybrid_block_fwd(Params P) {
    extern __shared__ __attribute__((aligned(16))) unsigned char lds_raw[];
    LAS unsigned char* lds = (LAS unsigned char*)lds_raw;
    cg::grid_group grid = cg::this_grid();
    const int G = gridDim.x, bx = blockIdx.x;
    unsigned char* ws = P.ws;
    bf16_t* Zb = (bf16_t*)P.out;
    if (PH(0)) for (int rep = 0; rep < REP_P0; ++rep) p0_prologue(P, lds, G);
    grid.sync();
    if (PH(1)) p1_rows(P, lds, G);
    grid.sync();
    if (PH(2)) { pg8::Gemm g{(const bf16_t*)(ws + WS_XN), (const bf16_t*)(ws + WS_WIN), M, ZC, DM, DM, DM}; pg8::StaticOrder S; S.init(M, ZC, G, bx);
      pg8::EpiPlain E{Zb, ZC}; pg8::gemm_phase<pg8::EpiPlain, pg8::StaticOrder, true, true>(lds, g, S, E); }
    grid.sync();
    if (PH(3)) p2b_rows(P, G);
    grid.sync();
    if (PH(4)) { pg8::Gemm g{(const bf16_t*)(ws + WS_CQN), (const bf16_t*)(ws + WS_WUQ), M, QC, 512, 512, 512}; pg8::StaticOrder S; S.init(M, QC, G, bx);
      pg8::EpiRowScaleRope E{(bf16_t*)(ws + WS_Q), QC, QSCALE, 4, (const float*)(ws + WS_CS)};
      pg8::gemm_phase<pg8::EpiRowScaleRope, pg8::StaticOrder, true, true>(lds, g, S, E); }
    if (PH(5)) { pg8::Gemm g{(const bf16_t*)(ws + WS_CKVN), (const bf16_t*)(ws + WS_WUK), M, 1024, 256, 256, 256}; pg8::StaticOrder S; S.init(M, 1024, G, bx);
      pg8::EpiPlain E{(bf16_t*)(ws + WS_KN), 1024}; pg8::gemm_phase<pg8::EpiPlain, pg8::StaticOrder, true, true>(lds, g, S, E); }
    if (PH(6)) { pg8::Gemm g{(const bf16_t*)(ws + WS_WUV), (const bf16_t*)(ws + WS_CKVN), 1024, M, 256, 256, 256}; pg8::StaticOrder S; S.init(1024, M, G, bx);
      pg8::EpiPlain E{(bf16_t*)(ws + WS_VT), M}; pg8::gemm_phase<pg8::EpiPlain, pg8::StaticOrder, true, true>(lds, g, S, E); }
    if (PH(7)) for (int rep = 0; rep < REP_GLA; ++rep) for (int u = bx; u < 1024; u += G) gla_intra_unit(P, lds, u);
    grid.sync();
    if (PH(8)) gla_scan(P, G);
    grid.sync();
    if (PH(9)) for (int u = bx; u < 1024; u += G) gla_inter_unit(P, lds, u);
    if (PH(10)) { const int vcu = (G % 8 == 0) ? (bx % 8) * (G / 8) + bx / 8 : bx;
      for (int rep = 0; rep < REP_ATT; ++rep) for (int p2 = 2 * vcu; p2 < 512; p2 += 2 * G) {
#pragma clang loop unroll(disable)
          for (int i2 = 0; i2 < 2; ++i2) { const int p = p2 >> 1, bh = p >> 4, s = p & 15; attn_unit(P, lds, bh, i2 ? s : 31 - s); } } }
    grid.sync();
    if (PH(11)) { pg8::Gemm g{(const bf16_t*)(ws + WS_XN), (const bf16_t*)(ws + WS_WOUT), M, DM, DM, DM, DM}; pg8::StaticOrder S; S.init(M, DM, G, bx);
      pg8::EpiPlain E{(bf16_t*)(ws + WS_O), DM}; pg8::gemm_phase<pg8::EpiPlain, pg8::StaticOrder, true, true>(lds, g, S, E); }
    grid.sync();
    if (PH(12)) p7_rows(P, lds, G);
    grid.sync();
    if (PH(13)) { pg8::Gemm g{(const bf16_t*)(ws + WS_XN), (const bf16_t*)(ws + WS_WGU), M, 2 * DFF, DM, DM, DM}; pg8::StaticOrder S; S.init(M, 2 * DFF, G, bx);
      pg8::EpiSwiGLU E{(bf16_t*)(ws + WS_ACT), DFF}; pg8::gemm_phase<pg8::EpiSwiGLU, pg8::StaticOrder, true, true>(lds, g, S, E); }
    grid.sync();
    if (PH(14)) { pg8::Gemm g{(const bf16_t*)(ws + WS_ACT), (const bf16_t*)(ws + WS_WD), M, DM, DFF, DFF, DFF}; pg8::StaticOrder S; S.init(M, DM, G, bx);
      pg8::EpiPlain E{(bf16_t*)(ws + WS_O), DM}; pg8::gemm_phase<pg8::EpiPlain, pg8::StaticOrder, true, true>(lds, g, S, E); }
    grid.sync();
    if (PH(15)) p10_rows(P, lds, G);
}

extern "C" void kernel_launch(void* const* d_in, const int* in_sizes, int n_in, void* d_out, int out_size, void* d_ws, size_t ws_size, hipStream_t stream) {
    static int grid = 0;
    if (grid == 0) {
        if (n_in != 22 || in_sizes[0] != M * DM || out_size != M * DM || ws_size < WS_END) { fprintf(stderr, "kernel_launch: unexpected shapes (n_in %d, in0 %d, out %d, ws %zu)\n", n_in, n_in > 0 ? in_sizes[0] : -1, out_size, ws_size); grid = -1; return; }
        int dev = 0, cus = 0, per_cu = 0;
        (void)hipGetDevice(&dev); (void)hipDeviceGetAttribute(&cus, hipDeviceAttributeMultiprocessorCount, dev);
        if (hipFuncSetAttribute((const void*)hybrid_block_fwd, hipFuncAttributeMaxDynamicSharedMemorySize, LDS_BYTES) != hipSuccess) { fprintf(stderr, "kernel_launch: hipFuncSetAttribute failed\n"); grid = -1; return; }
        if (hipOccupancyMaxActiveBlocksPerMultiprocessor(&per_cu, (const void*)hybrid_block_fwd, NTHREADS, LDS_BYTES) != hipSuccess || per_cu < 1) { fprintf(stderr, "kernel_launch: occupancy query failed (%d)\n", per_cu); (void)hipGetLastError(); grid = -1; return; }
        grid = cus;
    }
    if (grid < 0) return;
    Params p{};
    const float* const* fin = (const float* const*)d_in;
    p.x = fin[0]; p.c = fin[1]; p.pos = (const int*)d_in[2]; p.w_ada = fin[3]; p.b_ada = fin[4]; p.g_pre_mix = fin[5]; p.g_post_mix = fin[6]; p.w_in = fin[7]; p.g_q = fin[8]; p.w_uq = fin[9];
    p.g_kv = fin[10]; p.w_uk = fin[11]; p.w_uv = fin[12]; p.w_gate_up = fin[13]; p.b_gate = fin[14]; p.g_gla = fin[15]; p.w_out = fin[16]; p.g_pre_ffn = fin[17]; p.g_post_ffn = fin[18];
    p.w_fg = fin[19]; p.w_fu = fin[20]; p.w_fd = fin[21]; p.out = (float*)d_out; p.ws = (unsigned char*)d_ws;
    void* args[] = {&p};
    hipError_t e = hipLaunchCooperativeKernel((const void*)hybrid_block_fwd, dim3(grid), dim3(NTHREADS), args, LDS_BYTES, stream);
    if (e != hipSuccess) fprintf(stderr, "cooperative launch failed: %s (grid %d)\n", hipGetErrorString(e), grid);
}
```

```cpp
#define P3_SP2 false
#include <hip/hip_runtime.h>
#include <hip/hip_cooperative_groups.h>
#include <cstdio>
#include <cstdint>
#include <cmath>
namespace cg = cooperative_groups;
namespace pg8 {
#define PG8_LAS __attribute__((address_space(3)))
typedef unsigned short bf16_t;
typedef short bf16x8 __attribute__((ext_vector_type(8)));
typedef float f32x4 __attribute__((ext_vector_type(4)));
typedef unsigned u32x4 __attribute__((ext_vector_type(4)));
constexpr int BM = 256, BK = 64, HALF = 128, HTB = HALF * BK * 2  , STAGE_BYTES = 8 * HTB, NXCD = 8, WGM = 8;

__host__ __device__ __forceinline__ int lds_byte(int r, int c) { const int st = (r >> 4) * 2 + (c >> 5), rr = r & 15, cc = c & 31, ob = rr * 64 + cc * 2; return st * 1024 + (ob ^ (((ob >> 9) & 1) << 5)); }
__host__ __device__ __forceinline__ void stage_rc(int b, int& R, int& C) { const int st = b / 1024, sb = b % 1024, swz = sb ^ (((sb >> 9) & 1) << 5); R = (st >> 1) * 16 + swz / 64; C = (st & 1) * 32 + (swz % 64) / 2; }
__host__ __device__ __forceinline__ int perm32(int rho) { const int n = rho >> 4, i = rho & 15; return 8 * (i >> 2) + 4 * n + (i & 3); }

struct Unit { int pm, pn; };
struct Gemm { const bf16_t* A; const bf16_t* Bt; int M, N, K, lda, ldb; };

struct StaticOrder {
    int nM, nN, nwg, G, c;
    __host__ __device__ void init(int M, int N, int G_, int c_) { nM = M / BM; nN = N / BM; nwg = nM * nN; G = G_; c = c_; }
    __host__ __device__ bool next(int i, Unit& u) const {
        const long L = (long)i * G + c; if (L >= nwg) return false;
        int wgid = (int)L; { const int q = nwg / NXCD, r = nwg % NXCD, xcd = wgid % NXCD, off = wgid / NXCD; wgid = (xcd < r ? xcd * (q + 1) : r * (q + 1) + (xcd - r) * q) + off; }
        const int nig = WGM * nN, gid = wgid / nig, fm = gid * WGM, gsz = (nM - fm) < WGM ? (nM - fm) : WGM;
        u.pm = fm + ((wgid % nig) % gsz); u.pn = (wgid % nig) / gsz; return true;
    }
    __device__ __forceinline__ void a_ready(const Unit&) const {}
    __device__ __forceinline__ void done(const Unit&) const {}
};

__device__ __forceinline__ unsigned cvt_pk_bf16(float lo, float hi) { unsigned r; asm volatile("v_cvt_pk_bf16_f32 %0, %1, %2" : "=v"(r) : "v"(lo), "v"(hi)); return r; }
typedef float f32x2 __attribute__((ext_vector_type(2)));
template <class Epi, class Sched, bool ALIGN_EPI = false, bool SP2 = false>
__device__ __forceinline__ void gemm_phase(PG8_LAS unsigned char* lds, const Gemm g, const Sched& S, const Epi& E) {
    int tid_ = threadIdx.x; asm volatile("" : "+v"(tid_)); const int tid = tid_, wid = __builtin_amdgcn_readfirstlane(tid >> 6), lane = tid & 63, wr = wid >> 2, wc = wid & 3, fr = lane & 15, fq = lane >> 4;
    const int K = g.K, nt = K / BK;
    unsigned voffA[2], voffB[2];
#pragma unroll
    for (int i = 0; i < 2; ++i) { int R, C; stage_rc(tid * 16 + i * 8192, R, C); const int Rb = Epi::PERM ? ((R & ~31) + perm32(R & 31)) : R;
        voffA[i] = (unsigned)(R * g.lda + C) * 2u; voffB[i] = (unsigned)(Rb * g.ldb + C) * 2u; }
    const size_t kstep = (size_t)(BK * 2);
    const size_t hstepA = (size_t)HALF * g.lda * 2, hstepB = (size_t)HALF * g.ldb * 2;
    const size_t tstepA = 2 * hstepA, tstepB = 2 * hstepB;
    const unsigned ldsw = (unsigned)wid * 1024u;
    const int aoff = lds_byte(wr * 64 + fr, fq * 8), boff = lds_byte(wc * 32 + fr, fq * 8);
#define PG8_SA(b, h) (((b) * 2 + (h)) * HTB)
#define PG8_SB(b, h) ((4 + (b) * 2 + (h)) * HTB)
#define PG8_STAGE(bufoff, gbase, voff) do { _Pragma("unroll") for (int _i = 0; _i < 2; ++_i) \
        __builtin_amdgcn_global_load_lds((const unsigned*)((const char*)(gbase) + (voff)[_i]), (PG8_LAS unsigned*)(lds + (bufoff) + ldsw + _i * 8192), 16, 0, 0); } while (0)
#define PG8_LDA(dst, b, h) do { _Pragma("unroll") for (int m = 0; m < 4; ++m) _Pragma("unroll") for (int k = 0; k < 2; ++k) dst[m][k] = *(const PG8_LAS bf16x8*)(lds + PG8_SA(b, h) + aoff + m * 2048 + k * 1024); } while (0)
#define PG8_LDB(dst, b, h) do { _Pragma("unroll") for (int n = 0; n < 2; ++n) _Pragma("unroll") for (int k = 0; k < 2; ++k) dst[n][k] = *(const PG8_LAS bf16x8*)(lds + PG8_SB(b, h) + boff + n * 2048 + k * 1024); } while (0)
#define PG8_MMA(ai, bj, At, Bt) do { __builtin_amdgcn_s_setprio(1); _Pragma("unroll") for (int m = 0; m < 4; ++m) _Pragma("unroll") for (int n = 0; n < 2; ++n) _Pragma("unroll") for (int k = 0; k < 2; ++k) \
        acc[ai][bj][m][n] = __builtin_amdgcn_mfma_f32_16x16x32_bf16(Bt[n][k], At[m][k], acc[ai][bj][m][n], 0, 0, 0); __builtin_amdgcn_s_setprio(0); } while (0)
#define PG8_WAIT_V(n) asm volatile("s_waitcnt vmcnt(" #n ")" ::: "memory")
#define PG8_WAIT_L(n) asm volatile("s_waitcnt lgkmcnt(" #n ")" ::: "memory")
#define PG8_BAR __builtin_amdgcn_s_barrier()
#define PG8_SCHED __builtin_amdgcn_sched_barrier(0)
    Unit cur, nxt; int ui = 0;
    if (!S.next(0, cur)) return;
    f32x4 acc[2][2][4][2];
#pragma unroll
    for (int a = 0; a < 2; ++a)
#pragma unroll
        for (int b = 0; b < 2; ++b)
#pragma unroll
            for (int m = 0; m < 4; ++m)
#pragma unroll
                for (int n = 0; n < 2; ++n) acc[a][b][m][n] = (f32x4){0.f, 0.f, 0.f, 0.f};
    bf16x8 At[4][2], B0[2][2], B1[2][2];
    const char* cA = (const char*)g.A + (size_t)cur.pm * tstepA; const char* cB = (const char*)g.Bt + (size_t)cur.pn * tstepB;
    S.a_ready(cur);
    if constexpr (SP2) {
        PG8_STAGE(PG8_SB(0, 0), cB, voffB); PG8_STAGE(PG8_SB(0, 1), cB + hstepB, voffB); PG8_STAGE(PG8_SA(0, 0), cA, voffA); PG8_STAGE(PG8_SA(0, 1), cA + hstepA, voffA);
        if (wr == 1) PG8_BAR;
        PG8_WAIT_V(2); PG8_BAR;
        PG8_STAGE(PG8_SB(1, 0), cB + kstep, voffB); PG8_STAGE(PG8_SA(1, 0), cA + kstep, voffA); PG8_STAGE(PG8_SB(1, 1), cB + hstepB + kstep, voffB);
        PG8_WAIT_V(6); PG8_BAR;
    } else {
        PG8_STAGE(PG8_SB(0, 0), cB, voffB); PG8_STAGE(PG8_SA(0, 0), cA, voffA); PG8_STAGE(PG8_SB(0, 1), cB + hstepB, voffB); PG8_STAGE(PG8_SA(0, 1), cA + hstepA, voffA);
        if (wr == 1) PG8_BAR;
        PG8_WAIT_V(4); PG8_BAR;
        PG8_STAGE(PG8_SB(1, 0), cB + kstep, voffB); PG8_STAGE(PG8_SA(1, 0), cA + kstep, voffA); PG8_STAGE(PG8_SB(1, 1), cB + hstepB + kstep, voffB);
        PG8_WAIT_V(6); PG8_BAR;
    }
    for (;;) {
        const bool has_next = S.next(ui + 1, nxt);
        const char* nA = has_next ? (const char*)g.A + (size_t)nxt.pm * tstepA : cA; const char* nB = has_next ? (const char*)g.Bt + (size_t)nxt.pn * tstepB : cB;
        for (int t = 0; t < nt; t += 2) {
            const bool last = (t == nt - 2);
            const char* a1 = cA + (size_t)(t + 1) * kstep;
            const char* a2 = last ? nA : cA + (size_t)(t + 2) * kstep; const char* b2 = last ? nB : cB + (size_t)(t + 2) * kstep;
            const char* a3 = a2 + kstep; const char* b3 = b2 + kstep;
            if (last && has_next) S.a_ready(nxt);
            if constexpr (SP2) {
            PG8_LDB(B0, 0, 0); PG8_LDB(B1, 0, 1); PG8_SCHED; PG8_LDA(At, 0, 0); PG8_STAGE(PG8_SA(1, 1), a1 + hstepA, voffA);
            PG8_WAIT_V(8); PG8_WAIT_L(0); PG8_BAR; PG8_MMA(0, 0, At, B0); PG8_MMA(0, 1, At, B1); PG8_BAR; PG8_SCHED;
            PG8_LDA(At, 0, 1); PG8_STAGE(PG8_SB(0, 0), b2, voffB); PG8_STAGE(PG8_SB(0, 1), b2 + hstepB, voffB); PG8_STAGE(PG8_SA(0, 0), a2, voffA);
            PG8_WAIT_V(8); PG8_WAIT_L(0); PG8_BAR; PG8_MMA(1, 0, At, B0); PG8_MMA(1, 1, At, B1); PG8_BAR; PG8_SCHED;
            PG8_LDB(B0, 1, 0); PG8_LDB(B1, 1, 1); PG8_SCHED; PG8_LDA(At, 1, 0); PG8_STAGE(PG8_SA(0, 1), a2 + hstepA, voffA);
            PG8_WAIT_V(8); PG8_WAIT_L(0); PG8_BAR; PG8_MMA(0, 0, At, B0); PG8_MMA(0, 1, At, B1); PG8_BAR; PG8_SCHED;
            PG8_LDA(At, 1, 1); PG8_STAGE(PG8_SB(1, 0), b3, voffB); PG8_STAGE(PG8_SB(1, 1), b3 + hstepB, voffB); PG8_STAGE(PG8_SA(1, 0), a3, voffA);
            PG8_WAIT_V(8); PG8_WAIT_L(0); PG8_BAR; PG8_MMA(1, 0, At, B0); PG8_MMA(1, 1, At, B1); PG8_BAR; PG8_SCHED;
            } else {
            PG8_LDB(B0, 0, 0); PG8_SCHED; PG8_LDA(At, 0, 0); PG8_STAGE(PG8_SA(1, 1), a1 + hstepA, voffA);
            PG8_WAIT_L(8); PG8_BAR; PG8_WAIT_L(0); PG8_MMA(0, 0, At, B0); PG8_BAR; PG8_SCHED;
            PG8_LDB(B1, 0, 1); PG8_STAGE(PG8_SB(0, 0), b2, voffB);
            PG8_BAR; PG8_WAIT_L(0); PG8_MMA(0, 1, At, B1); PG8_BAR;
            PG8_LDA(At, 0, 1); PG8_STAGE(PG8_SA(0, 0), a2, voffA);
            PG8_BAR; PG8_WAIT_L(0); PG8_MMA(1, 0, At, B0); PG8_BAR; PG8_SCHED;
            PG8_STAGE(PG8_SB(0, 1), b2 + hstepB, voffB);
            PG8_WAIT_V(6); PG8_BAR; PG8_MMA(1, 1, At, B1); PG8_BAR;
            PG8_LDB(B0, 1, 0); PG8_SCHED; PG8_LDA(At, 1, 0); PG8_STAGE(PG8_SA(0, 1), a2 + hstepA, voffA);
            PG8_WAIT_L(8); PG8_BAR; PG8_WAIT_L(0); PG8_MMA(0, 0, At, B0); PG8_BAR; PG8_SCHED;
            PG8_LDB(B1, 1, 1); PG8_STAGE(PG8_SB(1, 0), b3, voffB);
            PG8_BAR; PG8_WAIT_L(0); PG8_MMA(0, 1, At, B1); PG8_BAR;
            PG8_LDA(At, 1, 1); PG8_STAGE(PG8_SA(1, 0), a3, voffA);
            PG8_BAR; PG8_WAIT_L(0); PG8_MMA(1, 0, At, B0); PG8_BAR; PG8_SCHED;
            PG8_STAGE(PG8_SB(1, 1), b3 + hstepB, voffB);
            PG8_WAIT_V(6); PG8_BAR; PG8_MMA(1, 1, At, B1); PG8_BAR;
            }
        }
        if constexpr (ALIGN_EPI) { if (wr == 0) PG8_BAR; }
        if constexpr (!Epi::AFTER_DRAIN) { E(acc, cur, wr, wc, fr, fq); S.done(cur); }
        if (!has_next) break;
#pragma unroll
        for (int a = 0; a < 2; ++a)
#pragma unroll
            for (int b = 0; b < 2; ++b)
#pragma unroll
                for (int m = 0; m < 4; ++m)
#pragma unroll
                    for (int n = 0; n < 2; ++n) acc[a][b][m][n] = (f32x4){0.f, 0.f, 0.f, 0.f};
        cur = nxt; cA = nA; cB = nB; ++ui;
        if constexpr (ALIGN_EPI) { if (wr == 1) PG8_BAR; }
    }
    PG8_WAIT_V(0);
    if constexpr (!ALIGN_EPI) { if (wr == 0) PG8_BAR; }
    PG8_BAR;
    if constexpr (Epi::AFTER_DRAIN) { E.fused(acc, cur, wr, wc, fr, fq, lds, wid, lane); S.done(cur); }
#undef PG8_SA
#undef PG8_SB
#undef PG8_STAGE
#undef PG8_LDA
#undef PG8_LDB
#undef PG8_MMA
#undef PG8_WAIT_V
#undef PG8_WAIT_L
#undef PG8_BAR
#undef PG8_SCHED
}
}
namespace pg8 {
__device__ __forceinline__ unsigned cvtpk(float lo, float hi) { typedef float f2_t __attribute__((ext_vector_type(2))); typedef __bf16 b2_t __attribute__((ext_vector_type(2))); f2_t v = {lo, hi}; b2_t b = __builtin_convertvector(v, b2_t); return __builtin_bit_cast(unsigned, b); }
__device__ __forceinline__ u32x4 pack8(const f32x4& v0, const f32x4& v1) { u32x4 w; w.x = cvtpk(v0[0], v0[1]); w.y = cvtpk(v0[2], v0[3]); w.z = cvtpk(v1[0], v1[1]); w.w = cvtpk(v1[2], v1[3]); return w; }
struct EpiPlain {
    static constexpr bool PERM = true, AFTER_DRAIN = false;
    bf16_t* O; int ldc;
    __device__ __forceinline__ void operator()(const f32x4 (&acc)[2][2][4][2], const Unit& u, int wr, int wc, int fr, int fq) const {
        const int row0 = u.pm * BM + wr * 64 + fr, col0 = u.pn * BM + wc * 32 + 8 * fq;
#pragma unroll
        for (int ai = 0; ai < 2; ++ai)
#pragma unroll
            for (int m = 0; m < 4; ++m) { bf16_t* rowp = O + (size_t)(row0 + ai * HALF + m * 16) * ldc + col0;
#pragma unroll
                for (int bj = 0; bj < 2; ++bj) *(u32x4*)(rowp + bj * HALF) = pack8(acc[ai][bj][m][0], acc[ai][bj][m][1]); }
    }
};
struct EpiRowScaleRope {
    static constexpr bool PERM = true, AFTER_DRAIN = false;
    bf16_t* O; int ldc; float mult; int rope_pn0; const float* cs;
    __device__ __forceinline__ void operator()(const f32x4 (&acc)[2][2][4][2], const Unit& u, int wr, int wc, int fr, int fq) const {
        const int row0 = u.pm * BM + wr * 64 + fr, col0 = u.pn * BM + wc * 32 + 8 * fq;
        const bool rope = u.pn >= rope_pn0;
#pragma unroll
        for (int ai = 0; ai < 2; ++ai)
#pragma unroll
            for (int m = 0; m < 4; ++m) { const int row = row0 + ai * HALF + m * 16; const float s = mult;
                f32x4 a0 = acc[ai][0][m][0] * s, a1 = acc[ai][0][m][1] * s, b0 = acc[ai][1][m][0] * s, b1 = acc[ai][1][m][1] * s;
                if (rope) { const f32x4* cp = (const f32x4*)(cs + (size_t)row * 64 + 16 * fq);
                    const f32x4 c0 = cp[0], c1 = cp[1], c2 = cp[2], c3 = cp[3];
                    f32x4 x0, x1, y0, y1;
                    x0[0] = a0[0] * c0[0] - b0[0] * c0[1]; y0[0] = b0[0] * c0[0] + a0[0] * c0[1];
                    x0[1] = a0[1] * c0[2] - b0[1] * c0[3]; y0[1] = b0[1] * c0[2] + a0[1] * c0[3];
                    x0[2] = a0[2] * c1[0] - b0[2] * c1[1]; y0[2] = b0[2] * c1[0] + a0[2] * c1[1];
                    x0[3] = a0[3] * c1[2] - b0[3] * c1[3]; y0[3] = b0[3] * c1[2] + a0[3] * c1[3];
                    x1[0] = a1[0] * c2[0] - b1[0] * c2[1]; y1[0] = b1[0] * c2[0] + a1[0] * c2[1];
                    x1[1] = a1[1] * c2[2] - b1[1] * c2[3]; y1[1] = b1[1] * c2[2] + a1[1] * c2[3];
                    x1[2] = a1[2] * c3[0] - b1[2] * c3[1]; y1[2] = b1[2] * c3[0] + a1[2] * c3[1];
                    x1[3] = a1[3] * c3[2] - b1[3] * c3[3]; y1[3] = b1[3] * c3[2] + a1[3] * c3[3];
                    a0 = x0; a1 = x1; b0 = y0; b1 = y1; }
                bf16_t* rowp = O + (size_t)row * ldc + col0;
                *(u32x4*)(rowp) = pack8(a0, a1); *(u32x4*)(rowp + HALF) = pack8(b0, b1); }
    }
};
struct EpiColScale {
    static constexpr bool PERM = true, AFTER_DRAIN = false;
    bf16_t* O; int ldc; const float* cscale;
    __device__ __forceinline__ void operator()(const f32x4 (&acc)[2][2][4][2], const Unit& u, int wr, int wc, int fr, int fq) const {
        const int row0 = u.pm * BM + wr * 64 + fr, col0 = u.pn * BM + wc * 32 + 8 * fq;
#pragma unroll
        for (int bj = 0; bj < 2; ++bj) { const f32x4 s0 = *(const f32x4*)(cscale + col0 + bj * HALF), s1 = *(const f32x4*)(cscale + col0 + bj * HALF + 4);
#pragma unroll
            for (int ai = 0; ai < 2; ++ai)
#pragma unroll
                for (int m = 0; m < 4; ++m) *(u32x4*)(O + (size_t)(row0 + ai * HALF + m * 16) * ldc + col0 + bj * HALF) = pack8(acc[ai][bj][m][0] * s0, acc[ai][bj][m][1] * s1);
            asm volatile("" ::: "memory"); }
    }
};
struct EpiSwiGLU {
    static constexpr bool PERM = true, AFTER_DRAIN = false;
    bf16_t* O; int ldc;
    __device__ __forceinline__ void operator()(const f32x4 (&acc)[2][2][4][2], const Unit& u, int wr, int wc, int fr, int fq) const {
        const int row0 = u.pm * BM + wr * 64 + fr, col0 = u.pn * HALF + wc * 32 + 8 * fq;
#pragma unroll
        for (int ai = 0; ai < 2; ++ai)
#pragma unroll
            for (int m = 0; m < 4; ++m) { f32x4 r[2];
#pragma unroll
                for (int n = 0; n < 2; ++n) { const f32x4 g = acc[ai][0][m][n], up = acc[ai][1][m][n];
#pragma unroll
                    for (int e = 0; e < 4; ++e) r[n][e] = g[e] * __builtin_amdgcn_rcpf(1.0f + __expf(-g[e])) * up[e]; }
                *(u32x4*)(O + (size_t)(row0 + ai * HALF + m * 16) * ldc + col0) = pack8(r[0], r[1]); }
    }
};
}
#define LAS __attribute__((address_space(3)))
typedef unsigned short bf16_t;
typedef short bf16x8 __attribute__((ext_vector_type(8)));
typedef float f32x4 __attribute__((ext_vector_type(4)));
typedef unsigned u32x4 __attribute__((ext_vector_type(4)));
typedef unsigned u32x2 __attribute__((ext_vector_type(2)));
constexpr int BATCH = 2, SEQ = 8192, DM = 2048, M = BATCH * SEQ, DFF = 5632, NADA = 6 * DM;
constexpr int ZC = 4096;
constexpr int ZO_CQ = 0, ZO_CKV = 512, ZO_QG = 768, ZO_KG = 1280, ZO_VG = 1792, ZO_RG = 2816, ZO_KR = 3840, ZO_AG = 3904;
constexpr int QC = 1536;
constexpr float RMS_EPS = 1e-6f;
constexpr float QSCALE = 0.07216878364870323f * 1.4426950408889634f;
constexpr int KS_ADA = 16;
constexpr size_t MiB = 1u << 20;
constexpr size_t WS_ADAP = 0, WS_ADA = 1536 * 1024, WS_RSTDQ = 1792 * 1024, WS_RSTDKV = 1856 * 1024, WS_DECAY = 2 * MiB, WS_CS = 3 * MiB, WS_KROPE = 7 * MiB;
constexpr size_t WS_WIN = 10 * MiB, WS_WUQ = 26 * MiB, WS_WUK = 28 * MiB, WS_WUV = 29 * MiB, WS_WOUT = 30 * MiB, WS_WGU = 38 * MiB, WS_WD = 82 * MiB;
constexpr size_t WS_XN = 104 * MiB;
constexpr size_t WS_Q = 168 * MiB, WS_KN = 216 * MiB, WS_VT = 248 * MiB, WS_QDEC = 280 * MiB, WS_OI = 296 * MiB, WS_ST = 328 * MiB;
constexpr size_t WS_O = 168 * MiB;
constexpr size_t WS_ACT = 232 * MiB, WS_CQN = 392 * MiB, WS_CKVN = 408 * MiB, WS_X1 = 416 * MiB, WS_END = 480 * MiB;
constexpr size_t WS_CTL = 9 * MiB, CTL_BYTES = 65536;
constexpr int NTHREADS = 512, LDS_BYTES = 147456, MISC_OFF = 131072 + 320;

__device__ const double INVF_REV[32] = {
    1.59154943091895346e-01,
    1.19349370211248862e-01,
    8.94994016088910133e-02,
    6.71150830052272551e-02,
    5.03292121044870353e-02,
    3.77415847174197711e-02,
    2.83021958306233987e-02,
    2.12236527647776604e-02,
    1.59154943091895339e-02,
    1.19349370211248862e-02,
    8.94994016088910237e-03,
    6.71150830052272534e-03,
    5.03292121044870370e-03,
    3.77415847174197719e-03,
    2.83021958306233987e-03,
    2.12236527647776622e-03,
    1.59154943091895356e-03,
    1.19349370211248849e-03,
    8.94994016088910237e-04,
    6.71150830052272599e-04,
    5.03292121044870326e-04,
    3.77415847174197741e-04,
    2.83021958306233954e-04,
    2.12236527647776605e-04,
    1.59154943091895351e-04,
    1.19349370211248862e-04,
    8.94994016088910182e-05,
    6.71150830052272545e-05,
    5.03292121044870354e-05,
    3.77415847174197768e-05,
    2.83021958306233961e-05,
    2.12236527647776592e-05

};

struct Params {
    const float *x, *c; const int* pos; const float *w_ada, *b_ada, *g_pre_mix, *g_post_mix, *w_in, *g_q, *w_uq, *g_kv, *w_uk, *w_uv, *w_gate_up, *b_gate, *g_gla, *w_out, *g_pre_ffn, *g_post_ffn, *w_fg, *w_fu, *w_fd;
    float* out; unsigned char* ws;
};

__device__ __forceinline__ int opaque_tid() { int t = threadIdx.x; asm volatile("" : "+v"(t)); return t; }
__device__ __forceinline__ float bf2f(unsigned short u) { return __uint_as_float((unsigned)u << 16); }
__device__ __forceinline__ unsigned short f2bf(float f) { unsigned u = __float_as_uint(f); return (unsigned short)((u + 0x7fffu + ((u >> 16) & 1u)) >> 16); }
__device__ __forceinline__ unsigned pk2(float lo, float hi) { return pg8::cvtpk(lo, hi); }
__device__ __forceinline__ float wave_sum(float v) {
#pragma unroll
    for (int o = 1; o < 64; o <<= 1) v += __shfl_xor(v, o);
    return v;
}
__device__ __forceinline__ float silu_f(float v) { return v * __builtin_amdgcn_rcpf(1.0f + __expf(-v)); }
#define MFMA16(a, b, c) __builtin_amdgcn_mfma_f32_16x16x32_bf16((a), (b), (c), 0, 0, 0)

struct MapIn { const float* W;
    __device__ __forceinline__ const float* col(int n, int& ld) const { ld = 3920; int s;
        if (n < 768) s = n; else if (n < 1280) s = 832 + (n - 768); else if (n < 1792) s = 1344 + (n - 1280); else if (n < 2816) s = 1856 + (n - 1792);
        else if (n < 3840) s = 2896 + (n - 2816); else if (n < 3904) s = 768 + (n - 3840); else if (n < 3920) s = 2880 + (n - 3904); else return nullptr;
        return W + s; } };
struct MapUq { const float* W;
    __device__ __forceinline__ const float* col(int n, int& ld) const { ld = 1536; int s;
        if (n < 1024) s = (n >> 7) * 192 + (n & 127);
        else { const int mm = n - 1024, tile = mm >> 8, w = mm & 255, half = w >> 7, hh = (w & 127) >> 5, i = w & 31; s = (tile * 4 + hh) * 192 + 128 + half * 32 + i; }
        return W + s; } };
struct MapId { const float* W; int ldw;
    __device__ __forceinline__ const float* col(int n, int& ld) const { ld = ldw; return W + n; } };
struct MapGU { const float* Wg; const float* Wu;
    __device__ __forceinline__ const float* col(int n, int& ld) const { ld = DFF; const int tile = n >> 8, w = n & 255; return (w < 128) ? (Wg + tile * 128 + w) : (Wu + tile * 128 + (w - 128)); } };
template <class Map>
__device__ __forceinline__ void transpose_item(const Map& mp, const float* gain, int K, bf16_t* WT, int item, int nblk, int lane, bool late = false, bool grp = false) {
    int kb, nb; if (grp) { const int g = item >> 6, w = item & 63, ngn = nblk >> 3; nb = (g % ngn) * 8 + (w & 7); kb = (g / ngn) * 8 + (w >> 3); } else { kb = item / nblk; nb = item % nblk; }
    const int k0 = 64 * kb, n0 = 64 * nb, kq = lane >> 4, nc = lane & 15;
    int ld; const float* src = mp.col(n0 + 4 * nc, ld);
    f32x4 v[16];
    if (src) { src += (size_t)(k0 + 16 * kq) * ld;
#pragma unroll
        for (int i = 0; i < 16; ++i) v[i] = __builtin_nontemporal_load((const f32x4*)(src + (size_t)i * ld));
    } else {
#pragma unroll
        for (int i = 0; i < 16; ++i) v[i] = (f32x4){0.f, 0.f, 0.f, 0.f};
    }
    if (gain) {
#pragma unroll
        for (int i = 0; i < 16; ++i) v[i] *= gain[k0 + 16 * kq + i];
    }
#pragma unroll
    for (int e = 0; e < 4; ++e) { bf16_t* dst = WT + (size_t)(n0 + 4 * nc + e) * K + k0 + 16 * kq;
        u32x4 w0, w1; w0.x = pk2(v[0][e], v[1][e]); w0.y = pk2(v[2][e], v[3][e]); w0.z = pk2(v[4][e], v[5][e]); w0.w = pk2(v[6][e], v[7][e]);
        w1.x = pk2(v[8][e], v[9][e]); w1.y = pk2(v[10][e], v[11][e]); w1.z = pk2(v[12][e], v[13][e]); w1.w = pk2(v[14][e], v[15][e]);
        if (late) { __builtin_nontemporal_store(w0, (u32x4*)dst); __builtin_nontemporal_store(w1, (u32x4*)(dst + 8)); }
        else { *(u32x4*)dst = w0; *(u32x4*)(dst + 8) = w1; } }
}

__device__ __forceinline__ void p0_prologue(const Params& P, LAS unsigned char* lds, int G) {
    const int tid = opaque_tid(), lane = tid & 63, wave = tid >> 6;
    unsigned char* ws = P.ws;
    const int gw = wave * G + blockIdx.x, NGW = G * 8;
    float* adap = (float*)(ws + WS_ADAP);
    for (int it = gw; it < 48 * KS_ADA; it += NGW) {
        const int nc = it % 48, ks = it / 48, n0 = nc * 256 + lane * 4;
        f32x4 a0 = {0.f, 0.f, 0.f, 0.f}, a1 = {0.f, 0.f, 0.f, 0.f};
#pragma unroll 16
        for (int kk = 0; kk < 128; ++kk) { const int k = ks * 128 + kk; const f32x4 w = __builtin_nontemporal_load((const f32x4*)(P.w_ada + (size_t)k * NADA + n0));
            const float s0 = silu_f(P.c[k]), s1 = silu_f(P.c[DM + k]); a0 += w * s0; a1 += w * s1; }
        *(f32x4*)(adap + (size_t)(ks * 2 + 0) * NADA + n0) = a0; *(f32x4*)(adap + (size_t)(ks * 2 + 1) * NADA + n0) = a1;
    }
    constexpr int I_IN = 32 * 64, I_UQ = 8 * 24, I_UK = 4 * 16, I_UV = 4 * 16, I_OUT = 32 * 32, I_GU = 32 * 176, I_D = 88 * 32;
    constexpr int NITEMS = I_IN + I_UQ + I_UK + I_UV + I_OUT + I_GU + I_D;
    for (int it = gw; it < NITEMS; it += NGW) {
        int r = it;
        if (r < I_IN) { transpose_item(MapIn{P.w_in}, nullptr, 2048, (bf16_t*)(ws + WS_WIN), r, 64, lane, false, true); continue; } r -= I_IN;
        if (r < I_UQ) { transpose_item(MapUq{P.w_uq}, P.g_q, 512, (bf16_t*)(ws + WS_WUQ), r, 24, lane, false, true); continue; } r -= I_UQ;
        if (r < I_UK) { transpose_item(MapId{P.w_uk, 1024}, P.g_kv, 256, (bf16_t*)(ws + WS_WUK), r, 16, lane); continue; } r -= I_UK;
        if (r < I_UV) { transpose_item(MapId{P.w_uv, 1024}, P.g_kv, 256, (bf16_t*)(ws + WS_WUV), r, 16, lane); continue; } r -= I_UV;
        if (r < I_OUT) { transpose_item(MapId{P.w_out, 2048}, nullptr, 2048, (bf16_t*)(ws + WS_WOUT), r, 32, lane, true, true); continue; } r -= I_OUT;
        if (r < I_GU) { transpose_item(MapGU{P.w_fg, P.w_fu}, nullptr, 2048, (bf16_t*)(ws + WS_WGU), r, 176, lane, true, true); continue; } r -= I_GU;
        transpose_item(MapId{P.w_fd, 2048}, nullptr, DFF, (bf16_t*)(ws + WS_WD), r, 32, lane, true, true);
    }
    float* cs = (float*)(ws + WS_CS);
    for (int idx = blockIdx.x * NTHREADS + tid; idx < M * 32; idx += G * NTHREADS) {
        const int m = idx >> 5, i = idx & 31; const double rev = (double)P.pos[m] * INVF_REV[i]; const float fr = (float)(rev - floor(rev));
        cs[2 * idx] = __builtin_amdgcn_cosf(fr); cs[2 * idx + 1] = __builtin_amdgcn_sinf(fr);
    }
}

__device__ __forceinline__ void p1_rows(const Params& P, LAS unsigned char* lds, int G) {
    const int tid = opaque_tid(), lane = tid & 63, wave = tid >> 6;
    const float* adap = (const float*)(P.ws + WS_ADAP); float* ada = (float*)(P.ws + WS_ADA);
    LAS float* TA = (LAS float*)lds;
    LAS float* TC = TA + 2 * DM;
    for (int idx = tid; idx < 2 * DM; idx += NTHREADS) { const int b = idx >> 11, col = idx & (DM - 1);
        float sh = P.b_ada[col], sc = P.b_ada[DM + col];
        for (int ks = 0; ks < KS_ADA; ++ks) { sh += adap[(size_t)(ks * 2 + b) * NADA + col]; sc += adap[(size_t)(ks * 2 + b) * NADA + DM + col]; }
        TA[idx] = P.g_pre_mix[col] * (1.0f + sc); TC[idx] = sh; }
    for (int idx = blockIdx.x * NTHREADS + tid; idx < 2 * NADA; idx += G * NTHREADS) { const int b = idx / NADA, n = idx % NADA; float v = P.b_ada[n];
        for (int ks = 0; ks < KS_ADA; ++ks) v += adap[(size_t)(ks * 2 + b) * NADA + n];
        ada[idx] = v; }
    __syncthreads();
    bf16_t* XN = (bf16_t*)(P.ws + WS_XN);
    for (int m = blockIdx.x * 8 + wave; m < M; m += G * 8) {
        const int b = m >> 13; const f32x4* xr = (const f32x4*)(P.x + (size_t)m * DM) + lane;
        f32x4 v[8]; float ss = 0.f;
#pragma unroll
        for (int j = 0; j < 8; ++j) { v[j] = __builtin_nontemporal_load(xr + 64 * j); ss += (v[j][0] * v[j][0] + v[j][1] * v[j][1]) + (v[j][2] * v[j][2] + v[j][3] * v[j][3]); }
        const float rstd = rsqrtf(wave_sum(ss) * (1.0f / DM) + RMS_EPS);
        u32x2* o = (u32x2*)(XN + (size_t)m * DM) + lane;
#pragma unroll
        for (int j = 0; j < 8; ++j) { const f32x4 a = *(const LAS f32x4*)(TA + b * DM + 256 * j + 4 * lane), c = *(const LAS f32x4*)(TC + b * DM + 256 * j + 4 * lane);
            const f32x4 h = v[j] * rstd * a + c; u32x2 w; w.x = pk2(h[0], h[1]); w.y = pk2(h[2], h[3]); o[64 * j] = w; }
    }
}
__device__ __forceinline__ void p2b_rows(const Params& P, int G) {
    const int tid = opaque_tid(), lane = tid & 63, wave = tid >> 6;
    const bf16_t* Z = (const bf16_t*)P.out; bf16_t* CQN = (bf16_t*)(P.ws + WS_CQN); bf16_t* CKVN = (bf16_t*)(P.ws + WS_CKVN);
    const float* cs = (const float*)(P.ws + WS_CS); bf16_t* KR = (bf16_t*)(P.ws + WS_KROPE);
    for (int m = blockIdx.x * 8 + wave; m < M; m += G * 8) {
        const bf16_t* zr = Z + (size_t)m * ZC;
        const u32x4 a = *(const u32x4*)(zr + ZO_CQ + 8 * lane); const u32x2 k = *(const u32x2*)(zr + ZO_CKV + 4 * lane);
        float s1 = 0.f, s2 = 0.f;
#pragma unroll
        for (int e = 0; e < 4; ++e) { const float lo = __uint_as_float(a[e] << 16), hi = __uint_as_float(a[e] & 0xffff0000u); s1 += lo * lo + hi * hi; }
#pragma unroll
        for (int e = 0; e < 2; ++e) { const float lo = __uint_as_float(k[e] << 16), hi = __uint_as_float(k[e] & 0xffff0000u); s2 += lo * lo + hi * hi; }
        s1 = wave_sum(s1); s2 = wave_sum(s2);
        const float r1 = rsqrtf(s1 * (1.0f / 512.0f) + RMS_EPS), r2 = rsqrtf(s2 * (1.0f / 256.0f) + RMS_EPS);
        { u32x4 w;
#pragma unroll
          for (int e = 0; e < 4; ++e) w[e] = pk2(__uint_as_float(a[e] << 16) * r1, __uint_as_float(a[e] & 0xffff0000u) * r1);
          *(u32x4*)(CQN + (size_t)m * 512 + 8 * lane) = w;
          u32x2 w2;
#pragma unroll
          for (int e = 0; e < 2; ++e) w2[e] = pk2(__uint_as_float(k[e] << 16) * r2, __uint_as_float(k[e] & 0xffff0000u) * r2);
          *(u32x2*)(CKVN + (size_t)m * 256 + 4 * lane) = w2; }
        if (lane < 32) { const float x1 = bf2f(zr[ZO_KR + lane]), x2 = bf2f(zr[ZO_KR + 32 + lane]); const float c = cs[(size_t)m * 64 + 2 * lane], s = cs[(size_t)m * 64 + 2 * lane + 1];
            KR[(size_t)m * 64 + lane] = f2bf(x1 * c - x2 * s); KR[(size_t)m * 64 + 32 + lane] = f2bf(x2 * c + x1 * s); }
    }
}
__device__ __forceinline__ void p7_rows(const Params& P, LAS unsigned char* lds, int G) {
    const int tid = opaque_tid(), lane = tid & 63, wave = tid >> 6;
    const float* ada = (const float*)(P.ws + WS_ADA);
    LAS float* TA = (LAS float*)lds; LAS float* TB = TA + 2 * DM; LAS float* TC = TB + 2 * DM;
    for (int idx = tid; idx < 2 * DM; idx += NTHREADS) { const int b = idx >> 11, col = idx & (DM - 1); const float* ab = ada + (size_t)b * NADA;
        TA[idx] = ab[2 * DM + col] * P.g_post_mix[col]; TB[idx] = P.g_pre_ffn[col] * (1.0f + ab[4 * DM + col]); TC[idx] = ab[3 * DM + col]; }
    __syncthreads();
    const bf16_t* O = (const bf16_t*)(P.ws + WS_O); bf16_t* XN = (bf16_t*)(P.ws + WS_XN);
    for (int m = blockIdx.x * 8 + wave; m < M; m += G * 8) {
        const int b = m >> 13; const f32x4* xr = (const f32x4*)(P.x + (size_t)m * DM) + lane; const u32x2* orow = (const u32x2*)(O + (size_t)m * DM) + lane;
        f32x4 v[8], xv[8]; float ss = 0.f;
#pragma unroll
        for (int j = 0; j < 8; ++j) xv[j] = __builtin_nontemporal_load(xr + 64 * j);
#pragma unroll
        for (int j = 0; j < 8; ++j) { const u32x2 w = __builtin_nontemporal_load(orow + 64 * j); v[j][0] = __uint_as_float(w.x << 16); v[j][1] = __uint_as_float(w.x & 0xffff0000u); v[j][2] = __uint_as_float(w.y << 16); v[j][3] = __uint_as_float(w.y & 0xffff0000u);
            ss += (v[j][0] * v[j][0] + v[j][1] * v[j][1]) + (v[j][2] * v[j][2] + v[j][3] * v[j][3]); }
        const float rstd = rsqrtf(wave_sum(ss) * (1.0f / DM) + RMS_EPS);
        float s2 = 0.f; u32x2* x1r = (u32x2*)((bf16_t*)(P.ws + WS_X1) + (size_t)m * DM) + lane;
#pragma unroll
        for (int j = 0; j < 8; ++j) { const f32x4 a = *(const LAS f32x4*)(TA + b * DM + 256 * j + 4 * lane); const f32x4 x1 = xv[j] + v[j] * rstd * a; v[j] = x1; { u32x2 w; w.x = pk2(x1[0], x1[1]); w.y = pk2(x1[2], x1[3]); __builtin_nontemporal_store(w, x1r + 64 * j); }
            s2 += (x1[0] * x1[0] + x1[1] * x1[1]) + (x1[2] * x1[2] + x1[3] * x1[3]); }
        const float rstd2 = rsqrtf(wave_sum(s2) * (1.0f / DM) + RMS_EPS);
        u32x2* o = (u32x2*)(XN + (size_t)m * DM) + lane;
#pragma unroll
        for (int j = 0; j < 8; ++j) { const f32x4 a = *(const LAS f32x4*)(TB + b * DM + 256 * j + 4 * lane), c = *(const LAS f32x4*)(TC + b * DM + 256 * j + 4 * lane);
            const f32x4 h = v[j] * rstd2 * a + c; u32x2 w; w.x = pk2(h[0], h[1]); w.y = pk2(h[2], h[3]); o[64 * j] = w; }
    }
}
__device__ __forceinline__ void p10_rows(const Params& P, LAS unsigned char* lds, int G) {
    const int tid = opaque_tid(), lane = tid & 63, wave = tid >> 6;
    const float* ada = (const float*)(P.ws + WS_ADA);
    LAS float* TA = (LAS float*)lds;
    for (int idx = tid; idx < 2 * DM; idx += NTHREADS) { const int b = idx >> 11, col = idx & (DM - 1); TA[idx] = ada[(size_t)b * NADA + 5 * DM + col] * P.g_post_ffn[col]; }
    __syncthreads();
    const bf16_t* F = (const bf16_t*)(P.ws + WS_O);
    for (int m = blockIdx.x * 8 + wave; m < M; m += G * 8) {
        const int b = m >> 13; const u32x2* fr = (const u32x2*)(F + (size_t)m * DM) + lane; f32x4* outr = (f32x4*)(P.out + (size_t)m * DM) + lane; const u32x2* x1r = (const u32x2*)((const bf16_t*)(P.ws + WS_X1) + (size_t)m * DM) + lane;
        f32x4 v[8]; u32x2 xw8[8]; float ss = 0.f;
#pragma unroll
        for (int j = 0; j < 8; ++j) xw8[j] = __builtin_nontemporal_load(x1r + 64 * j);
#pragma unroll
        for (int j = 0; j < 8; ++j) { const u32x2 w = __builtin_nontemporal_load(fr + 64 * j); v[j][0] = __uint_as_float(w.x << 16); v[j][1] = __uint_as_float(w.x & 0xffff0000u); v[j][2] = __uint_as_float(w.y << 16); v[j][3] = __uint_as_float(w.y & 0xffff0000u);
            ss += (v[j][0] * v[j][0] + v[j][1] * v[j][1]) + (v[j][2] * v[j][2] + v[j][3] * v[j][3]); }
        const float rstd = rsqrtf(wave_sum(ss) * (1.0f / DM) + RMS_EPS);
#pragma unroll
        for (int j = 0; j < 8; ++j) { const f32x4 a = *(const LAS f32x4*)(TA + b * DM + 256 * j + 4 * lane); const u32x2 xw = xw8[j]; f32x4 x1; x1[0] = __uint_as_float(xw.x << 16); x1[1] = __uint_as_float(xw.x & 0xffff0000u); x1[2] = __uint_as_float(xw.y << 16); x1[3] = __uint_as_float(xw.y & 0xffff0000u); __builtin_nontemporal_store(x1 + v[j] * rstd * a, outr + 64 * j); }
    }
}
constexpr int G1_AG = 0, G1_SEG = 4096, G1_QD = 8192, G1_KI = G1_QD + 64 * 272, G1_KDT = G1_KI + 64 * 272, G1_VT = G1_KDT + 128 * 144, G1_AT = G1_VT + 256 * 144, G1_END = G1_AT + 64 * 144;
static_assert(G1_END <= 131072, "G1 LDS");
__device__ __forceinline__ void gla_intra_unit(const Params& P, LAS unsigned char* lds, int unit) {
    const int tid = opaque_tid(), lane = tid & 63, wid = tid >> 6, fr = lane & 15, fq = lane >> 4;
    const int bh = unit >> 7, n = unit & 127, b = bh >> 2, h = bh & 3;
    const size_t t0 = (size_t)b * SEQ + 64 * n;
    const bf16_t* Z = (const bf16_t*)P.out;
    LAS float* ag = (LAS float*)(lds + G1_AG); LAS float* seg = (LAS float*)(lds + G1_SEG);
    LAS bf16_t* qd = (LAS bf16_t*)(lds + G1_QD); LAS bf16_t* ki = (LAS bf16_t*)(lds + G1_KI); LAS bf16_t* kdT = (LAS bf16_t*)(lds + G1_KDT);
    LAS bf16_t* vT = (LAS bf16_t*)(lds + G1_VT); LAS bf16_t* at = (LAS bf16_t*)(lds + G1_AT);
    bf16_t* qdec_g = (bf16_t*)(P.ws + WS_QDEC); float* decay_g = (float*)(P.ws + WS_DECAY); bf16_t* OI = (bf16_t*)(P.ws + WS_OI); bf16_t* DS = (bf16_t*)(P.ws + WS_XN);
    const int d_ = tid & 127, cgp_ = tid >> 7;
    float wg_[16];
#pragma unroll
    for (int r = 0; r < 16; ++r) wg_[r] = P.w_gate_up[r * 512 + 128 * h + d_];
    const float bias_ = P.b_gate[128 * h + d_];
    bf16_t qraw_[16], kraw_[16];
#pragma unroll
    for (int i = 0; i < 16; ++i) { const size_t zr = (t0 + cgp_ * 16 + i) * ZC; qraw_[i] = Z[zr + ZO_QG + 128 * h + d_]; kraw_[i] = Z[zr + ZO_KG + 128 * h + d_]; }
    { const int idx = tid * 2, c = idx >> 4, r = idx & 15; const unsigned w = *(const unsigned*)(Z + (t0 + c) * ZC + ZO_AG + r); ag[c * 16 + r] = __uint_as_float(w << 16); ag[c * 16 + r + 1] = __uint_as_float(w & 0xffff0000u); }
#pragma unroll
    for (int i = 0; i < 4; ++i) { const int id = tid + NTHREADS * i, c = id & 63, vc = id >> 6;
        const u32x4 w = *(const u32x4*)(Z + (t0 + c) * ZC + ZO_VG + 256 * h + 8 * vc);
#pragma unroll
        for (int e = 0; e < 4; ++e) { vT[(8 * vc + 2 * e) * 72 + c] = (bf16_t)(w[e] & 0xffffu); vT[(8 * vc + 2 * e + 1) * 72 + c] = (bf16_t)(w[e] >> 16); } }
    __syncthreads();
    { const int d = d_, cgp = cgp_;
      float (&w)[16] = wg_; const float bias = bias_;
      float bcv[16]; float run = 0.f;
#pragma unroll
      for (int i = 0; i < 16; ++i) { const int c = cgp * 16 + i; float xg = bias;
#pragma unroll
          for (int r4 = 0; r4 < 4; ++r4) { const f32x4 a = *(const LAS f32x4*)(ag + c * 16 + 4 * r4); xg += a[0] * w[4 * r4] + a[1] * w[4 * r4 + 1] + a[2] * w[4 * r4 + 2] + a[3] * w[4 * r4 + 3]; }
          const float ls = fminf(xg, 0.f) - __logf(1.0f + __expf(-fabsf(xg)));
          run += ls * (1.0f / 16.0f); bcv[i] = run; }
      seg[cgp * 128 + d] = run;
      __syncthreads();
      float off = 0.f, tot = 0.f;
#pragma unroll
      for (int g2 = 0; g2 < 4; ++g2) { const float sv = seg[g2 * 128 + d]; tot += sv; if (g2 < cgp) off += sv; }
      float kd_prev = 0.f;
#pragma unroll
      for (int i = 0; i < 16; ++i) { const int c = cgp * 16 + i; const float bc = bcv[i] + off;
          const float q = bf2f(qraw_[i]), k = bf2f(kraw_[i]);
          const bf16_t qv = f2bf(q * 0.08838834764831845f * __expf(bc));
          qd[c * 136 + d] = qv; ki[c * 136 + d] = f2bf(k * __expf(-bc));
          const float kdv = k * __expf(tot - bc);
          if (i & 1) *(LAS unsigned*)(kdT + d * 72 + c - 1) = pk2(kd_prev, kdv); else kd_prev = kdv; }
      if (cgp == 0) decay_g[(size_t)unit * 128 + d] = __expf(tot);
    }
    __syncthreads();
#pragma unroll
    for (int i = 0; i < 2; ++i) { const int id = tid + NTHREADS * i, c = id >> 4, ch = id & 15; *(u32x4*)(qdec_g + ((size_t)unit * 64 + c) * 128 + 8 * ch) = *(const LAS u32x4*)(qd + c * 136 + 8 * ch); }
    { const int cb = wid >> 1;
#pragma unroll
      for (int jj = 0; jj < 2; ++jj) { const int jb = (wid & 1) * 2 + jj; f32x4 acc = {0.f, 0.f, 0.f, 0.f};
          if (jb <= cb) {
#pragma unroll
              for (int ks = 0; ks < 4; ++ks) { const bf16x8 a = *(const LAS bf16x8*)(qd + (16 * cb + fr) * 136 + 32 * ks + 8 * fq), bb = *(const LAS bf16x8*)(ki + (16 * jb + fr) * 136 + 32 * ks + 8 * fq); acc = MFMA16(a, bb, acc); } }
#pragma unroll
          for (int e = 0; e < 4; ++e) { const int c = 16 * cb + 4 * fq + e, j = 16 * jb + fr; at[c * 72 + j] = f2bf(j <= c ? acc[e] : 0.f); } }
    }
    __syncthreads();
#pragma unroll
    for (int vbi = 0; vbi < 2; ++vbi) { const int vb = 2 * wid + vbi;
        bf16x8 vf[2];
#pragma unroll
        for (int ks = 0; ks < 2; ++ks) vf[ks] = *(const LAS bf16x8*)(vT + (16 * vb + fr) * 72 + 32 * ks + 8 * fq);
#pragma unroll
        for (int cb = 0; cb < 4; ++cb) { f32x4 acc = {0.f, 0.f, 0.f, 0.f};
#pragma unroll
            for (int ks = 0; ks < 2; ++ks) acc = MFMA16(vf[ks], *(const LAS bf16x8*)(at + (16 * cb + fr) * 72 + 32 * ks + 8 * fq), acc);
            u32x2 w; w.x = pk2(acc[0], acc[1]); w.y = pk2(acc[2], acc[3]);
            *(u32x2*)(OI + (t0 + 16 * cb + fr) * 1024 + 256 * h + 16 * vb + 4 * fq) = w; }
#pragma unroll
        for (int db = 0; db < 8; ++db) { f32x4 acc = {0.f, 0.f, 0.f, 0.f};
#pragma unroll
            for (int ks = 0; ks < 2; ++ks) acc = MFMA16(*(const LAS bf16x8*)(kdT + (16 * db + fr) * 72 + 32 * ks + 8 * fq), vf[ks], acc);
            u32x2 w; w.x = pk2(acc[0], acc[1]); w.y = pk2(acc[2], acc[3]);
            *(u32x2*)(DS + ((size_t)unit * 256 + 16 * vb + fr) * 128 + 16 * db + 4 * fq) = w; }
    }
    __syncthreads();
}
__device__ __forceinline__ void gla_scan(const Params& P, int G) {
    const bf16_t* DS = (const bf16_t*)(P.ws + WS_XN); bf16_t* ST = (bf16_t*)(P.ws + WS_ST); const float* decay_g = (const float*)(P.ws + WS_DECAY);
    for (int gid = blockIdx.x * NTHREADS + threadIdx.x; gid < 8 * 16384; gid += G * NTHREADS) {
        const int bh = gid >> 14, e2 = gid & 16383, d = (2 * e2) & 127;
        float s0 = 0.f, s1 = 0.f;
#pragma unroll 16
        for (int n = 0; n < 128; ++n) { const size_t unit = (size_t)bh * 128 + n;
            const unsigned w = *(const unsigned*)(DS + unit * 32768 + 2 * e2); typedef float f32x2_t __attribute__((ext_vector_type(2))); const f32x2_t dd = *(const f32x2_t*)(decay_g + unit * 128 + d); const float d0 = dd.x, d1 = dd.y;
            *(unsigned*)(ST + unit * 32768 + 2 * e2) = pk2(s0, s1);
            s0 = d0 * s0 + __uint_as_float(w << 16); s1 = d1 * s1 + __uint_as_float(w & 0xffff0000u); }
    }
}
__device__ __forceinline__ void gla_inter_unit(const Params& P, LAS unsigned char* lds, int unit) {
    const int tid = opaque_tid(), lane = tid & 63, wid = tid >> 6, fr = lane & 15, fq = lane >> 4;
    const int bh = unit >> 7, n = unit & 127, b = bh >> 2, h = bh & 3;
    const size_t t0 = (size_t)b * SEQ + 64 * n;
    const bf16_t* Z = (const bf16_t*)P.out; const bf16_t* qdec_g = (const bf16_t*)(P.ws + WS_QDEC); const bf16_t* OI = (const bf16_t*)(P.ws + WS_OI); const bf16_t* ST = (const bf16_t*)(P.ws + WS_ST);
    bf16_t* AO = (bf16_t*)(P.ws + WS_XN);
    LAS float* red = (LAS float*)lds;
    const int cb = wid & 3, vh = wid >> 2; const size_t trow = t0 + 16 * cb + fr;
    bf16x8 qf[4];
#pragma unroll
    for (int ks = 0; ks < 4; ++ks) qf[ks] = *(const bf16x8*)(qdec_g + ((size_t)unit * 64 + 16 * cb + fr) * 128 + 32 * ks + 8 * fq);
    f32x4 o[8]; float ss = 0.f;
    bf16x8 sf[8][4]; u32x2 oiw[8];
#pragma unroll
    for (int vbi = 0; vbi < 8; ++vbi) { const int vb = vh * 8 + vbi;
#pragma unroll
        for (int ks = 0; ks < 4; ++ks) sf[vbi][ks] = *(const bf16x8*)(ST + ((size_t)unit * 256 + 16 * vb + fr) * 128 + 32 * ks + 8 * fq);
        oiw[vbi] = *(const u32x2*)(OI + trow * 1024 + 256 * h + 16 * vb + 4 * fq); }
#pragma unroll
    for (int vbi = 0; vbi < 8; ++vbi) { f32x4 acc = {0.f, 0.f, 0.f, 0.f};
#pragma unroll
        for (int ks = 0; ks < 4; ++ks) acc = MFMA16(sf[vbi][ks], qf[ks], acc);
        const u32x2 w = oiw[vbi];
        acc[0] += __uint_as_float(w.x << 16); acc[1] += __uint_as_float(w.x & 0xffff0000u); acc[2] += __uint_as_float(w.y << 16); acc[3] += __uint_as_float(w.y & 0xffff0000u);
        o[vbi] = acc; ss += (acc[0] * acc[0] + acc[1] * acc[1]) + (acc[2] * acc[2] + acc[3] * acc[3]); }
    ss += __shfl_xor(ss, 16); ss += __shfl_xor(ss, 32);
    if (fq == 0) red[wid * 16 + fr] = ss;
    __syncthreads();
    const float tot = red[cb * 16 + fr] + red[(cb + 4) * 16 + fr];
    const float rstd = rsqrtf(tot * (1.0f / 256.0f) + RMS_EPS);
#pragma unroll
    for (int vbi = 0; vbi < 8; ++vbi) { const int vcol = 16 * (vh * 8 + vbi) + 4 * fq;
        const f32x4 g = *(const f32x4*)(P.g_gla + vcol); const u32x2 rw = *(const u32x2*)(Z + trow * ZC + ZO_RG + 256 * h + vcol);
        const float r0 = __uint_as_float(rw.x << 16), r1 = __uint_as_float(rw.x & 0xffff0000u), r2 = __uint_as_float(rw.y << 16), r3 = __uint_as_float(rw.y & 0xffff0000u);
        u32x2 w; w.x = pk2(o[vbi][0] * rstd * g[0] * silu_f(r0), o[vbi][1] * rstd * g[1] * silu_f(r1)); w.y = pk2(o[vbi][2] * rstd * g[2] * silu_f(r2), o[vbi][3] * rstd * g[3] * silu_f(r3));
        *(u32x2*)(AO + trow * DM + 1024 + 256 * h + vcol) = w; }
    __syncthreads();
}

constexpr int AT_KB = 64 * 512, AT_VB = 128 * 144, AT_BUF = AT_KB + AT_VB;
constexpr float AT_THR = 8.0f;
#ifndef AT_SGB
#define AT_SGB 1
#endif
#ifndef AT_QK_AHEAD
#define AT_QK_AHEAD 4
#endif
#ifndef AT_PV_AHEAD
#define AT_PV_AHEAD 4
#endif
#ifndef AT_SCHED
#define AT_SCHED
#endif
__device__ __forceinline__ void attn_unit(const Params& P, LAS unsigned char* lds, int bh, int qb) {
    const int tid = opaque_tid(), lane = tid & 63, wid = __builtin_amdgcn_readfirstlane(tid >> 6), fr = lane & 15, fq = lane >> 4;
    const int b = bh >> 3, h = bh & 7; const size_t rowb = (size_t)b * SEQ; const int q0 = qb * 256 + wid * 32;
    const bf16_t* Q = (const bf16_t*)(P.ws + WS_Q); const bf16_t* KN = (const bf16_t*)(P.ws + WS_KN); const bf16_t* KR = (const bf16_t*)(P.ws + WS_KROPE); const bf16_t* VT = (const bf16_t*)(P.ws + WS_VT);
    bf16_t* AO = (bf16_t*)(P.ws + WS_XN);
    bf16x8 qf[6][2];
#pragma unroll
    for (int qk = 0; qk < 2; ++qk) { const bf16_t* qp = Q + (rowb + q0 + 16 * qk + fr) * QC;
#pragma unroll
        for (int ks = 0; ks < 4; ++ks) qf[ks][qk] = *(const bf16x8*)(qp + 128 * h + 32 * ks + 8 * fq);
        qf[4][qk] = *(const bf16x8*)(qp + 1024 + (h >> 2) * 256 + (h & 3) * 32 + 8 * fq); qf[5][qk] = *(const bf16x8*)(qp + 1024 + (h >> 2) * 256 + 128 + (h & 3) * 32 + 8 * fq); }
    const int NT = (qb + 1) * 4;
    const bf16_t* KNh = KN + rowb * 1024 + 128 * h; const bf16_t* KRb = KR + rowb * 64; const bf16_t* VTh = VT + (size_t)(128 * h) * M + rowb;
    const unsigned char* dsrc[7]; unsigned dstr[7];
#pragma unroll
    for (int j_ = 0; j_ < 7; ++j_) { const int c_ = wid + 8 * j_; const int L_ = 1024 * c_ + 16 * lane; const bf16_t* src_ = KNh; unsigned st_ = 0;
        if (L_ < AT_KB) { const int row_ = L_ >> 9, pp_ = (L_ & 511) >> 4; int pc_ = (pp_ & 16) | ((pp_ & 15) ^ (row_ & 15)); if (pc_ >= 24) pc_ = 0;
            if (pc_ < 16) { src_ = KNh + (size_t)row_ * 1024 + 8 * pc_; st_ = 64u * 1024u * 2u; } else { src_ = KRb + (size_t)row_ * 64 + 8 * (pc_ - 16); st_ = 64u * 64u * 2u; } }
        else if (c_ < 50) { const int L2_ = L_ - AT_KB, dv_ = L2_ / 144, cb_ = L2_ - dv_ * 144; int pc_ = cb_ >> 4; if (pc_ >= 8) pc_ = 0; src_ = VTh + (size_t)dv_ * M + 8 * pc_; st_ = 128u; }
        dsrc[j_] = (const unsigned char*)src_; dstr[j_] = st_; }
#define AT_DMA(t, buf) do { _Pragma("unroll") for (int j_ = 0; j_ < 7; ++j_) { const int c_ = wid + 8 * j_; if (c_ < 50) { \
            __builtin_amdgcn_global_load_lds((const unsigned*)dsrc[j_], (LAS unsigned*)(lds + (buf) * AT_BUF + 1024 * c_), 16, 0, 0); dsrc[j_] += dstr[j_]; } } } while (0)
    int kxo[4];
#pragma unroll
    for (int j = 0; j < 4; ++j) kxo[j] = fr * 512 + (((4 * j + fq) ^ fr) << 4);
    float mrow[2] = {0.f, 0.f}; f32x4 lacc[2] = {(f32x4){0.f, 0.f, 0.f, 0.f}, (f32x4){0.f, 0.f, 0.f, 0.f}};
    const bf16x8 ones = {16256, 16256, 16256, 16256, 16256, 16256, 16256, 16256};
    f32x4 o[8][2];
#pragma unroll
    for (int dvb = 0; dvb < 8; ++dvb) { o[dvb][0] = (f32x4){0.f, 0.f, 0.f, 0.f}; o[dvb][1] = (f32x4){0.f, 0.f, 0.f, 0.f}; }
    AT_DMA(0, 0);
    asm volatile("s_waitcnt vmcnt(0)" ::: "memory"); __syncthreads();
#pragma clang loop unroll(disable)
    for (int t = 0; t < NT; ++t) {
        const int buf = t & 1; const bool more = (t + 1 < NT);
        if (more) AT_DMA(t + 1, buf ^ 1);
        const LAS unsigned char* Kl = lds + buf * AT_BUF; const LAS unsigned char* Vl = Kl + AT_KB;
        const int k0 = 64 * t;
        if (k0 <= q0) {
#define AT_SB __builtin_amdgcn_sched_barrier(0)
#define AT_KLD(dst, ks_) do { _Pragma("unroll") for (int kvb = 0; kvb < 4; ++kvb) dst[kvb] = *(const LAS bf16x8*)(Kl + kxo[(ks_) & 3] + ((ks_) >> 2) * 256 + kvb * (16 * 512)); } while (0)
#define AT_VLD(dst, g_) do { _Pragma("unroll") for (int i_ = 0; i_ < 4; ++i_) { const LAS unsigned char* vp = Vl + (16 * (4 * ((g_) & 1) + i_) + fr) * 144 + (32 * ((g_) >> 1) + 4 * fq) * 2; \
            const u32x2 lo = *(const LAS u32x2*)vp, hi = *(const LAS u32x2*)(vp + 32); u32x4 w; w.x = lo.x; w.y = lo.y; w.z = hi.x; w.w = hi.y; dst[i_] = __builtin_bit_cast(bf16x8, w); } } while (0)
            bf16x8 kc[4], kn[4];
            AT_KLD(kc, 0);
            f32x4 s[4][2];
#pragma unroll
            for (int kvb = 0; kvb < 4; ++kvb) { s[kvb][0] = (f32x4){-mrow[0], -mrow[0], -mrow[0], -mrow[0]}; s[kvb][1] = (f32x4){-mrow[1], -mrow[1], -mrow[1], -mrow[1]}; }
#pragma unroll
            for (int ks = 0; ks < 6; ++ks) {
                if (ks < 5) AT_KLD(kn, ks + 1);
                AT_SB;
#pragma unroll
                for (int kvb = 0; kvb < 4; ++kvb) { s[kvb][0] = MFMA16(kc[kvb], qf[ks][0], s[kvb][0]); s[kvb][1] = MFMA16(kc[kvb], qf[ks][1], s[kvb][1]); }
                AT_SB;
                if (ks < 5) {
#pragma unroll
                    for (int kvb = 0; kvb < 4; ++kvb) kc[kvb] = kn[kvb]; }
            }
            bf16x8 vc[4], vn[4];
            AT_VLD(vc, 0);
            AT_SB;
            if (k0 + 63 > q0) {
#pragma unroll
                for (int kvb = 0; kvb < 4; ++kvb)
#pragma unroll
                    for (int qk = 0; qk < 2; ++qk)
#pragma unroll
                        for (int e = 0; e < 4; ++e) { const int kv = k0 + 16 * kvb + 4 * fq + e, q = q0 + 16 * qk + fr; if (kv > q) s[kvb][qk][e] = -INFINITY; }
            }
            float mx[2];
#pragma unroll
            for (int qk = 0; qk < 2; ++qk) { float m_ = fmaxf(fmaxf(s[0][qk][0], s[0][qk][1]), fmaxf(s[0][qk][2], s[0][qk][3]));
#pragma unroll
                for (int kvb = 1; kvb < 4; ++kvb) m_ = fmaxf(m_, fmaxf(fmaxf(s[kvb][qk][0], s[kvb][qk][1]), fmaxf(s[kvb][qk][2], s[kvb][qk][3])));
                m_ = fmaxf(m_, __shfl_xor(m_, 16)); m_ = fmaxf(m_, __shfl_xor(m_, 32)); mx[qk] = m_; }
            if (t == 0 || __any((mx[0] > AT_THR) || (mx[1] > AT_THR))) {
#pragma unroll
                for (int qk = 0; qk < 2; ++qk) { const float dl = (t == 0) ? mx[qk] : fmaxf(mx[qk], 0.f), alpha = __builtin_amdgcn_exp2f(-dl); mrow[qk] += dl; lacc[qk] *= alpha;
#pragma unroll
                    for (int kvb = 0; kvb < 4; ++kvb) s[kvb][qk] -= dl;
#pragma unroll
                    for (int dvb = 0; dvb < 8; ++dvb) o[dvb][qk] *= alpha; }
            }
            bf16x8 pf[2][2];
#pragma unroll
            for (int qk = 0; qk < 2; ++qk) {
#pragma unroll
                for (int kvb = 0; kvb < 4; ++kvb)
#pragma unroll
                    for (int e = 0; e < 4; ++e) s[kvb][qk][e] = __builtin_amdgcn_exp2f(s[kvb][qk][e]);
#pragma unroll
                for (int s2 = 0; s2 < 2; ++s2) { u32x4 w; w.x = pk2(s[2 * s2][qk][0], s[2 * s2][qk][1]); w.y = pk2(s[2 * s2][qk][2], s[2 * s2][qk][3]);
                    w.z = pk2(s[2 * s2 + 1][qk][0], s[2 * s2 + 1][qk][1]); w.w = pk2(s[2 * s2 + 1][qk][2], s[2 * s2 + 1][qk][3]); pf[s2][qk] = __builtin_bit_cast(bf16x8, w); } }
            AT_SB;
#pragma unroll
            for (int g = 0; g < 4; ++g) {
                if (g < 3) AT_VLD(vn, g + 1);
                AT_SB;
                if ((g & 1) == 0) { lacc[0] = MFMA16(ones, pf[g >> 1][0], lacc[0]); lacc[1] = MFMA16(ones, pf[g >> 1][1], lacc[1]); }
#pragma unroll
                for (int i = 0; i < 4; ++i) { const int dvb = 4 * (g & 1) + i; o[dvb][0] = MFMA16(vc[i], pf[g >> 1][0], o[dvb][0]); o[dvb][1] = MFMA16(vc[i], pf[g >> 1][1], o[dvb][1]); }
                AT_SB;
                if (g < 3) {
#pragma unroll
                    for (int i = 0; i < 4; ++i) vc[i] = vn[i]; }
            }
#undef AT_SB
#undef AT_KLD
#undef AT_VLD
        }
        asm volatile("s_waitcnt vmcnt(0)" ::: "memory"); __syncthreads();
    }
#pragma unroll
    for (int qk = 0; qk < 2; ++qk) { const float rl = 1.0f / lacc[qk][0];
        bf16_t* op = AO + (rowb + q0 + 16 * qk + fr) * DM + 128 * h + 4 * fq;
#pragma unroll
        for (int dvb = 0; dvb < 8; ++dvb) { u32x2 w; w.x = pk2(o[dvb][qk][0] * rl, o[dvb][qk][1] * rl); w.y = pk2(o[dvb][qk][2] * rl, o[dvb][qk][3] * rl); *(u32x2*)(op + 16 * dvb) = w; } }
#undef AT_DMA
}

#define GAS __attribute__((address_space(1)))
typedef GAS unsigned gu32;
typedef GAS unsigned long long gu64;
#define RLX_AGENT __ATOMIC_RELAXED, __HIP_MEMORY_SCOPE_AGENT
#define LDS_WAIT() asm volatile("s_waitcnt lgkmcnt(0)" ::: "memory")
#define VM_WAIT() asm volatile("s_waitcnt vmcnt(0)" ::: "memory")
__device__ __forceinline__ unsigned long long rt() { return __builtin_amdgcn_s_memrealtime(); }

#define XB_TMO      128
#define XB_XCNT(j)  (256  + 64 * (j))
#define XB_XSUB(j)  (1280 + 64 * (j))
#define XB_XGEN(j)  (2304 + 64 * (j))
#define XB_TOP      3328
#define XB_TOPGEN   3392
#define XCD_BAR_WORDS 3456
#define XB_SPIN_CAP (1u << 18)

__device__ __forceinline__ unsigned xb_ld(unsigned* p)              { return __hip_atomic_load(p, __ATOMIC_RELAXED, __HIP_MEMORY_SCOPE_AGENT); }
__device__ __forceinline__ unsigned xb_add(unsigned* p, unsigned v) { return __hip_atomic_fetch_add(p, v, __ATOMIC_RELAXED, __HIP_MEMORY_SCOPE_AGENT); }
__device__ __forceinline__ unsigned xb_xcc_id() { return (unsigned)__builtin_amdgcn_s_getreg((3 << 11) | 20) & 0xFu; }
#define XB_SPIN(cond, bar) do { unsigned _sp = 0; while (cond) { __builtin_amdgcn_s_sleep(1); \
    if ((++_sp & 255u) == 0u) { if (xb_ld(&(bar)[XB_TMO])) break; if (_sp > XB_SPIN_CAP) { atomicAdd(&(bar)[XB_TMO], 1u); break; } } } } while (0)

struct XcdBarrier {
    unsigned* bar; unsigned x;
    volatile LAS unsigned* st;
};

__device__ __forceinline__ XcdBarrier xcd_barrier_post(unsigned* bar, volatile LAS unsigned* st) {
    XcdBarrier b; b.bar = bar; b.x = xb_xcc_id(); b.st = st;
    if (threadIdx.x == 0) (void)xb_add(&bar[XB_XCNT(b.x)], 1u);
    return b;
}
__device__ __forceinline__ void xcd_barrier_complete(unsigned* bar, unsigned x, unsigned& nloc, unsigned& nx) {
    const unsigned G = gridDim.x * gridDim.y * gridDim.z;
    unsigned sum, cnt, mine, sp = 0u;
    for (;;) {
        sum = 0u; cnt = 0u; mine = 0u;
#pragma unroll
        for (unsigned j = 0; j < 16; ++j) { const unsigned c = xb_ld(&bar[XB_XCNT(j)]); sum += c; cnt += (c > 0u) ? 1u : 0u; mine = (j == x) ? c : mine; }
        if (sum == G) break;
        __builtin_amdgcn_s_sleep(1);
        if ((++sp & 255u) == 0u) { if (xb_ld(&bar[XB_TMO])) break; if (sp > XB_SPIN_CAP) { atomicAdd(&bar[XB_TMO], 1u); break; } }
    }
    nloc = mine > 0u ? mine : 1u; nx = cnt > 0u ? cnt : 1u;
}

__device__ __forceinline__ void xcd_barrier(const XcdBarrier& b) {
    asm volatile("s_waitcnt vmcnt(0)" ::: "memory");
    __syncthreads();
    if (threadIdx.x == 0) {
        unsigned* bar = b.bar;
        __builtin_amdgcn_s_waitcnt(0);
        unsigned nloc = b.st[0], nx = b.st[1];
        if (nloc == 0u) { xcd_barrier_complete(bar, b.x, nloc, nx); b.st[0] = nloc; b.st[1] = nx; }
        const unsigned old = xb_add(&bar[XB_XSUB(b.x)], 1u);
        const unsigned gen = old / nloc;
        if (old + 1u == (gen + 1u) * nloc) {
            __builtin_amdgcn_fence(__ATOMIC_RELEASE, "agent");
            asm volatile("s_waitcnt vmcnt(0)" ::: "memory");
            const unsigned og = xb_add(&bar[XB_TOP], 1u);
            const unsigned tg = og / nx;
            if (og + 1u == (tg + 1u) * nx) xb_add(&bar[XB_TOPGEN], 1u);
            else XB_SPIN(xb_ld(&bar[XB_TOPGEN]) == tg, bar);
            __builtin_amdgcn_fence(__ATOMIC_ACQUIRE, "agent");
            xb_add(&bar[XB_XGEN(b.x)], 1u);
            asm volatile("s_waitcnt vmcnt(0)" ::: "memory");
        } else {
            XB_SPIN(xb_ld(&bar[XB_XGEN(b.x)]) == gen, bar);
            __builtin_amdgcn_fence(__ATOMIC_ACQUIRE, "agent");
            asm volatile("s_waitcnt vmcnt(0)" ::: "memory");
        }
    }
    __syncthreads();
}


#ifndef PHASES
#define PHASES 0xFFFF
#endif
#define PH(k) ((PHASES >> (k)) & 1)
#ifndef REP_ATT
#define REP_ATT 1
#endif
#ifndef REP_P0
#define REP_P0 1
#endif
#ifndef REP_GLA
#define REP_GLA 1
#endif
#ifndef REP_A
#define REP_A 1
#endif
#ifndef REP_B
#define REP_B 1
#endif
#ifndef REP_C
#define REP_C 1
#endif
#ifndef REP_D
#define REP_D 1
#endif
#ifndef P2_SP2
#define P2_SP2 true
#endif
#ifndef P2_ALIGN
#define P2_ALIGN true
#endif
#ifndef P69_ALIGN
#define P69_ALIGN true
#endif
#ifndef P3_ALIGN
#define P3_ALIGN false
#endif
#ifndef P3_SP2
#define P3_SP2 true
#endif
#ifndef REP_P8
#define REP_P8 1
#endif
#ifndef REP_ROWS
#define REP_ROWS 1
#endif
#ifndef REP_SYNC
#define REP_SYNC 1
#endif
__global__ void __launch_bounds__(NTHREADS, 2) hybrid_block_fwd(Params P) {
    extern __shared__ __attribute__((aligned(16))) unsigned char lds_raw[];
    LAS unsigned char* lds = (LAS unsigned char*)lds_raw;
    cg::grid_group grid = cg::this_grid();
    volatile LAS unsigned* MISC = (volatile LAS unsigned*)(lds + MISC_OFF);
    if (threadIdx.x < 32) MISC[threadIdx.x] = 0u;
    __syncthreads();
    XcdBarrier bar = xcd_barrier_post((unsigned*)(P.ws + WS_CTL), MISC + 8);
#define GSYNC() xcd_barrier(bar)
    const int G = gridDim.x, bx = blockIdx.x;
    unsigned char* ws = P.ws;
    bf16_t* Zb = (bf16_t*)P.out;
    if (PH(0)) for (int rep = 0; rep < REP_P0; ++rep) p0_prologue(P, lds, G);
    if (P.out == nullptr) grid.sync();
    GSYNC();
    if (PH(1)) p1_rows(P, lds, G);
#if defined(DUP_A)
    __syncthreads(); p1_rows(P, lds, G);
#endif
    for (int rep = 0; rep < REP_SYNC; ++rep) GSYNC();
    if (PH(2)) { pg8::Gemm g{(const bf16_t*)(ws + WS_XN), (const bf16_t*)(ws + WS_WIN), M, ZC, DM, DM, DM}; pg8::StaticOrder S; S.init(M, ZC, G, bx);
      pg8::EpiPlain E{Zb, ZC}; pg8::gemm_phase<pg8::EpiPlain, pg8::StaticOrder, P2_ALIGN, P2_SP2>(lds, g, S, E); }
#if defined(DUP_P2)
    if (PH(2)) { pg8::Gemm g{(const bf16_t*)(ws + WS_XN), (const bf16_t*)(ws + WS_WIN), M, ZC, DM, DM, DM}; pg8::StaticOrder S; S.init(M, ZC, G, bx);
      pg8::EpiPlain E{Zb, ZC}; pg8::gemm_phase<pg8::EpiPlain, pg8::StaticOrder, P2_ALIGN, P2_SP2>(lds, g, S, E); }
#endif
    GSYNC();
    if (PH(3)) p2b_rows(P, G);
#if defined(DUP_A)
    p2b_rows(P, G);
#endif
    GSYNC();
    if (PH(4)) { pg8::Gemm g{(const bf16_t*)(ws + WS_CQN), (const bf16_t*)(ws + WS_WUQ), M, QC, 512, 512, 512}; pg8::StaticOrder S; S.init(M, QC, G, bx);
      pg8::EpiRowScaleRope E{(bf16_t*)(ws + WS_Q), QC, QSCALE, 4, (const float*)(ws + WS_CS)};
      pg8::gemm_phase<pg8::EpiRowScaleRope, pg8::StaticOrder, P3_ALIGN, P3_SP2>(lds, g, S, E); }
    if (PH(5)) { pg8::Gemm g{(const bf16_t*)(ws + WS_CKVN), (const bf16_t*)(ws + WS_WUK), M, 1024, 256, 256, 256}; pg8::StaticOrder S; S.init(M, 1024, G, bx);
      pg8::EpiPlain E{(bf16_t*)(ws + WS_KN), 1024}; pg8::gemm_phase<pg8::EpiPlain, pg8::StaticOrder, P3_ALIGN, P3_SP2>(lds, g, S, E); }
    if (PH(6)) { pg8::Gemm g{(const bf16_t*)(ws + WS_WUV), (const bf16_t*)(ws + WS_CKVN), 1024, M, 256, 256, 256}; pg8::StaticOrder S; S.init(1024, M, G, bx);
      pg8::EpiPlain E{(bf16_t*)(ws + WS_VT), M}; pg8::gemm_phase<pg8::EpiPlain, pg8::StaticOrder, P3_ALIGN, P3_SP2>(lds, g, S, E); }
#if defined(DUP_P3)
    if (PH(4)) { pg8::Gemm g{(const bf16_t*)(ws + WS_CQN), (const bf16_t*)(ws + WS_WUQ), M, QC, 512, 512, 512}; pg8::StaticOrder S; S.init(M, QC, G, bx);
      pg8::EpiRowScaleRope E{(bf16_t*)(ws + WS_Q), QC, QSCALE, 4, (const float*)(ws + WS_CS)};
      pg8::gemm_phase<pg8::EpiRowScaleRope, pg8::StaticOrder, true, true>(lds, g, S, E); }
    if (PH(5)) { pg8::Gemm g{(const bf16_t*)(ws + WS_CKVN), (const bf16_t*)(ws + WS_WUK), M, 1024, 256, 256, 256}; pg8::StaticOrder S; S.init(M, 1024, G, bx);
      pg8::EpiPlain E{(bf16_t*)(ws + WS_KN), 1024}; pg8::gemm_phase<pg8::EpiPlain, pg8::StaticOrder, true, true>(lds, g, S, E); }
    if (PH(6)) { pg8::Gemm g{(const bf16_t*)(ws + WS_WUV), (const bf16_t*)(ws + WS_CKVN), 1024, M, 256, 256, 256}; pg8::StaticOrder S; S.init(1024, M, G, bx);
      pg8::EpiPlain E{(bf16_t*)(ws + WS_VT), M}; pg8::gemm_phase<pg8::EpiPlain, pg8::StaticOrder, true, true>(lds, g, S, E); }
#endif
    if (PH(7)) for (int rep = 0; rep < REP_GLA; ++rep) for (int u = bx; u < 1024; u += G) gla_intra_unit(P, lds, u);
    GSYNC();
    if (PH(8)) for (int rep = 0; rep < REP_B; ++rep) gla_scan(P, G);
    GSYNC();
    if (PH(9)) for (int u = bx; u < 1024; u += G) gla_inter_unit(P, lds, u);
#if defined(DUP_C)
    for (int u = bx; u < 1024; u += G) gla_inter_unit(P, lds, u);
#endif
    if (PH(10)) { const int vcu = (G % 8 == 0) ? (bx % 8) * (G / 8) + bx / 8 : bx;
      for (int rep = 0; rep < REP_ATT; ++rep) for (int p2 = 2 * vcu; p2 < 512; p2 += 2 * G) {
#pragma clang loop unroll(disable)
          for (int i2 = 0; i2 < 2; ++i2) { const int p = p2 >> 1, bh = p >> 4, s = p & 15; attn_unit(P, lds, bh, i2 ? s : 31 - s); } } }
    GSYNC();
    if (PH(11)) { pg8::Gemm g{(const bf16_t*)(ws + WS_XN), (const bf16_t*)(ws + WS_WOUT), M, DM, DM, DM, DM}; pg8::StaticOrder S; S.init(M, DM, G, bx);
      pg8::EpiPlain E{(bf16_t*)(ws + WS_O), DM}; pg8::gemm_phase<pg8::EpiPlain, pg8::StaticOrder, P69_ALIGN, true>(lds, g, S, E); }
#if defined(DUP_P6)
    if (PH(11)) { pg8::Gemm g{(const bf16_t*)(ws + WS_XN), (const bf16_t*)(ws + WS_WOUT), M, DM, DM, DM, DM}; pg8::StaticOrder S; S.init(M, DM, G, bx);
      pg8::EpiPlain E{(bf16_t*)(ws + WS_O), DM}; pg8::gemm_phase<pg8::EpiPlain, pg8::StaticOrder, P69_ALIGN, true>(lds, g, S, E); }
#endif
    GSYNC();
    if (PH(12)) for (int rep = 0; rep < REP_D; ++rep) { p7_rows(P, lds, G); __syncthreads(); }
    GSYNC();
    if (PH(13)) { pg8::Gemm g{(const bf16_t*)(ws + WS_XN), (const bf16_t*)(ws + WS_WGU), M, 2 * DFF, DM, DM, DM}; pg8::StaticOrder S; S.init(M, 2 * DFF, G, bx);
      pg8::EpiSwiGLU E{(bf16_t*)(ws + WS_ACT), DFF}; pg8::gemm_phase<pg8::EpiSwiGLU, pg8::StaticOrder, true, true>(lds, g, S, E); }
#if defined(DUP_P8)
    if (PH(13)) { pg8::Gemm g{(const bf16_t*)(ws + WS_XN), (const bf16_t*)(ws + WS_WGU), M, 2 * DFF, DM, DM, DM}; pg8::StaticOrder S; S.init(M, 2 * DFF, G, bx);
      pg8::EpiSwiGLU E{(bf16_t*)(ws + WS_ACT), DFF}; pg8::gemm_phase<pg8::EpiSwiGLU, pg8::StaticOrder, true, true>(lds, g, S, E); }
#endif
    GSYNC();
    if (PH(14)) { pg8::Gemm g{(const bf16_t*)(ws + WS_ACT), (const bf16_t*)(ws + WS_WD), M, DM, DFF, DFF, DFF}; pg8::StaticOrder S; S.init(M, DM, G, bx);
      pg8::EpiPlain E{(bf16_t*)(ws + WS_O), DM}; pg8::gemm_phase<pg8::EpiPlain, pg8::StaticOrder, P69_ALIGN, true>(lds, g, S, E); }
#if defined(DUP_P9)
    if (PH(14)) { pg8::Gemm g{(const bf16_t*)(ws + WS_ACT), (const bf16_t*)(ws + WS_WD), M, DM, DFF, DFF, DFF}; pg8::StaticOrder S; S.init(M, DM, G, bx);
      pg8::EpiPlain E{(bf16_t*)(ws + WS_O), DM}; pg8::gemm_phase<pg8::EpiPlain, pg8::StaticOrder, P69_ALIGN, true>(lds, g, S, E); }
#endif
    GSYNC();
    if (PH(15)) for (int rep = 0; rep < REP_D; ++rep) { p10_rows(P, lds, G); __syncthreads(); }
}

extern "C" void kernel_launch(void* const* d_in, const int* in_sizes, int n_in, void* d_out, int out_size, void* d_ws, size_t ws_size, hipStream_t stream) {
    static int grid = 0;
    if (grid == 0) {
        if (n_in != 22 || in_sizes[0] != M * DM || out_size != M * DM || ws_size < WS_END) { fprintf(stderr, "kernel_launch: unexpected shapes (n_in %d, in0 %d, out %d, ws %zu)\n", n_in, n_in > 0 ? in_sizes[0] : -1, out_size, ws_size); grid = -1; return; }
        int dev = 0, cus = 0, per_cu = 0;
        (void)hipGetDevice(&dev); (void)hipDeviceGetAttribute(&cus, hipDeviceAttributeMultiprocessorCount, dev);
        if (hipFuncSetAttribute((const void*)hybrid_block_fwd, hipFuncAttributeMaxDynamicSharedMemorySize, LDS_BYTES) != hipSuccess) { fprintf(stderr, "kernel_launch: hipFuncSetAttribute failed\n"); grid = -1; return; }
        if (hipOccupancyMaxActiveBlocksPerMultiprocessor(&per_cu, (const void*)hybrid_block_fwd, NTHREADS, LDS_BYTES) != hipSuccess || per_cu < 1) { fprintf(stderr, "kernel_launch: occupancy query failed (%d)\n", per_cu); (void)hipGetLastError(); grid = -1; return; }
        grid = cus;
    }
    if (grid < 0) return;
    Params p{};
    const float* const* fin = (const float* const*)d_in;
    p.x = fin[0]; p.c = fin[1]; p.pos = (const int*)d_in[2]; p.w_ada = fin[3]; p.b_ada = fin[4]; p.g_pre_mix = fin[5]; p.g_post_mix = fin[6]; p.w_in = fin[7]; p.g_q = fin[8]; p.w_uq = fin[9];
    p.g_kv = fin[10]; p.w_uk = fin[11]; p.w_uv = fin[12]; p.w_gate_up = fin[13]; p.b_gate = fin[14]; p.g_gla = fin[15]; p.w_out = fin[16]; p.g_pre_ffn = fin[17]; p.g_post_ffn = fin[18];
    p.w_fg = fin[19]; p.w_fu = fin[20]; p.w_fd = fin[21]; p.out = (float*)d_out; p.ws = (unsigned char*)d_ws;
    if (hipMemsetAsync((char*)d_ws + WS_CTL, 0, CTL_BYTES, stream) != hipSuccess) { fprintf(stderr, "kernel_launch: memset failed\n"); return; }
    void* args[] = {&p};
    hipError_t e = hipLaunchCooperativeKernel((const void*)hybrid_block_fwd, dim3(grid), dim3(NTHREADS), args, LDS_BYTES, stream);
    if (e != hipSuccess) fprintf(stderr, "cooperative launch failed: %s (grid %d)\n", hipGetErrorString(e), grid);
}
```

```cpp
#define P3_SP2 false
#include <hip/hip_runtime.h>
#include <hip/hip_cooperative_groups.h>
#include <cstdio>
#include <cstdint>
#include <cmath>
namespace cg = cooperative_groups;
namespace pg8 {
#define PG8_LAS __attribute__((address_space(3)))
typedef unsigned short bf16_t;
typedef short bf16x8 __attribute__((ext_vector_type(8)));
typedef float f32x4 __attribute__((ext_vector_type(4)));
typedef unsigned u32x4 __attribute__((ext_vector_type(4)));
constexpr int BM = 256, BK = 64, HALF = 128, HTB = HALF * BK * 2  , STAGE_BYTES = 8 * HTB, NXCD = 8, WGM = 8;

__host__ __device__ __forceinline__ int lds_byte(int r, int c) { const int st = (r >> 4) * 2 + (c >> 5), rr = r & 15, cc = c & 31, ob = rr * 64 + cc * 2; return st * 1024 + (ob ^ (((ob >> 9) & 1) << 5)); }
__host__ __device__ __forceinline__ void stage_rc(int b, int& R, int& C) { const int st = b / 1024, sb = b % 1024, swz = sb ^ (((sb >> 9) & 1) << 5); R = (st >> 1) * 16 + swz / 64; C = (st & 1) * 32 + (swz % 64) / 2; }
__host__ __device__ __forceinline__ int perm32(int rho) { const int n = rho >> 4, i = rho & 15; return 8 * (i >> 2) + 4 * n + (i & 3); }

struct Unit { int pm, pn; };
struct Gemm { const bf16_t* A; const bf16_t* Bt; int M, N, K, lda, ldb; };

struct StaticOrder {
    int nM, nN, nwg, G, c;
    __host__ __device__ void init(int M, int N, int G_, int c_) { nM = M / BM; nN = N / BM; nwg = nM * nN; G = G_; c = c_; }
    __host__ __device__ bool next(int i, Unit& u) const {
        const long L = (long)i * G + c; if (L >= nwg) return false;
        int wgid = (int)L; { const int q = nwg / NXCD, r = nwg % NXCD, xcd = wgid % NXCD, off = wgid / NXCD; wgid = (xcd < r ? xcd * (q + 1) : r * (q + 1) + (xcd - r) * q) + off; }
        const int nig = WGM * nN, gid = wgid / nig, fm = gid * WGM, gsz = (nM - fm) < WGM ? (nM - fm) : WGM;
        u.pm = fm + ((wgid % nig) % gsz); u.pn = (wgid % nig) / gsz; return true;
    }
    __device__ __forceinline__ void a_ready(const Unit&) const {}
    __device__ __forceinline__ void done(const Unit&) const {}
};

__device__ __forceinline__ unsigned cvt_pk_bf16(float lo, float hi) { unsigned r; asm volatile("v_cvt_pk_bf16_f32 %0, %1, %2" : "=v"(r) : "v"(lo), "v"(hi)); return r; }
typedef float f32x2 __attribute__((ext_vector_type(2)));
template <class Epi, class Sched, bool ALIGN_EPI = false, bool SP2 = false>
__device__ __forceinline__ void gemm_phase(PG8_LAS unsigned char* lds, const Gemm g, const Sched& S, const Epi& E) {
    int tid_ = threadIdx.x; asm volatile("" : "+v"(tid_)); const int tid = tid_, wid = __builtin_amdgcn_readfirstlane(tid >> 6), lane = tid & 63, wr = wid >> 2, wc = wid & 3, fr = lane & 15, fq = lane >> 4;
    const int K = g.K, nt = K / BK;
    unsigned voffA[2], voffB[2];
#pragma unroll
    for (int i = 0; i < 2; ++i) { int R, C; stage_rc(tid * 16 + i * 8192, R, C); const int Rb = Epi::PERM ? ((R & ~31) + perm32(R & 31)) : R;
        voffA[i] = (unsigned)(R * g.lda + C) * 2u; voffB[i] = (unsigned)(Rb * g.ldb + C) * 2u; }
    const size_t kstep = (size_t)(BK * 2);
    const size_t hstepA = (size_t)HALF * g.lda * 2, hstepB = (size_t)HALF * g.ldb * 2;
    const size_t tstepA = 2 * hstepA, tstepB = 2 * hstepB;
    const unsigned ldsw = (unsigned)wid * 1024u;
    const int aoff = lds_byte(wr * 64 + fr, fq * 8), boff = lds_byte(wc * 32 + fr, fq * 8);
#define PG8_SA(b, h) (((b) * 2 + (h)) * HTB)
#define PG8_SB(b, h) ((4 + (b) * 2 + (h)) * HTB)
#define PG8_STAGE(bufoff, gbase, voff) do { _Pragma("unroll") for (int _i = 0; _i < 2; ++_i) \
        __builtin_amdgcn_global_load_lds((const unsigned*)((const char*)(gbase) + (voff)[_i]), (PG8_LAS unsigned*)(lds + (bufoff) + ldsw + _i * 8192), 16, 0, 0); } while (0)
#define PG8_LDA(dst, b, h) do { _Pragma("unroll") for (int m = 0; m < 4; ++m) _Pragma("unroll") for (int k = 0; k < 2; ++k) dst[m][k] = *(const PG8_LAS bf16x8*)(lds + PG8_SA(b, h) + aoff + m * 2048 + k * 1024); } while (0)
#define PG8_LDB(dst, b, h) do { _Pragma("unroll") for (int n = 0; n < 2; ++n) _Pragma("unroll") for (int k = 0; k < 2; ++k) dst[n][k] = *(const PG8_LAS bf16x8*)(lds + PG8_SB(b, h) + boff + n * 2048 + k * 1024); } while (0)
#define PG8_MMA(ai, bj, At, Bt) do { __builtin_amdgcn_s_setprio(1); _Pragma("unroll") for (int m = 0; m < 4; ++m) _Pragma("unroll") for (int n = 0; n < 2; ++n) _Pragma("unroll") for (int k = 0; k < 2; ++k) \
        acc[ai][bj][m][n] = __builtin_amdgcn_mfma_f32_16x16x32_bf16(Bt[n][k], At[m][k], acc[ai][bj][m][n], 0, 0, 0); __builtin_amdgcn_s_setprio(0); } while (0)
#define PG8_WAIT_V(n) asm volatile("s_waitcnt vmcnt(" #n ")" ::: "memory")
#define PG8_WAIT_L(n) asm volatile("s_waitcnt lgkmcnt(" #n ")" ::: "memory")
#define PG8_BAR __builtin_amdgcn_s_barrier()
#define PG8_SCHED __builtin_amdgcn_sched_barrier(0)
    Unit cur, nxt; int ui = 0;
    if (!S.next(0, cur)) return;
    f32x4 acc[2][2][4][2];
#pragma unroll
    for (int a = 0; a < 2; ++a)
#pragma unroll
        for (int b = 0; b < 2; ++b)
#pragma unroll
            for (int m = 0; m < 4; ++m)
#pragma unroll
                for (int n = 0; n < 2; ++n) acc[a][b][m][n] = (f32x4){0.f, 0.f, 0.f, 0.f};
    bf16x8 At[4][2], B0[2][2], B1[2][2];
    const char* cA = (const char*)g.A + (size_t)cur.pm * tstepA; const char* cB = (const char*)g.Bt + (size_t)cur.pn * tstepB;
    S.a_ready(cur);
    if constexpr (SP2) {
        PG8_STAGE(PG8_SB(0, 0), cB, voffB); PG8_STAGE(PG8_SB(0, 1), cB + hstepB, voffB); PG8_STAGE(PG8_SA(0, 0), cA, voffA); PG8_STAGE(PG8_SA(0, 1), cA + hstepA, voffA);
        if (wr == 1) PG8_BAR;
        PG8_WAIT_V(2); PG8_BAR;
        PG8_STAGE(PG8_SB(1, 0), cB + kstep, voffB); PG8_STAGE(PG8_SA(1, 0), cA + kstep, voffA); PG8_STAGE(PG8_SB(1, 1), cB + hstepB + kstep, voffB);
        PG8_WAIT_V(6); PG8_BAR;
    } else {
        PG8_STAGE(PG8_SB(0, 0), cB, voffB); PG8_STAGE(PG8_SA(0, 0), cA, voffA); PG8_STAGE(PG8_SB(0, 1), cB + hstepB, voffB); PG8_STAGE(PG8_SA(0, 1), cA + hstepA, voffA);
        if (wr == 1) PG8_BAR;
        PG8_WAIT_V(4); PG8_BAR;
        PG8_STAGE(PG8_SB(1, 0), cB + kstep, voffB); PG8_STAGE(PG8_SA(1, 0), cA + kstep, voffA); PG8_STAGE(PG8_SB(1, 1), cB + hstepB + kstep, voffB);
        PG8_WAIT_V(6); PG8_BAR;
    }
    for (;;) {
        const bool has_next = S.next(ui + 1, nxt);
        const char* nA = has_next ? (const char*)g.A + (size_t)nxt.pm * tstepA : cA; const char* nB = has_next ? (const char*)g.Bt + (size_t)nxt.pn * tstepB : cB;
        for (int t = 0; t < nt; t += 2) {
            const bool last = (t == nt - 2);
            const char* a1 = cA + (size_t)(t + 1) * kstep;
            const char* a2 = last ? nA : cA + (size_t)(t + 2) * kstep; const char* b2 = last ? nB : cB + (size_t)(t + 2) * kstep;
            const char* a3 = a2 + kstep; const char* b3 = b2 + kstep;
            if (last && has_next) S.a_ready(nxt);
            if constexpr (SP2) {
            PG8_LDB(B0, 0, 0); PG8_LDB(B1, 0, 1); PG8_SCHED; PG8_LDA(At, 0, 0); PG8_STAGE(PG8_SA(1, 1), a1 + hstepA, voffA);
            PG8_WAIT_V(8); PG8_WAIT_L(0); PG8_BAR; PG8_MMA(0, 0, At, B0); PG8_MMA(0, 1, At, B1); PG8_BAR; PG8_SCHED;
            PG8_LDA(At, 0, 1); PG8_STAGE(PG8_SB(0, 0), b2, voffB); PG8_STAGE(PG8_SB(0, 1), b2 + hstepB, voffB); PG8_STAGE(PG8_SA(0, 0), a2, voffA);
            PG8_WAIT_V(8); PG8_WAIT_L(0); PG8_BAR; PG8_MMA(1, 0, At, B0); PG8_MMA(1, 1, At, B1); PG8_BAR; PG8_SCHED;
            PG8_LDB(B0, 1, 0); PG8_LDB(B1, 1, 1); PG8_SCHED; PG8_LDA(At, 1, 0); PG8_STAGE(PG8_SA(0, 1), a2 + hstepA, voffA);
            PG8_WAIT_V(8); PG8_WAIT_L(0); PG8_BAR; PG8_MMA(0, 0, At, B0); PG8_MMA(0, 1, At, B1); PG8_BAR; PG8_SCHED;
            PG8_LDA(At, 1, 1); PG8_STAGE(PG8_SB(1, 0), b3, voffB); PG8_STAGE(PG8_SB(1, 1), b3 + hstepB, voffB); PG8_STAGE(PG8_SA(1, 0), a3, voffA);
            PG8_WAIT_V(8); PG8_WAIT_L(0); PG8_BAR; PG8_MMA(1, 0, At, B0); PG8_MMA(1, 1, At, B1); PG8_BAR; PG8_SCHED;
            } else {
            PG8_LDB(B0, 0, 0); PG8_SCHED; PG8_LDA(At, 0, 0); PG8_STAGE(PG8_SA(1, 1), a1 + hstepA, voffA);
            PG8_WAIT_L(8); PG8_BAR; PG8_WAIT_L(0); PG8_MMA(0, 0, At, B0); PG8_BAR; PG8_SCHED;
            PG8_LDB(B1, 0, 1); PG8_STAGE(PG8_SB(0, 0), b2, voffB);
            PG8_BAR; PG8_WAIT_L(0); PG8_MMA(0, 1, At, B1); PG8_BAR;
            PG8_LDA(At, 0, 1); PG8_STAGE(PG8_SA(0, 0), a2, voffA);
            PG8_BAR; PG8_WAIT_L(0); PG8_MMA(1, 0, At, B0); PG8_BAR; PG8_SCHED;
            PG8_STAGE(PG8_SB(0, 1), b2 + hstepB, voffB);
            PG8_WAIT_V(6); PG8_BAR; PG8_MMA(1, 1, At, B1); PG8_BAR;
            PG8_LDB(B0, 1, 0); PG8_SCHED; PG8_LDA(At, 1, 0); PG8_STAGE(PG8_SA(0, 1), a2 + hstepA, voffA);
            PG8_WAIT_L(8); PG8_BAR; PG8_WAIT_L(0); PG8_MMA(0, 0, At, B0); PG8_BAR; PG8_SCHED;
            PG8_LDB(B1, 1, 1); PG8_STAGE(PG8_SB(1, 0), b3, voffB);
            PG8_BAR; PG8_WAIT_L(0); PG8_MMA(0, 1, At, B1); PG8_BAR;
            PG8_LDA(At, 1, 1); PG8_STAGE(PG8_SA(1, 0), a3, voffA);
            PG8_BAR; PG8_WAIT_L(0); PG8_MMA(1, 0, At, B0); PG8_BAR; PG8_SCHED;
            PG8_STAGE(PG8_SB(1, 1), b3 + hstepB, voffB);
            PG8_WAIT_V(6); PG8_BAR; PG8_MMA(1, 1, At, B1); PG8_BAR;
            }
        }
        if constexpr (ALIGN_EPI) { if (wr == 0) PG8_BAR; }
        if constexpr (!Epi::AFTER_DRAIN) { E(acc, cur, wr, wc, fr, fq); S.done(cur); }
        if (!has_next) break;
#pragma unroll
        for (int a = 0; a < 2; ++a)
#pragma unroll
            for (int b = 0; b < 2; ++b)
#pragma unroll
                for (int m = 0; m < 4; ++m)
#pragma unroll
                    for (int n = 0; n < 2; ++n) acc[a][b][m][n] = (f32x4){0.f, 0.f, 0.f, 0.f};
        cur = nxt; cA = nA; cB = nB; ++ui;
        if constexpr (ALIGN_EPI) { if (wr == 1) PG8_BAR; }
    }
    PG8_WAIT_V(0);
    if constexpr (!ALIGN_EPI) { if (wr == 0) PG8_BAR; }
    PG8_BAR;
    if constexpr (Epi::AFTER_DRAIN) { E.fused(acc, cur, wr, wc, fr, fq, lds, wid, lane); S.done(cur); }
#undef PG8_SA
#undef PG8_SB
#undef PG8_STAGE
#undef PG8_LDA
#undef PG8_LDB
#undef PG8_MMA
#undef PG8_WAIT_V
#undef PG8_WAIT_L
#undef PG8_BAR
#undef PG8_SCHED
}
}
namespace pg8 {
__device__ __forceinline__ unsigned cvtpk(float lo, float hi) { typedef float f2_t __attribute__((ext_vector_type(2))); typedef __bf16 b2_t __attribute__((ext_vector_type(2))); f2_t v = {lo, hi}; b2_t b = __builtin_convertvector(v, b2_t); return __builtin_bit_cast(unsigned, b); }
__device__ __forceinline__ u32x4 pack8(const f32x4& v0, const f32x4& v1) { u32x4 w; w.x = cvtpk(v0[0], v0[1]); w.y = cvtpk(v0[2], v0[3]); w.z = cvtpk(v1[0], v1[1]); w.w = cvtpk(v1[2], v1[3]); return w; }
struct EpiPlain {
    static constexpr bool PERM = true, AFTER_DRAIN = false;
    bf16_t* O; int ldc;
    __device__ __forceinline__ void operator()(const f32x4 (&acc)[2][2][4][2], const Unit& u, int wr, int wc, int fr, int fq) const {
        const int row0 = u.pm * BM + wr * 64 + fr, col0 = u.pn * BM + wc * 32 + 8 * fq;
#pragma unroll
        for (int ai = 0; ai < 2; ++ai)
#pragma unroll
            for (int m = 0; m < 4; ++m) { bf16_t* rowp = O + (size_t)(row0 + ai * HALF + m * 16) * ldc + col0;
#pragma unroll
                for (int bj = 0; bj < 2; ++bj) *(u32x4*)(rowp + bj * HALF) = pack8(acc[ai][bj][m][0], acc[ai][bj][m][1]); }
    }
};
struct EpiRowScaleRope {
    static constexpr bool PERM = true, AFTER_DRAIN = false;
    bf16_t* O; int ldc; float mult; int rope_pn0; const float* cs;
    __device__ __forceinline__ void operator()(const f32x4 (&acc)[2][2][4][2], const Unit& u, int wr, int wc, int fr, int fq) const {
        const int row0 = u.pm * BM + wr * 64 + fr, col0 = u.pn * BM + wc * 32 + 8 * fq;
        const bool rope = u.pn >= rope_pn0;
#pragma unroll
        for (int ai = 0; ai < 2; ++ai)
#pragma unroll
            for (int m = 0; m < 4; ++m) { const int row = row0 + ai * HALF + m * 16; const float s = mult;
                f32x4 a0 = acc[ai][0][m][0] * s, a1 = acc[ai][0][m][1] * s, b0 = acc[ai][1][m][0] * s, b1 = acc[ai][1][m][1] * s;
                if (rope) { const f32x4* cp = (const f32x4*)(cs + (size_t)row * 64 + 16 * fq);
                    const f32x4 c0 = cp[0], c1 = cp[1], c2 = cp[2], c3 = cp[3];
                    f32x4 x0, x1, y0, y1;
                    x0[0] = a0[0] * c0[0] - b0[0] * c0[1]; y0[0] = b0[0] * c0[0] + a0[0] * c0[1];
                    x0[1] = a0[1] * c0[2] - b0[1] * c0[3]; y0[1] = b0[1] * c0[2] + a0[1] * c0[3];
                    x0[2] = a0[2] * c1[0] - b0[2] * c1[1]; y0[2] = b0[2] * c1[0] + a0[2] * c1[1];
                    x0[3] = a0[3] * c1[2] - b0[3] * c1[3]; y0[3] = b0[3] * c1[2] + a0[3] * c1[3];
                    x1[0] = a1[0] * c2[0] - b1[0] * c2[1]; y1[0] = b1[0] * c2[0] + a1[0] * c2[1];
                    x1[1] = a1[1] * c2[2] - b1[1] * c2[3]; y1[1] = b1[1] * c2[2] + a1[1] * c2[3];
                    x1[2] = a1[2] * c3[0] - b1[2] * c3[1]; y1[2] = b1[2] * c3[0] + a1[2] * c3[1];
                    x1[3] = a1[3] * c3[2] - b1[3] * c3[3]; y1[3] = b1[3] * c3[2] + a1[3] * c3[3];
                    a0 = x0; a1 = x1; b0 = y0; b1 = y1; }
                bf16_t* rowp = O + (size_t)row * ldc + col0;
                *(u32x4*)(rowp) = pack8(a0, a1); *(u32x4*)(rowp + HALF) = pack8(b0, b1); }
    }
};
struct EpiColScale {
    static constexpr bool PERM = true, AFTER_DRAIN = false;
    bf16_t* O; int ldc; const float* cscale;
    __device__ __forceinline__ void operator()(const f32x4 (&acc)[2][2][4][2], const Unit& u, int wr, int wc, int fr, int fq) const {
        const int row0 = u.pm * BM + wr * 64 + fr, col0 = u.pn * BM + wc * 32 + 8 * fq;
#pragma unroll
        for (int bj = 0; bj < 2; ++bj) { const f32x4 s0 = *(const f32x4*)(cscale + col0 + bj * HALF), s1 = *(const f32x4*)(cscale + col0 + bj * HALF + 4);
#pragma unroll
            for (int ai = 0; ai < 2; ++ai)
#pragma unroll
                for (int m = 0; m < 4; ++m) *(u32x4*)(O + (size_t)(row0 + ai * HALF + m * 16) * ldc + col0 + bj * HALF) = pack8(acc[ai][bj][m][0] * s0, acc[ai][bj][m][1] * s1);
            asm volatile("" ::: "memory"); }
    }
};
struct EpiSwiGLU {
    static constexpr bool PERM = true, AFTER_DRAIN = false;
    bf16_t* O; int ldc;
    __device__ __forceinline__ void operator()(const f32x4 (&acc)[2][2][4][2], const Unit& u, int wr, int wc, int fr, int fq) const {
        const int row0 = u.pm * BM + wr * 64 + fr, col0 = u.pn * HALF + wc * 32 + 8 * fq;
#pragma unroll
        for (int ai = 0; ai < 2; ++ai)
#pragma unroll
            for (int m = 0; m < 4; ++m) { f32x4 r[2];
#pragma unroll
                for (int n = 0; n < 2; ++n) { const f32x4 g = acc[ai][0][m][n], up = acc[ai][1][m][n];
#pragma unroll
                    for (int e = 0; e < 4; ++e) r[n][e] = g[e] * __builtin_amdgcn_rcpf(1.0f + __expf(-g[e])) * up[e]; }
                *(u32x4*)(O + (size_t)(row0 + ai * HALF + m * 16) * ldc + col0) = pack8(r[0], r[1]); }
    }
};
}
#define LAS __attribute__((address_space(3)))
typedef unsigned short bf16_t;
typedef short bf16x8 __attribute__((ext_vector_type(8)));
typedef float f32x4 __attribute__((ext_vector_type(4)));
typedef unsigned u32x4 __attribute__((ext_vector_type(4)));
typedef unsigned u32x2 __attribute__((ext_vector_type(2)));
constexpr int BATCH = 2, SEQ = 8192, DM = 2048, M = BATCH * SEQ, DFF = 5632, NADA = 6 * DM;
constexpr int ZC = 4096;
constexpr int ZO_CQ = 0, ZO_CKV = 512, ZO_QG = 768, ZO_KG = 1280, ZO_VG = 1792, ZO_RG = 2816, ZO_KR = 3840, ZO_AG = 3904;
constexpr int QC = 1536;
constexpr float RMS_EPS = 1e-6f;
constexpr float QSCALE = 0.07216878364870323f * 1.4426950408889634f;
constexpr int KS_ADA = 16;
constexpr size_t MiB = 1u << 20;
constexpr size_t WS_ADAP = 0, WS_ADA = 1536 * 1024, WS_RSTDQ = 1792 * 1024, WS_RSTDKV = 1856 * 1024, WS_DECAY = 2 * MiB, WS_CS = 3 * MiB, WS_KROPE = 7 * MiB;
constexpr size_t WS_WIN = 10 * MiB, WS_WUQ = 26 * MiB, WS_WUK = 28 * MiB, WS_WUV = 29 * MiB, WS_WOUT = 30 * MiB, WS_WGU = 38 * MiB, WS_WD = 82 * MiB;
constexpr size_t WS_XN = 104 * MiB;
constexpr size_t WS_Q = 168 * MiB, WS_KN = 216 * MiB, WS_VT = 248 * MiB, WS_QDEC = 280 * MiB, WS_OI = 296 * MiB, WS_ST = 328 * MiB;
constexpr size_t WS_O = 168 * MiB;
constexpr size_t WS_ACT = 232 * MiB, WS_CQN = 392 * MiB, WS_CKVN = 408 * MiB, WS_X1 = 416 * MiB, WS_END = 480 * MiB;
constexpr size_t WS_CTL = 9 * MiB, CTL_BYTES = 65536;
constexpr int NTHREADS = 512, LDS_BYTES = 147456, MISC_OFF = 131072 + 320;

__device__ const double INVF_REV[32] = {
    1.59154943091895346e-01,
    1.19349370211248862e-01,
    8.94994016088910133e-02,
    6.71150830052272551e-02,
    5.03292121044870353e-02,
    3.77415847174197711e-02,
    2.83021958306233987e-02,
    2.12236527647776604e-02,
    1.59154943091895339e-02,
    1.19349370211248862e-02,
    8.94994016088910237e-03,
    6.71150830052272534e-03,
    5.03292121044870370e-03,
    3.77415847174197719e-03,
    2.83021958306233987e-03,
    2.12236527647776622e-03,
    1.59154943091895356e-03,
    1.19349370211248849e-03,
    8.94994016088910237e-04,
    6.71150830052272599e-04,
    5.03292121044870326e-04,
    3.77415847174197741e-04,
    2.83021958306233954e-04,
    2.12236527647776605e-04,
    1.59154943091895351e-04,
    1.19349370211248862e-04,
    8.94994016088910182e-05,
    6.71150830052272545e-05,
    5.03292121044870354e-05,
    3.77415847174197768e-05,
    2.83021958306233961e-05,
    2.12236527647776592e-05

};

struct Params {
    const float *x, *c; const int* pos; const float *w_ada, *b_ada, *g_pre_mix, *g_post_mix, *w_in, *g_q, *w_uq, *g_kv, *w_uk, *w_uv, *w_gate_up, *b_gate, *g_gla, *w_out, *g_pre_ffn, *g_post_ffn, *w_fg, *w_fu, *w_fd;
    float* out; unsigned char* ws;
};

__device__ __forceinline__ int opaque_tid() { int t = threadIdx.x; asm volatile("" : "+v"(t)); return t; }
__device__ __forceinline__ float bf2f(unsigned short u) { return __uint_as_float((unsigned)u << 16); }
__device__ __forceinline__ unsigned short f2bf(float f) { unsigned u = __float_as_uint(f); return (unsigned short)((u + 0x7fffu + ((u >> 16) & 1u)) >> 16); }
__device__ __forceinline__ unsigned pk2(float lo, float hi) { return pg8::cvtpk(lo, hi); }
__device__ __forceinline__ float wave_sum(float v) {
#pragma unroll
    for (int o = 1; o < 64; o <<= 1) v += __shfl_xor(v, o);
    return v;
}
__device__ __forceinline__ float silu_f(float v) { return v * __builtin_amdgcn_rcpf(1.0f + __expf(-v)); }
#define MFMA16(a, b, c) __builtin_amdgcn_mfma_f32_16x16x32_bf16((a), (b), (c), 0, 0, 0)

struct MapIn { const float* W;
    __device__ __forceinline__ const float* col(int n, int& ld) const { ld = 3920; int s;
        if (n < 768) s = n; else if (n < 1280) s = 832 + (n - 768); else if (n < 1792) s = 1344 + (n - 1280); else if (n < 2816) s = 1856 + (n - 1792);
        else if (n < 3840) s = 2896 + (n - 2816); else if (n < 3904) s = 768 + (n - 3840); else if (n < 3920) s = 2880 + (n - 3904); else return nullptr;
        return W + s; } };
struct MapUq { const float* W;
    __device__ __forceinline__ const float* col(int n, int& ld) const { ld = 1536; int s;
        if (n < 1024) s = (n >> 7) * 192 + (n & 127);
        else { const int mm = n - 1024, tile = mm >> 8, w = mm & 255, half = w >> 7, hh = (w & 127) >> 5, i = w & 31; s = (tile * 4 + hh) * 192 + 128 + half * 32 + i; }
        return W + s; } };
struct MapId { const float* W; int ldw;
    __device__ __forceinline__ const float* col(int n, int& ld) const { ld = ldw; return W + n; } };
struct MapGU { const float* Wg; const float* Wu;
    __device__ __forceinline__ const float* col(int n, int& ld) const { ld = DFF; const int tile = n >> 8, w = n & 255; return (w < 128) ? (Wg + tile * 128 + w) : (Wu + tile * 128 + (w - 128)); } };
template <class Map>
__device__ __forceinline__ void transpose_item(const Map& mp, const float* gain, int K, bf16_t* WT, int item, int nblk, int lane, bool late = false) {
    const int kb = item / nblk, nb = item % nblk, k0 = 64 * kb, n0 = 64 * nb, kq = lane >> 4, nc = lane & 15;
    int ld; const float* src = mp.col(n0 + 4 * nc, ld);
    f32x4 v[16];
    if (src) { src += (size_t)(k0 + 16 * kq) * ld;
#pragma unroll
        for (int i = 0; i < 16; ++i) v[i] = __builtin_nontemporal_load((const f32x4*)(src + (size_t)i * ld));
    } else {
#pragma unroll
        for (int i = 0; i < 16; ++i) v[i] = (f32x4){0.f, 0.f, 0.f, 0.f};
    }
    if (gain) {
#pragma unroll
        for (int i = 0; i < 16; ++i) v[i] *= gain[k0 + 16 * kq + i];
    }
#pragma unroll
    for (int e = 0; e < 4; ++e) { bf16_t* dst = WT + (size_t)(n0 + 4 * nc + e) * K + k0 + 16 * kq;
        u32x4 w0, w1; w0.x = pk2(v[0][e], v[1][e]); w0.y = pk2(v[2][e], v[3][e]); w0.z = pk2(v[4][e], v[5][e]); w0.w = pk2(v[6][e], v[7][e]);
        w1.x = pk2(v[8][e], v[9][e]); w1.y = pk2(v[10][e], v[11][e]); w1.z = pk2(v[12][e], v[13][e]); w1.w = pk2(v[14][e], v[15][e]);
        if (late) { __builtin_nontemporal_store(w0, (u32x4*)dst); __builtin_nontemporal_store(w1, (u32x4*)(dst + 8)); }
        else { *(u32x4*)dst = w0; *(u32x4*)(dst + 8) = w1; } }
}

__device__ __forceinline__ void p0_prologue(const Params& P, LAS unsigned char* lds, int G) {
    const int tid = opaque_tid(), lane = tid & 63, wave = tid >> 6;
    unsigned char* ws = P.ws;
    const int gw = wave * G + blockIdx.x, NGW = G * 8;
    float* adap = (float*)(ws + WS_ADAP);
    for (int it = gw; it < 48 * KS_ADA; it += NGW) {
        const int nc = it % 48, ks = it / 48, n0 = nc * 256 + lane * 4;
        f32x4 a0 = {0.f, 0.f, 0.f, 0.f}, a1 = {0.f, 0.f, 0.f, 0.f};
#pragma unroll 16
        for (int kk = 0; kk < 128; ++kk) { const int k = ks * 128 + kk; const f32x4 w = __builtin_nontemporal_load((const f32x4*)(P.w_ada + (size_t)k * NADA + n0));
            const float s0 = silu_f(P.c[k]), s1 = silu_f(P.c[DM + k]); a0 += w * s0; a1 += w * s1; }
        *(f32x4*)(adap + (size_t)(ks * 2 + 0) * NADA + n0) = a0; *(f32x4*)(adap + (size_t)(ks * 2 + 1) * NADA + n0) = a1;
    }
    constexpr int I_IN = 32 * 64, I_UQ = 8 * 24, I_UK = 4 * 16, I_UV = 4 * 16, I_OUT = 32 * 32, I_GU = 32 * 176, I_D = 88 * 32;
    constexpr int NITEMS = I_IN + I_UQ + I_UK + I_UV + I_OUT + I_GU + I_D;
    for (int it = gw; it < NITEMS; it += NGW) {
        int r = it;
        if (r < I_IN) { transpose_item(MapIn{P.w_in}, nullptr, 2048, (bf16_t*)(ws + WS_WIN), r, 64, lane); continue; } r -= I_IN;
        if (r < I_UQ) { transpose_item(MapUq{P.w_uq}, P.g_q, 512, (bf16_t*)(ws + WS_WUQ), r, 24, lane); continue; } r -= I_UQ;
        if (r < I_UK) { transpose_item(MapId{P.w_uk, 1024}, P.g_kv, 256, (bf16_t*)(ws + WS_WUK), r, 16, lane); continue; } r -= I_UK;
        if (r < I_UV) { transpose_item(MapId{P.w_uv, 1024}, P.g_kv, 256, (bf16_t*)(ws + WS_WUV), r, 16, lane); continue; } r -= I_UV;
        if (r < I_OUT) { transpose_item(MapId{P.w_out, 2048}, nullptr, 2048, (bf16_t*)(ws + WS_WOUT), r, 32, lane, true); continue; } r -= I_OUT;
        if (r < I_GU) { transpose_item(MapGU{P.w_fg, P.w_fu}, nullptr, 2048, (bf16_t*)(ws + WS_WGU), r, 176, lane, true); continue; } r -= I_GU;
        transpose_item(MapId{P.w_fd, 2048}, nullptr, DFF, (bf16_t*)(ws + WS_WD), r, 32, lane, true);
    }
    float* cs = (float*)(ws + WS_CS);
    for (int idx = blockIdx.x * NTHREADS + tid; idx < M * 32; idx += G * NTHREADS) {
        const int m = idx >> 5, i = idx & 31; const double rev = (double)P.pos[m] * INVF_REV[i]; const float fr = (float)(rev - floor(rev));
        cs[2 * idx] = __builtin_amdgcn_cosf(fr); cs[2 * idx + 1] = __builtin_amdgcn_sinf(fr);
    }
}

__device__ __forceinline__ void p1_rows(const Params& P, LAS unsigned char* lds, int G) {
    const int tid = opaque_tid(), lane = tid & 63, wave = tid >> 6;
    const float* adap = (const float*)(P.ws + WS_ADAP); float* ada = (float*)(P.ws + WS_ADA);
    LAS float* TA = (LAS float*)lds;
    LAS float* TC = TA + 2 * DM;
    for (int idx = tid; idx < 2 * DM; idx += NTHREADS) { const int b = idx >> 11, col = idx & (DM - 1);
        float sh = P.b_ada[col], sc = P.b_ada[DM + col];
        for (int ks = 0; ks < KS_ADA; ++ks) { sh += adap[(size_t)(ks * 2 + b) * NADA + col]; sc += adap[(size_t)(ks * 2 + b) * NADA + DM + col]; }
        TA[idx] = P.g_pre_mix[col] * (1.0f + sc); TC[idx] = sh; }
    for (int idx = blockIdx.x * NTHREADS + tid; idx < 2 * NADA; idx += G * NTHREADS) { const int b = idx / NADA, n = idx % NADA; float v = P.b_ada[n];
        for (int ks = 0; ks < KS_ADA; ++ks) v += adap[(size_t)(ks * 2 + b) * NADA + n];
        ada[idx] = v; }
    __syncthreads();
    bf16_t* XN = (bf16_t*)(P.ws + WS_XN);
    for (int m = blockIdx.x * 8 + wave; m < M; m += G * 8) {
        const int b = m >> 13; const f32x4* xr = (const f32x4*)(P.x + (size_t)m * DM) + lane;
        f32x4 v[8]; float ss = 0.f;
#pragma unroll
        for (int j = 0; j < 8; ++j) { v[j] = __builtin_nontemporal_load(xr + 64 * j); ss += (v[j][0] * v[j][0] + v[j][1] * v[j][1]) + (v[j][2] * v[j][2] + v[j][3] * v[j][3]); }
        const float rstd = rsqrtf(wave_sum(ss) * (1.0f / DM) + RMS_EPS);
        u32x2* o = (u32x2*)(XN + (size_t)m * DM) + lane;
#pragma unroll
        for (int j = 0; j < 8; ++j) { const f32x4 a = *(const LAS f32x4*)(TA + b * DM + 256 * j + 4 * lane), c = *(const LAS f32x4*)(TC + b * DM + 256 * j + 4 * lane);
            const f32x4 h = v[j] * rstd * a + c; u32x2 w; w.x = pk2(h[0], h[1]); w.y = pk2(h[2], h[3]); o[64 * j] = w; }
    }
}
__device__ __forceinline__ void p2b_rows(const Params& P, int G) {
    const int tid = opaque_tid(), lane = tid & 63, wave = tid >> 6;
    const bf16_t* Z = (const bf16_t*)P.out; bf16_t* CQN = (bf16_t*)(P.ws + WS_CQN); bf16_t* CKVN = (bf16_t*)(P.ws + WS_CKVN);
    const float* cs = (const float*)(P.ws + WS_CS); bf16_t* KR = (bf16_t*)(P.ws + WS_KROPE);
    for (int m = blockIdx.x * 8 + wave; m < M; m += G * 8) {
        const bf16_t* zr = Z + (size_t)m * ZC;
        const u32x4 a = *(const u32x4*)(zr + ZO_CQ + 8 * lane); const u32x2 k = *(const u32x2*)(zr + ZO_CKV + 4 * lane);
        float s1 = 0.f, s2 = 0.f;
#pragma unroll
        for (int e = 0; e < 4; ++e) { const float lo = __uint_as_float(a[e] << 16), hi = __uint_as_float(a[e] & 0xffff0000u); s1 += lo * lo + hi * hi; }
#pragma unroll
        for (int e = 0; e < 2; ++e) { const float lo = __uint_as_float(k[e] << 16), hi = __uint_as_float(k[e] & 0xffff0000u); s2 += lo * lo + hi * hi; }
        s1 = wave_sum(s1); s2 = wave_sum(s2);
        const float r1 = rsqrtf(s1 * (1.0f / 512.0f) + RMS_EPS), r2 = rsqrtf(s2 * (1.0f / 256.0f) + RMS_EPS);
        { u32x4 w;
#pragma unroll
          for (int e = 0; e < 4; ++e) w[e] = pk2(__uint_as_float(a[e] << 16) * r1, __uint_as_float(a[e] & 0xffff0000u) * r1);
          *(u32x4*)(CQN + (size_t)m * 512 + 8 * lane) = w;
          u32x2 w2;
#pragma unroll
          for (int e = 0; e < 2; ++e) w2[e] = pk2(__uint_as_float(k[e] << 16) * r2, __uint_as_float(k[e] & 0xffff0000u) * r2);
          *(u32x2*)(CKVN + (size_t)m * 256 + 4 * lane) = w2; }
        if (lane < 32) { const float x1 = bf2f(zr[ZO_KR + lane]), x2 = bf2f(zr[ZO_KR + 32 + lane]); const float c = cs[(size_t)m * 64 + 2 * lane], s = cs[(size_t)m * 64 + 2 * lane + 1];
            KR[(size_t)m * 64 + lane] = f2bf(x1 * c - x2 * s); KR[(size_t)m * 64 + 32 + lane] = f2bf(x2 * c + x1 * s); }
    }
}
__device__ __forceinline__ void p7_rows(const Params& P, LAS unsigned char* lds, int G) {
    const int tid = opaque_tid(), lane = tid & 63, wave = tid >> 6;
    const float* ada = (const float*)(P.ws + WS_ADA);
    LAS float* TA = (LAS float*)lds; LAS float* TB = TA + 2 * DM; LAS float* TC = TB + 2 * DM;
    for (int idx = tid; idx < 2 * DM; idx += NTHREADS) { const int b = idx >> 11, col = idx & (DM - 1); const float* ab = ada + (size_t)b * NADA;
        TA[idx] = ab[2 * DM + col] * P.g_post_mix[col]; TB[idx] = P.g_pre_ffn[col] * (1.0f + ab[4 * DM + col]); TC[idx] = ab[3 * DM + col]; }
    __syncthreads();
    const bf16_t* O = (const bf16_t*)(P.ws + WS_O); bf16_t* XN = (bf16_t*)(P.ws + WS_XN);
    for (int m = blockIdx.x * 8 + wave; m < M; m += G * 8) {
        const int b = m >> 13; const f32x4* xr = (const f32x4*)(P.x + (size_t)m * DM) + lane; const u32x2* orow = (const u32x2*)(O + (size_t)m * DM) + lane;
        f32x4 v[8], xv[8]; float ss = 0.f;
#pragma unroll
        for (int j = 0; j < 8; ++j) xv[j] = __builtin_nontemporal_load(xr + 64 * j);
#pragma unroll
        for (int j = 0; j < 8; ++j) { const u32x2 w = __builtin_nontemporal_load(orow + 64 * j); v[j][0] = __uint_as_float(w.x << 16); v[j][1] = __uint_as_float(w.x & 0xffff0000u); v[j][2] = __uint_as_float(w.y << 16); v[j][3] = __uint_as_float(w.y & 0xffff0000u);
            ss += (v[j][0] * v[j][0] + v[j][1] * v[j][1]) + (v[j][2] * v[j][2] + v[j][3] * v[j][3]); }
        const float rstd = rsqrtf(wave_sum(ss) * (1.0f / DM) + RMS_EPS);
        float s2 = 0.f; u32x2* x1r = (u32x2*)((bf16_t*)(P.ws + WS_X1) + (size_t)m * DM) + lane;
#pragma unroll
        for (int j = 0; j < 8; ++j) { const f32x4 a = *(const LAS f32x4*)(TA + b * DM + 256 * j + 4 * lane); const f32x4 x1 = xv[j] + v[j] * rstd * a; v[j] = x1; { u32x2 w; w.x = pk2(x1[0], x1[1]); w.y = pk2(x1[2], x1[3]); __builtin_nontemporal_store(w, x1r + 64 * j); }
            s2 += (x1[0] * x1[0] + x1[1] * x1[1]) + (x1[2] * x1[2] + x1[3] * x1[3]); }
        const float rstd2 = rsqrtf(wave_sum(s2) * (1.0f / DM) + RMS_EPS);
        u32x2* o = (u32x2*)(XN + (size_t)m * DM) + lane;
#pragma unroll
        for (int j = 0; j < 8; ++j) { const f32x4 a = *(const LAS f32x4*)(TB + b * DM + 256 * j + 4 * lane), c = *(const LAS f32x4*)(TC + b * DM + 256 * j + 4 * lane);
            const f32x4 h = v[j] * rstd2 * a + c; u32x2 w; w.x = pk2(h[0], h[1]); w.y = pk2(h[2], h[3]); o[64 * j] = w; }
    }
}
__device__ __forceinline__ void p10_rows(const Params& P, LAS unsigned char* lds, int G) {
    const int tid = opaque_tid(), lane = tid & 63, wave = tid >> 6;
    const float* ada = (const float*)(P.ws + WS_ADA);
    LAS float* TA = (LAS float*)lds;
    for (int idx = tid; idx < 2 * DM; idx += NTHREADS) { const int b = idx >> 11, col = idx & (DM - 1); TA[idx] = ada[(size_t)b * NADA + 5 * DM + col] * P.g_post_ffn[col]; }
    __syncthreads();
    const bf16_t* F = (const bf16_t*)(P.ws + WS_O);
    for (int m = blockIdx.x * 8 + wave; m < M; m += G * 8) {
        const int b = m >> 13; const u32x2* fr = (const u32x2*)(F + (size_t)m * DM) + lane; f32x4* outr = (f32x4*)(P.out + (size_t)m * DM) + lane; const u32x2* x1r = (const u32x2*)((const bf16_t*)(P.ws + WS_X1) + (size_t)m * DM) + lane;
        f32x4 v[8]; u32x2 xw8[8]; float ss = 0.f;
#pragma unroll
        for (int j = 0; j < 8; ++j) xw8[j] = __builtin_nontemporal_load(x1r + 64 * j);
#pragma unroll
        for (int j = 0; j < 8; ++j) { const u32x2 w = __builtin_nontemporal_load(fr + 64 * j); v[j][0] = __uint_as_float(w.x << 16); v[j][1] = __uint_as_float(w.x & 0xffff0000u); v[j][2] = __uint_as_float(w.y << 16); v[j][3] = __uint_as_float(w.y & 0xffff0000u);
            ss += (v[j][0] * v[j][0] + v[j][1] * v[j][1]) + (v[j][2] * v[j][2] + v[j][3] * v[j][3]); }
        const float rstd = rsqrtf(wave_sum(ss) * (1.0f / DM) + RMS_EPS);
#pragma unroll
        for (int j = 0; j < 8; ++j) { const f32x4 a = *(const LAS f32x4*)(TA + b * DM + 256 * j + 4 * lane); const u32x2 xw = xw8[j]; f32x4 x1; x1[0] = __uint_as_float(xw.x << 16); x1[1] = __uint_as_float(xw.x & 0xffff0000u); x1[2] = __uint_as_float(xw.y << 16); x1[3] = __uint_as_float(xw.y & 0xffff0000u); __builtin_nontemporal_store(x1 + v[j] * rstd * a, outr + 64 * j); }
    }
}
constexpr int G1_AG = 0, G1_SEG = 4096, G1_QD = 8192, G1_KI = G1_QD + 64 * 272, G1_KDT = G1_KI + 64 * 272, G1_VT = G1_KDT + 128 * 144, G1_AT = G1_VT + 256 * 144, G1_END = G1_AT + 64 * 144;
static_assert(G1_END <= 131072, "G1 LDS");
__device__ __forceinline__ void gla_intra_unit(const Params& P, LAS unsigned char* lds, int unit) {
    const int tid = opaque_tid(), lane = tid & 63, wid = tid >> 6, fr = lane & 15, fq = lane >> 4;
    const int bh = unit >> 7, n = unit & 127, b = bh >> 2, h = bh & 3;
    const size_t t0 = (size_t)b * SEQ + 64 * n;
    const bf16_t* Z = (const bf16_t*)P.out;
    LAS float* ag = (LAS float*)(lds + G1_AG); LAS float* seg = (LAS float*)(lds + G1_SEG);
    LAS bf16_t* qd = (LAS bf16_t*)(lds + G1_QD); LAS bf16_t* ki = (LAS bf16_t*)(lds + G1_KI); LAS bf16_t* kdT = (LAS bf16_t*)(lds + G1_KDT);
    LAS bf16_t* vT = (LAS bf16_t*)(lds + G1_VT); LAS bf16_t* at = (LAS bf16_t*)(lds + G1_AT);
    bf16_t* qdec_g = (bf16_t*)(P.ws + WS_QDEC); float* decay_g = (float*)(P.ws + WS_DECAY); bf16_t* OI = (bf16_t*)(P.ws + WS_OI); bf16_t* DS = (bf16_t*)(P.ws + WS_XN);
    const int d_ = tid & 127, cgp_ = tid >> 7;
    float wg_[16];
#pragma unroll
    for (int r = 0; r < 16; ++r) wg_[r] = P.w_gate_up[r * 512 + 128 * h + d_];
    const float bias_ = P.b_gate[128 * h + d_];
    bf16_t qraw_[16], kraw_[16];
#pragma unroll
    for (int i = 0; i < 16; ++i) { const size_t zr = (t0 + cgp_ * 16 + i) * ZC; qraw_[i] = Z[zr + ZO_QG + 128 * h + d_]; kraw_[i] = Z[zr + ZO_KG + 128 * h + d_]; }
    { const int idx = tid * 2, c = idx >> 4, r = idx & 15; const unsigned w = *(const unsigned*)(Z + (t0 + c) * ZC + ZO_AG + r); ag[c * 16 + r] = __uint_as_float(w << 16); ag[c * 16 + r + 1] = __uint_as_float(w & 0xffff0000u); }
#pragma unroll
    for (int i = 0; i < 4; ++i) { const int id = tid + NTHREADS * i, c = id & 63, vc = id >> 6;
        const u32x4 w = *(const u32x4*)(Z + (t0 + c) * ZC + ZO_VG + 256 * h + 8 * vc);
#pragma unroll
        for (int e = 0; e < 4; ++e) { vT[(8 * vc + 2 * e) * 72 + c] = (bf16_t)(w[e] & 0xffffu); vT[(8 * vc + 2 * e + 1) * 72 + c] = (bf16_t)(w[e] >> 16); } }
    __syncthreads();
    { const int d = d_, cgp = cgp_;
      float (&w)[16] = wg_; const float bias = bias_;
      float bcv[16]; float run = 0.f;
#pragma unroll
      for (int i = 0; i < 16; ++i) { const int c = cgp * 16 + i; float xg = bias;
#pragma unroll
          for (int r4 = 0; r4 < 4; ++r4) { const f32x4 a = *(const LAS f32x4*)(ag + c * 16 + 4 * r4); xg += a[0] * w[4 * r4] + a[1] * w[4 * r4 + 1] + a[2] * w[4 * r4 + 2] + a[3] * w[4 * r4 + 3]; }
          const float ls = fminf(xg, 0.f) - __logf(1.0f + __expf(-fabsf(xg)));
          run += ls * (1.0f / 16.0f); bcv[i] = run; }
      seg[cgp * 128 + d] = run;
      __syncthreads();
      float off = 0.f, tot = 0.f;
#pragma unroll
      for (int g2 = 0; g2 < 4; ++g2) { const float sv = seg[g2 * 128 + d]; tot += sv; if (g2 < cgp) off += sv; }
      float kd_prev = 0.f;
#pragma unroll
      for (int i = 0; i < 16; ++i) { const int c = cgp * 16 + i; const float bc = bcv[i] + off;
          const float q = bf2f(qraw_[i]), k = bf2f(kraw_[i]);
          const bf16_t qv = f2bf(q * 0.08838834764831845f * __expf(bc));
          qd[c * 136 + d] = qv; ki[c * 136 + d] = f2bf(k * __expf(-bc));
          const float kdv = k * __expf(tot - bc);
          if (i & 1) *(LAS unsigned*)(kdT + d * 72 + c - 1) = pk2(kd_prev, kdv); else kd_prev = kdv; }
      if (cgp == 0) decay_g[(size_t)unit * 128 + d] = __expf(tot);
    }
    __syncthreads();
#pragma unroll
    for (int i = 0; i < 2; ++i) { const int id = tid + NTHREADS * i, c = id >> 4, ch = id & 15; *(u32x4*)(qdec_g + ((size_t)unit * 64 + c) * 128 + 8 * ch) = *(const LAS u32x4*)(qd + c * 136 + 8 * ch); }
    { const int cb = wid >> 1;
#pragma unroll
      for (int jj = 0; jj < 2; ++jj) { const int jb = (wid & 1) * 2 + jj; f32x4 acc = {0.f, 0.f, 0.f, 0.f};
          if (jb <= cb) {
#pragma unroll
              for (int ks = 0; ks < 4; ++ks) { const bf16x8 a = *(const LAS bf16x8*)(qd + (16 * cb + fr) * 136 + 32 * ks + 8 * fq), bb = *(const LAS bf16x8*)(ki + (16 * jb + fr) * 136 + 32 * ks + 8 * fq); acc = MFMA16(a, bb, acc); } }
#pragma unroll
          for (int e = 0; e < 4; ++e) { const int c = 16 * cb + 4 * fq + e, j = 16 * jb + fr; at[c * 72 + j] = f2bf(j <= c ? acc[e] : 0.f); } }
    }
    __syncthreads();
#pragma unroll
    for (int vbi = 0; vbi < 2; ++vbi) { const int vb = 2 * wid + vbi;
        bf16x8 vf[2];
#pragma unroll
        for (int ks = 0; ks < 2; ++ks) vf[ks] = *(const LAS bf16x8*)(vT + (16 * vb + fr) * 72 + 32 * ks + 8 * fq);
#pragma unroll
        for (int cb = 0; cb < 4; ++cb) { f32x4 acc = {0.f, 0.f, 0.f, 0.f};
#pragma unroll
            for (int ks = 0; ks < 2; ++ks) acc = MFMA16(vf[ks], *(const LAS bf16x8*)(at + (16 * cb + fr) * 72 + 32 * ks + 8 * fq), acc);
            u32x2 w; w.x = pk2(acc[0], acc[1]); w.y = pk2(acc[2], acc[3]);
            *(u32x2*)(OI + (t0 + 16 * cb + fr) * 1024 + 256 * h + 16 * vb + 4 * fq) = w; }
#pragma unroll
        for (int db = 0; db < 8; ++db) { f32x4 acc = {0.f, 0.f, 0.f, 0.f};
#pragma unroll
            for (int ks = 0; ks < 2; ++ks) acc = MFMA16(*(const LAS bf16x8*)(kdT + (16 * db + fr) * 72 + 32 * ks + 8 * fq), vf[ks], acc);
            u32x2 w; w.x = pk2(acc[0], acc[1]); w.y = pk2(acc[2], acc[3]);
            *(u32x2*)(DS + ((size_t)unit * 256 + 16 * vb + fr) * 128 + 16 * db + 4 * fq) = w; }
    }
    __syncthreads();
}
__device__ __forceinline__ void gla_scan(const Params& P, int G) {
    const bf16_t* DS = (const bf16_t*)(P.ws + WS_XN); bf16_t* ST = (bf16_t*)(P.ws + WS_ST); const float* decay_g = (const float*)(P.ws + WS_DECAY);
    if (threadIdx.x < 256) for (int gid = blockIdx.x * 256 + threadIdx.x; gid < 8 * 8192; gid += G * 256) {
        const int bh = gid >> 13, e4 = gid & 8191, d = (4 * e4) & 127;
        f32x4 st = {0.f, 0.f, 0.f, 0.f};
#pragma unroll 16
        for (int n = 0; n < 128; ++n) { const size_t unit = (size_t)bh * 128 + n;
            const u32x2 w = *(const u32x2*)(DS + unit * 32768 + 4 * e4); const f32x4 dd = *(const f32x4*)(decay_g + unit * 128 + d);
            u32x2 o; o.x = pk2(st[0], st[1]); o.y = pk2(st[2], st[3]); *(u32x2*)(ST + unit * 32768 + 4 * e4) = o;
            f32x4 in; in[0] = __uint_as_float(w.x << 16); in[1] = __uint_as_float(w.x & 0xffff0000u); in[2] = __uint_as_float(w.y << 16); in[3] = __uint_as_float(w.y & 0xffff0000u);
            st = dd * st + in; }
    }
}
__device__ __forceinline__ void gla_inter_unit(const Params& P, LAS unsigned char* lds, int unit) {
    const int tid = opaque_tid(), lane = tid & 63, wid = tid >> 6, fr = lane & 15, fq = lane >> 4;
    const int bh = unit >> 7, n = unit & 127, b = bh >> 2, h = bh & 3;
    const size_t t0 = (size_t)b * SEQ + 64 * n;
    const bf16_t* Z = (const bf16_t*)P.out; const bf16_t* qdec_g = (const bf16_t*)(P.ws + WS_QDEC); const bf16_t* OI = (const bf16_t*)(P.ws + WS_OI); const bf16_t* ST = (const bf16_t*)(P.ws + WS_ST);
    bf16_t* AO = (bf16_t*)(P.ws + WS_XN);
    LAS float* red = (LAS float*)lds;
    const int cb = wid & 3, vh = wid >> 2; const size_t trow = t0 + 16 * cb + fr;
    bf16x8 qf[4];
#pragma unroll
    for (int ks = 0; ks < 4; ++ks) qf[ks] = *(const bf16x8*)(qdec_g + ((size_t)unit * 64 + 16 * cb + fr) * 128 + 32 * ks + 8 * fq);
    f32x4 o[8]; float ss = 0.f;
    bf16x8 sf[8][4]; u32x2 oiw[8];
#pragma unroll
    for (int vbi = 0; vbi < 8; ++vbi) { const int vb = vh * 8 + vbi;
#pragma unroll
        for (int ks = 0; ks < 4; ++ks) sf[vbi][ks] = *(const bf16x8*)(ST + ((size_t)unit * 256 + 16 * vb + fr) * 128 + 32 * ks + 8 * fq);
        oiw[vbi] = *(const u32x2*)(OI + trow * 1024 + 256 * h + 16 * vb + 4 * fq); }
#pragma unroll
    for (int vbi = 0; vbi < 8; ++vbi) { f32x4 acc = {0.f, 0.f, 0.f, 0.f};
#pragma unroll
        for (int ks = 0; ks < 4; ++ks) acc = MFMA16(sf[vbi][ks], qf[ks], acc);
        const u32x2 w = oiw[vbi];
        acc[0] += __uint_as_float(w.x << 16); acc[1] += __uint_as_float(w.x & 0xffff0000u); acc[2] += __uint_as_float(w.y << 16); acc[3] += __uint_as_float(w.y & 0xffff0000u);
        o[vbi] = acc; ss += (acc[0] * acc[0] + acc[1] * acc[1]) + (acc[2] * acc[2] + acc[3] * acc[3]); }
    ss += __shfl_xor(ss, 16); ss += __shfl_xor(ss, 32);
    if (fq == 0) red[wid * 16 + fr] = ss;
    __syncthreads();
    const float tot = red[cb * 16 + fr] + red[(cb + 4) * 16 + fr];
    const float rstd = rsqrtf(tot * (1.0f / 256.0f) + RMS_EPS);
#pragma unroll
    for (int vbi = 0; vbi < 8; ++vbi) { const int vcol = 16 * (vh * 8 + vbi) + 4 * fq;
        const f32x4 g = *(const f32x4*)(P.g_gla + vcol); const u32x2 rw = *(const u32x2*)(Z + trow * ZC + ZO_RG + 256 * h + vcol);
        const float r0 = __uint_as_float(rw.x << 16), r1 = __uint_as_float(rw.x & 0xffff0000u), r2 = __uint_as_float(rw.y << 16), r3 = __uint_as_float(rw.y & 0xffff0000u);
        u32x2 w; w.x = pk2(o[vbi][0] * rstd * g[0] * silu_f(r0), o[vbi][1] * rstd * g[1] * silu_f(r1)); w.y = pk2(o[vbi][2] * rstd * g[2] * silu_f(r2), o[vbi][3] * rstd * g[3] * silu_f(r3));
        *(u32x2*)(AO + trow * DM + 1024 + 256 * h + vcol) = w; }
    __syncthreads();
}

constexpr int AT_KB = 64 * 512, AT_VB = 128 * 144, AT_BUF = AT_KB + AT_VB;
constexpr float AT_THR = 8.0f;
#ifndef AT_SGB
#define AT_SGB 1
#endif
#ifndef AT_QK_AHEAD
#define AT_QK_AHEAD 4
#endif
#ifndef AT_PV_AHEAD
#define AT_PV_AHEAD 4
#endif
#ifndef AT_SCHED
#define AT_SCHED
#endif
__device__ __forceinline__ void attn_unit(const Params& P, LAS unsigned char* lds, int bh, int qb) {
    const int tid = opaque_tid(), lane = tid & 63, wid = __builtin_amdgcn_readfirstlane(tid >> 6), fr = lane & 15, fq = lane >> 4;
    const int b = bh >> 3, h = bh & 7; const size_t rowb = (size_t)b * SEQ; const int q0 = qb * 256 + wid * 32;
    const bf16_t* Q = (const bf16_t*)(P.ws + WS_Q); const bf16_t* KN = (const bf16_t*)(P.ws + WS_KN); const bf16_t* KR = (const bf16_t*)(P.ws + WS_KROPE); const bf16_t* VT = (const bf16_t*)(P.ws + WS_VT);
    bf16_t* AO = (bf16_t*)(P.ws + WS_XN);
    bf16x8 qf[6][2];
#pragma unroll
    for (int qk = 0; qk < 2; ++qk) { const bf16_t* qp = Q + (rowb + q0 + 16 * qk + fr) * QC;
#pragma unroll
        for (int ks = 0; ks < 4; ++ks) qf[ks][qk] = *(const bf16x8*)(qp + 128 * h + 32 * ks + 8 * fq);
        qf[4][qk] = *(const bf16x8*)(qp + 1024 + (h >> 2) * 256 + (h & 3) * 32 + 8 * fq); qf[5][qk] = *(const bf16x8*)(qp + 1024 + (h >> 2) * 256 + 128 + (h & 3) * 32 + 8 * fq); }
    const int NT = (qb + 1) * 4;
    const bf16_t* KNh = KN + rowb * 1024 + 128 * h; const bf16_t* KRb = KR + rowb * 64; const bf16_t* VTh = VT + (size_t)(128 * h) * M + rowb;
    const unsigned char* dsrc[7]; unsigned dstr[7];
#pragma unroll
    for (int j_ = 0; j_ < 7; ++j_) { const int c_ = wid + 8 * j_; const int L_ = 1024 * c_ + 16 * lane; const bf16_t* src_ = KNh; unsigned st_ = 0;
        if (L_ < AT_KB) { const int row_ = L_ >> 9, pp_ = (L_ & 511) >> 4; int pc_ = (pp_ & 16) | ((pp_ & 15) ^ (row_ & 15)); if (pc_ >= 24) pc_ = 0;
            if (pc_ < 16) { src_ = KNh + (size_t)row_ * 1024 + 8 * pc_; st_ = 64u * 1024u * 2u; } else { src_ = KRb + (size_t)row_ * 64 + 8 * (pc_ - 16); st_ = 64u * 64u * 2u; } }
        else if (c_ < 50) { const int L2_ = L_ - AT_KB, dv_ = L2_ / 144, cb_ = L2_ - dv_ * 144; int pc_ = cb_ >> 4; if (pc_ >= 8) pc_ = 0; src_ = VTh + (size_t)dv_ * M + 8 * pc_; st_ = 128u; }
        dsrc[j_] = (const unsigned char*)src_; dstr[j_] = st_; }
#define AT_DMA(t, buf) do { _Pragma("unroll") for (int j_ = 0; j_ < 7; ++j_) { const int c_ = wid + 8 * j_; if (c_ < 50) { \
            __builtin_amdgcn_global_load_lds((const unsigned*)dsrc[j_], (LAS unsigned*)(lds + (buf) * AT_BUF + 1024 * c_), 16, 0, 0); dsrc[j_] += dstr[j_]; } } } while (0)
    int kxo[4];
#pragma unroll
    for (int j = 0; j < 4; ++j) kxo[j] = fr * 512 + (((4 * j + fq) ^ fr) << 4);
    float mrow[2] = {0.f, 0.f}; f32x4 lacc[2] = {(f32x4){0.f, 0.f, 0.f, 0.f}, (f32x4){0.f, 0.f, 0.f, 0.f}};
    const bf16x8 ones = {16256, 16256, 16256, 16256, 16256, 16256, 16256, 16256};
    f32x4 o[8][2];
#pragma unroll
    for (int dvb = 0; dvb < 8; ++dvb) { o[dvb][0] = (f32x4){0.f, 0.f, 0.f, 0.f}; o[dvb][1] = (f32x4){0.f, 0.f, 0.f, 0.f}; }
    AT_DMA(0, 0);
    asm volatile("s_waitcnt vmcnt(0)" ::: "memory"); __syncthreads();
#pragma clang loop unroll(disable)
    for (int t = 0; t < NT; ++t) {
        const int buf = t & 1; const bool more = (t + 1 < NT);
        if (more) AT_DMA(t + 1, buf ^ 1);
        const LAS unsigned char* Kl = lds + buf * AT_BUF; const LAS unsigned char* Vl = Kl + AT_KB;
        const int k0 = 64 * t;
        if (k0 <= q0) {
#define AT_SB __builtin_amdgcn_sched_barrier(0)
#define AT_KLD(dst, ks_) do { _Pragma("unroll") for (int kvb = 0; kvb < 4; ++kvb) dst[kvb] = *(const LAS bf16x8*)(Kl + kxo[(ks_) & 3] + ((ks_) >> 2) * 256 + kvb * (16 * 512)); } while (0)
#define AT_VLD(dst, g_) do { _Pragma("unroll") for (int i_ = 0; i_ < 4; ++i_) { const LAS unsigned char* vp = Vl + (16 * (4 * ((g_) & 1) + i_) + fr) * 144 + (32 * ((g_) >> 1) + 4 * fq) * 2; \
            const u32x2 lo = *(const LAS u32x2*)vp, hi = *(const LAS u32x2*)(vp + 32); u32x4 w; w.x = lo.x; w.y = lo.y; w.z = hi.x; w.w = hi.y; dst[i_] = __builtin_bit_cast(bf16x8, w); } } while (0)
            bf16x8 kc[4], kn[4];
            AT_KLD(kc, 0);
            f32x4 s[4][2];
#pragma unroll
            for (int kvb = 0; kvb < 4; ++kvb) { s[kvb][0] = (f32x4){-mrow[0], -mrow[0], -mrow[0], -mrow[0]}; s[kvb][1] = (f32x4){-mrow[1], -mrow[1], -mrow[1], -mrow[1]}; }
#pragma unroll
            for (int ks = 0; ks < 6; ++ks) {
                if (ks < 5) AT_KLD(kn, ks + 1);
                AT_SB;
#pragma unroll
                for (int kvb = 0; kvb < 4; ++kvb) { s[kvb][0] = MFMA16(kc[kvb], qf[ks][0], s[kvb][0]); s[kvb][1] = MFMA16(kc[kvb], qf[ks][1], s[kvb][1]); }
                AT_SB;
                if (ks < 5) {
#pragma unroll
                    for (int kvb = 0; kvb < 4; ++kvb) kc[kvb] = kn[kvb]; }
            }
            bf16x8 vc[4], vn[4];
            AT_VLD(vc, 0);
            AT_SB;
            if (k0 + 63 > q0) {
#pragma unroll
                for (int kvb = 0; kvb < 4; ++kvb)
#pragma unroll
                    for (int qk = 0; qk < 2; ++qk)
#pragma unroll
                        for (int e = 0; e < 4; ++e) { const int kv = k0 + 16 * kvb + 4 * fq + e, q = q0 + 16 * qk + fr; if (kv > q) s[kvb][qk][e] = -INFINITY; }
            }
            float mx[2];
#pragma unroll
            for (int qk = 0; qk < 2; ++qk) { float m_ = fmaxf(fmaxf(s[0][qk][0], s[0][qk][1]), fmaxf(s[0][qk][2], s[0][qk][3]));
#pragma unroll
                for (int kvb = 1; kvb < 4; ++kvb) m_ = fmaxf(m_, fmaxf(fmaxf(s[kvb][qk][0], s[kvb][qk][1]), fmaxf(s[kvb][qk][2], s[kvb][qk][3])));
                m_ = fmaxf(m_, __shfl_xor(m_, 16)); m_ = fmaxf(m_, __shfl_xor(m_, 32)); mx[qk] = m_; }
            if (t == 0 || __any((mx[0] > AT_THR) || (mx[1] > AT_THR))) {
#pragma unroll
                for (int qk = 0; qk < 2; ++qk) { const float dl = (t == 0) ? mx[qk] : fmaxf(mx[qk], 0.f), alpha = __builtin_amdgcn_exp2f(-dl); mrow[qk] += dl; lacc[qk] *= alpha;
#pragma unroll
                    for (int kvb = 0; kvb < 4; ++kvb) s[kvb][qk] -= dl;
#pragma unroll
                    for (int dvb = 0; dvb < 8; ++dvb) o[dvb][qk] *= alpha; }
            }
            bf16x8 pf[2][2];
#pragma unroll
            for (int qk = 0; qk < 2; ++qk) {
#pragma unroll
                for (int kvb = 0; kvb < 4; ++kvb)
#pragma unroll
                    for (int e = 0; e < 4; ++e) s[kvb][qk][e] = __builtin_amdgcn_exp2f(s[kvb][qk][e]);
#pragma unroll
                for (int s2 = 0; s2 < 2; ++s2) { u32x4 w; w.x = pk2(s[2 * s2][qk][0], s[2 * s2][qk][1]); w.y = pk2(s[2 * s2][qk][2], s[2 * s2][qk][3]);
                    w.z = pk2(s[2 * s2 + 1][qk][0], s[2 * s2 + 1][qk][1]); w.w = pk2(s[2 * s2 + 1][qk][2], s[2 * s2 + 1][qk][3]); pf[s2][qk] = __builtin_bit_cast(bf16x8, w); } }
            AT_SB;
#pragma unroll
            for (int g = 0; g < 4; ++g) {
                if (g < 3) AT_VLD(vn, g + 1);
                AT_SB;
                if ((g & 1) == 0) { lacc[0] = MFMA16(ones, pf[g >> 1][0], lacc[0]); lacc[1] = MFMA16(ones, pf[g >> 1][1], lacc[1]); }
#pragma unroll
                for (int i = 0; i < 4; ++i) { const int dvb = 4 * (g & 1) + i; o[dvb][0] = MFMA16(vc[i], pf[g >> 1][0], o[dvb][0]); o[dvb][1] = MFMA16(vc[i], pf[g >> 1][1], o[dvb][1]); }
                AT_SB;
                if (g < 3) {
#pragma unroll
                    for (int i = 0; i < 4; ++i) vc[i] = vn[i]; }
            }
#undef AT_SB
#undef AT_KLD
#undef AT_VLD
        }
        asm volatile("s_waitcnt vmcnt(0)" ::: "memory"); __syncthreads();
    }
#pragma unroll
    for (int qk = 0; qk < 2; ++qk) { const float rl = 1.0f / lacc[qk][0];
        bf16_t* op = AO + (rowb + q0 + 16 * qk + fr) * DM + 128 * h + 4 * fq;
#pragma unroll
        for (int dvb = 0; dvb < 8; ++dvb) { u32x2 w; w.x = pk2(o[dvb][qk][0] * rl, o[dvb][qk][1] * rl); w.y = pk2(o[dvb][qk][2] * rl, o[dvb][qk][3] * rl); *(u32x2*)(op + 16 * dvb) = w; } }
#undef AT_DMA
}

#define GAS __attribute__((address_space(1)))
typedef GAS unsigned gu32;
typedef GAS unsigned long long gu64;
#define RLX_AGENT __ATOMIC_RELAXED, __HIP_MEMORY_SCOPE_AGENT
#define LDS_WAIT() asm volatile("s_waitcnt lgkmcnt(0)" ::: "memory")
#define VM_WAIT() asm volatile("s_waitcnt vmcnt(0)" ::: "memory")
__device__ __forceinline__ unsigned long long rt() { return __builtin_amdgcn_s_memrealtime(); }

#define XB_TMO      128
#define XB_XCNT(j)  (256  + 64 * (j))
#define XB_XSUB(j)  (1280 + 64 * (j))
#define XB_XGEN(j)  (2304 + 64 * (j))
#define XB_TOP      3328
#define XB_TOPGEN   3392
#define XCD_BAR_WORDS 3456
#define XB_SPIN_CAP (1u << 18)

__device__ __forceinline__ unsigned xb_ld(unsigned* p)              { return __hip_atomic_load(p, __ATOMIC_RELAXED, __HIP_MEMORY_SCOPE_AGENT); }
__device__ __forceinline__ unsigned xb_add(unsigned* p, unsigned v) { return __hip_atomic_fetch_add(p, v, __ATOMIC_RELAXED, __HIP_MEMORY_SCOPE_AGENT); }
__device__ __forceinline__ unsigned xb_xcc_id() { return (unsigned)__builtin_amdgcn_s_getreg((3 << 11) | 20) & 0xFu; }
#define XB_SPIN(cond, bar) do { unsigned _sp = 0; while (cond) { __builtin_amdgcn_s_sleep(1); \
    if ((++_sp & 255u) == 0u) { if (xb_ld(&(bar)[XB_TMO])) break; if (_sp > XB_SPIN_CAP) { atomicAdd(&(bar)[XB_TMO], 1u); break; } } } } while (0)

struct XcdBarrier {
    unsigned* bar; unsigned x;
    volatile LAS unsigned* st;
};

__device__ __forceinline__ XcdBarrier xcd_barrier_post(unsigned* bar, volatile LAS unsigned* st) {
    XcdBarrier b; b.bar = bar; b.x = xb_xcc_id(); b.st = st;
    if (threadIdx.x == 0) (void)xb_add(&bar[XB_XCNT(b.x)], 1u);
    return b;
}
__device__ __forceinline__ void xcd_barrier_complete(unsigned* bar, unsigned x, unsigned& nloc, unsigned& nx) {
    const unsigned G = gridDim.x * gridDim.y * gridDim.z;
    unsigned sum, cnt, mine, sp = 0u;
    for (;;) {
        sum = 0u; cnt = 0u; mine = 0u;
#pragma unroll
        for (unsigned j = 0; j < 16; ++j) { const unsigned c = xb_ld(&bar[XB_XCNT(j)]); sum += c; cnt += (c > 0u) ? 1u : 0u; mine = (j == x) ? c : mine; }
        if (sum == G) break;
        __builtin_amdgcn_s_sleep(1);
        if ((++sp & 255u) == 0u) { if (xb_ld(&bar[XB_TMO])) break; if (sp > XB_SPIN_CAP) { atomicAdd(&bar[XB_TMO], 1u); break; } }
    }
    nloc = mine > 0u ? mine : 1u; nx = cnt > 0u ? cnt : 1u;
}

__device__ __forceinline__ void xcd_barrier(const XcdBarrier& b) {
    asm volatile("s_waitcnt vmcnt(0)" ::: "memory");
    __syncthreads();
    if (threadIdx.x == 0) {
        unsigned* bar = b.bar;
        __builtin_amdgcn_s_waitcnt(0);
        unsigned nloc = b.st[0], nx = b.st[1];
        if (nloc == 0u) { xcd_barrier_complete(bar, b.x, nloc, nx); b.st[0] = nloc; b.st[1] = nx; }
        const unsigned old = xb_add(&bar[XB_XSUB(b.x)], 1u);
        const unsigned gen = old / nloc;
        if (old + 1u == (gen + 1u) * nloc) {
            __builtin_amdgcn_fence(__ATOMIC_RELEASE, "agent");
            asm volatile("s_waitcnt vmcnt(0)" ::: "memory");
            const unsigned og = xb_add(&bar[XB_TOP], 1u);
            const unsigned tg = og / nx;
            if (og + 1u == (tg + 1u) * nx) xb_add(&bar[XB_TOPGEN], 1u);
            else XB_SPIN(xb_ld(&bar[XB_TOPGEN]) == tg, bar);
            __builtin_amdgcn_fence(__ATOMIC_ACQUIRE, "agent");
            xb_add(&bar[XB_XGEN(b.x)], 1u);
            asm volatile("s_waitcnt vmcnt(0)" ::: "memory");
        } else {
            XB_SPIN(xb_ld(&bar[XB_XGEN(b.x)]) == gen, bar);
            __builtin_amdgcn_fence(__ATOMIC_ACQUIRE, "agent");
            asm volatile("s_waitcnt vmcnt(0)" ::: "memory");
        }
    }
    __syncthreads();
}


#ifndef PHASES
#define PHASES 0xFFFF
#endif
#define PH(k) ((PHASES >> (k)) & 1)
#ifndef REP_ATT
#define REP_ATT 1
#endif
#ifndef REP_P0
#define REP_P0 1
#endif
#ifndef REP_GLA
#define REP_GLA 1
#endif
#ifndef REP_A
#define REP_A 1
#endif
#ifndef REP_B
#define REP_B 1
#endif
#ifndef REP_C
#define REP_C 1
#endif
#ifndef REP_D
#define REP_D 1
#endif
#ifndef P2_SP2
#define P2_SP2 true
#endif
#ifndef P2_ALIGN
#define P2_ALIGN true
#endif
#ifndef P69_ALIGN
#define P69_ALIGN true
#endif
#ifndef P3_ALIGN
#define P3_ALIGN false
#endif
#ifndef P3_SP2
#define P3_SP2 true
#endif
#ifndef REP_P8
#define REP_P8 1
#endif
#ifndef REP_ROWS
#define REP_ROWS 1
#endif
#ifndef REP_SYNC
#define REP_SYNC 1
#endif
__global__ void __launch_bounds__(NTHREADS, 2) hybrid_block_fwd(Params P) {
    extern __shared__ __attribute__((aligned(16))) unsigned char lds_raw[];
    LAS unsigned char* lds = (LAS unsigned char*)lds_raw;
    cg::grid_group grid = cg::this_grid();
    volatile LAS unsigned* MISC = (volatile LAS unsigned*)(lds + MISC_OFF);
    if (threadIdx.x < 32) MISC[threadIdx.x] = 0u;
    __syncthreads();
    XcdBarrier bar = xcd_barrier_post((unsigned*)(P.ws + WS_CTL), MISC + 8);
#define GSYNC() xcd_barrier(bar)
    const int G = gridDim.x, bx = blockIdx.x;
    unsigned char* ws = P.ws;
    bf16_t* Zb = (bf16_t*)P.out;
    if (PH(0)) for (int rep = 0; rep < REP_P0; ++rep) p0_prologue(P, lds, G);
    if (P.out == nullptr) grid.sync();
    GSYNC();
    if (PH(1)) p1_rows(P, lds, G);
#if defined(DUP_A)
    __syncthreads(); p1_rows(P, lds, G);
#endif
    for (int rep = 0; rep < REP_SYNC; ++rep) GSYNC();
    if (PH(2)) { pg8::Gemm g{(const bf16_t*)(ws + WS_XN), (const bf16_t*)(ws + WS_WIN), M, ZC, DM, DM, DM}; pg8::StaticOrder S; S.init(M, ZC, G, bx);
      pg8::EpiPlain E{Zb, ZC}; pg8::gemm_phase<pg8::EpiPlain, pg8::StaticOrder, P2_ALIGN, P2_SP2>(lds, g, S, E); }
#if defined(DUP_P2)
    if (PH(2)) { pg8::Gemm g{(const bf16_t*)(ws + WS_XN), (const bf16_t*)(ws + WS_WIN), M, ZC, DM, DM, DM}; pg8::StaticOrder S; S.init(M, ZC, G, bx);
      pg8::EpiPlain E{Zb, ZC}; pg8::gemm_phase<pg8::EpiPlain, pg8::StaticOrder, P2_ALIGN, P2_SP2>(lds, g, S, E); }
#endif
    GSYNC();
    if (PH(3)) p2b_rows(P, G);
#if defined(DUP_A)
    p2b_rows(P, G);
#endif
    GSYNC();
    if (PH(4)) { pg8::Gemm g{(const bf16_t*)(ws + WS_CQN), (const bf16_t*)(ws + WS_WUQ), M, QC, 512, 512, 512}; pg8::StaticOrder S; S.init(M, QC, G, bx);
      pg8::EpiRowScaleRope E{(bf16_t*)(ws + WS_Q), QC, QSCALE, 4, (const float*)(ws + WS_CS)};
      pg8::gemm_phase<pg8::EpiRowScaleRope, pg8::StaticOrder, P3_ALIGN, P3_SP2>(lds, g, S, E); }
    if (PH(5)) { pg8::Gemm g{(const bf16_t*)(ws + WS_CKVN), (const bf16_t*)(ws + WS_WUK), M, 1024, 256, 256, 256}; pg8::StaticOrder S; S.init(M, 1024, G, bx);
      pg8::EpiPlain E{(bf16_t*)(ws + WS_KN), 1024}; pg8::gemm_phase<pg8::EpiPlain, pg8::StaticOrder, P3_ALIGN, P3_SP2>(lds, g, S, E); }
    if (PH(6)) { pg8::Gemm g{(const bf16_t*)(ws + WS_WUV), (const bf16_t*)(ws + WS_CKVN), 1024, M, 256, 256, 256}; pg8::StaticOrder S; S.init(1024, M, G, bx);
      pg8::EpiPlain E{(bf16_t*)(ws + WS_VT), M}; pg8::gemm_phase<pg8::EpiPlain, pg8::StaticOrder, P3_ALIGN, P3_SP2>(lds, g, S, E); }
#if defined(DUP_P3)
    if (PH(4)) { pg8::Gemm g{(const bf16_t*)(ws + WS_CQN), (const bf16_t*)(ws + WS_WUQ), M, QC, 512, 512, 512}; pg8::StaticOrder S; S.init(M, QC, G, bx);
      pg8::EpiRowScaleRope E{(bf16_t*)(ws + WS_Q), QC, QSCALE, 4, (const float*)(ws + WS_CS)};
      pg8::gemm_phase<pg8::EpiRowScaleRope, pg8::StaticOrder, true, true>(lds, g, S, E); }
    if (PH(5)) { pg8::Gemm g{(const bf16_t*)(ws + WS_CKVN), (const bf16_t*)(ws + WS_WUK), M, 1024, 256, 256, 256}; pg8::StaticOrder S; S.init(M, 1024, G, bx);
      pg8::EpiPlain E{(bf16_t*)(ws + WS_KN), 1024}; pg8::gemm_phase<pg8::EpiPlain, pg8::StaticOrder, true, true>(lds, g, S, E); }
    if (PH(6)) { pg8::Gemm g{(const bf16_t*)(ws + WS_WUV), (const bf16_t*)(ws + WS_CKVN), 1024, M, 256, 256, 256}; pg8::StaticOrder S; S.init(1024, M, G, bx);
      pg8::EpiPlain E{(bf16_t*)(ws + WS_VT), M}; pg8::gemm_phase<pg8::EpiPlain, pg8::StaticOrder, true, true>(lds, g, S, E); }
#endif
    if (PH(7)) for (int rep = 0; rep < REP_GLA; ++rep) for (int u = bx; u < 1024; u += G) gla_intra_unit(P, lds, u);
    GSYNC();
    if (PH(8)) for (int rep = 0; rep < REP_B; ++rep) gla_scan(P, G);
    GSYNC();
    if (PH(9)) for (int u = bx; u < 1024; u += G) gla_inter_unit(P, lds, u);
#if defined(DUP_C)
    for (int u = bx; u < 1024; u += G) gla_inter_unit(P, lds, u);
#endif
    if (PH(10)) { const int vcu = (G % 8 == 0) ? (bx % 8) * (G / 8) + bx / 8 : bx;
      for (int rep = 0; rep < REP_ATT; ++rep) for (int p2 = 2 * vcu; p2 < 512; p2 += 2 * G) {
#pragma clang loop unroll(disable)
          for (int i2 = 0; i2 < 2; ++i2) { const int p = p2 >> 1, bh = p >> 4, s = p & 15; attn_unit(P, lds, bh, i2 ? s : 31 - s); } } }
    GSYNC();
    if (PH(11)) { pg8::Gemm g{(const bf16_t*)(ws + WS_XN), (const bf16_t*)(ws + WS_WOUT), M, DM, DM, DM, DM}; pg8::StaticOrder S; S.init(M, DM, G, bx);
      pg8::EpiPlain E{(bf16_t*)(ws + WS_O), DM}; pg8::gemm_phase<pg8::EpiPlain, pg8::StaticOrder, P69_ALIGN, true>(lds, g, S, E); }
#if defined(DUP_P6)
    if (PH(11)) { pg8::Gemm g{(const bf16_t*)(ws + WS_XN), (const bf16_t*)(ws + WS_WOUT), M, DM, DM, DM, DM}; pg8::StaticOrder S; S.init(M, DM, G, bx);
      pg8::EpiPlain E{(bf16_t*)(ws + WS_O), DM}; pg8::gemm_phase<pg8::EpiPlain, pg8::StaticOrder, P69_ALIGN, true>(lds, g, S, E); }
#endif
    GSYNC();
    if (PH(12)) for (int rep = 0; rep < REP_D; ++rep) { p7_rows(P, lds, G); __syncthreads(); }
    GSYNC();
    if (PH(13)) { pg8::Gemm g{(const bf16_t*)(ws + WS_XN), (const bf16_t*)(ws + WS_WGU), M, 2 * DFF, DM, DM, DM}; pg8::StaticOrder S; S.init(M, 2 * DFF, G, bx);
      pg8::EpiSwiGLU E{(bf16_t*)(ws + WS_ACT), DFF}; pg8::gemm_phase<pg8::EpiSwiGLU, pg8::StaticOrder, true, true>(lds, g, S, E); }
#if defined(DUP_P8)
    if (PH(13)) { pg8::Gemm g{(const bf16_t*)(ws + WS_XN), (const bf16_t*)(ws + WS_WGU), M, 2 * DFF, DM, DM, DM}; pg8::StaticOrder S; S.init(M, 2 * DFF, G, bx);
      pg8::EpiSwiGLU E{(bf16_t*)(ws + WS_ACT), DFF}; pg8::gemm_phase<pg8::EpiSwiGLU, pg8::StaticOrder, true, true>(lds, g, S, E); }
#endif
    GSYNC();
    if (PH(14)) { pg8::Gemm g{(const bf16_t*)(ws + WS_ACT), (const bf16_t*)(ws + WS_WD), M, DM, DFF, DFF, DFF}; pg8::StaticOrder S; S.init(M, DM, G, bx);
      pg8::EpiPlain E{(bf16_t*)(ws + WS_O), DM}; pg8::gemm_phase<pg8::EpiPlain, pg8::StaticOrder, P69_ALIGN, true>(lds, g, S, E); }
#if defined(DUP_P9)
    if (PH(14)) { pg8::Gemm g{(const bf16_t*)(ws + WS_ACT), (const bf16_t*)(ws + WS_WD), M, DM, DFF, DFF, DFF}; pg8::StaticOrder S; S.init(M, DM, G, bx);
      pg8::EpiPlain E{(bf16_t*)(ws + WS_O), DM}; pg8::gemm_phase<pg8::EpiPlain, pg8::StaticOrder, P69_ALIGN, true>(lds, g, S, E); }
#endif
    GSYNC();
    if (PH(15)) for (int rep = 0; rep < REP_D; ++rep) { p10_rows(P, lds, G); __syncthreads(); }
}

extern "C" void kernel_launch(void* const* d_in, const int* in_sizes, int n_in, void* d_out, int out_size, void* d_ws, size_t ws_size, hipStream_t stream) {
    static int grid = 0;
    if (grid == 0) {
        if (n_in != 22 || in_sizes[0] != M * DM || out_size != M * DM || ws_size < WS_END) { fprintf(stderr, "kernel_launch: unexpected shapes (n_in %d, in0 %d, out %d, ws %zu)\n", n_in, n_in > 0 ? in_sizes[0] : -1, out_size, ws_size); grid = -1; return; }
        int dev = 0, cus = 0, per_cu = 0;
        (void)hipGetDevice(&dev); (void)hipDeviceGetAttribute(&cus, hipDeviceAttributeMultiprocessorCount, dev);
        if (hipFuncSetAttribute((const void*)hybrid_block_fwd, hipFuncAttributeMaxDynamicSharedMemorySize, LDS_BYTES) != hipSuccess) { fprintf(stderr, "kernel_launch: hipFuncSetAttribute failed\n"); grid = -1; return; }
        if (hipOccupancyMaxActiveBlocksPerMultiprocessor(&per_cu, (const void*)hybrid_block_fwd, NTHREADS, LDS_BYTES) != hipSuccess || per_cu < 1) { fprintf(stderr, "kernel_launch: occupancy query failed (%d)\n", per_cu); (void)hipGetLastError(); grid = -1; return; }
        grid = cus;
    }
    if (grid < 0) return;
    Params p{};
    const float* const* fin = (const float* const*)d_in;
    p.x = fin[0]; p.c = fin[1]; p.pos = (const int*)d_in[2]; p.w_ada = fin[3]; p.b_ada = fin[4]; p.g_pre_mix = fin[5]; p.g_post_mix = fin[6]; p.w_in = fin[7]; p.g_q = fin[8]; p.w_uq = fin[9];
    p.g_kv = fin[10]; p.w_uk = fin[11]; p.w_uv = fin[12]; p.w_gate_up = fin[13]; p.b_gate = fin[14]; p.g_gla = fin[15]; p.w_out = fin[16]; p.g_pre_ffn = fin[17]; p.g_post_ffn = fin[18];
    p.w_fg = fin[19]; p.w_fu = fin[20]; p.w_fd = fin[21]; p.out = (float*)d_out; p.ws = (unsigned char*)d_ws;
    if (hipMemsetAsync((char*)d_ws + WS_CTL, 0, CTL_BYTES, stream) != hipSuccess) { fprintf(stderr, "kernel_launch: memset failed\n"); return; }
    void* args[] = {&p};
    hipError_t e = hipLaunchCooperativeKernel((const void*)hybrid_block_fwd, dim3(grid), dim3(NTHREADS), args, LDS_BYTES, stream);
    if (e != hipSuccess) fprintf(stderr, "cooperative launch failed: %s (grid %d)\n", hipGetErrorString(e), grid);
}
```

```cpp
#define P3_SP2 false
#include <hip/hip_runtime.h>
#include <hip/hip_cooperative_groups.h>
#include <cstdio>
#include <cstdint>
#include <cmath>
namespace cg = cooperative_groups;
namespace pg8 {
#define PG8_LAS __attribute__((address_space(3)))
typedef unsigned short bf16_t;
typedef short bf16x8 __attribute__((ext_vector_type(8)));
typedef float f32x4 __attribute__((ext_vector_type(4)));
typedef unsigned u32x4 __attribute__((ext_vector_type(4)));
constexpr int BM = 256, BK = 64, HALF = 128, HTB = HALF * BK * 2  , STAGE_BYTES = 8 * HTB, NXCD = 8, WGM = 8;

__host__ __device__ __forceinline__ int lds_byte(int r, int c) { const int st = (r >> 4) * 2 + (c >> 5), rr = r & 15, cc = c & 31, ob = rr * 64 + cc * 2; return st * 1024 + (ob ^ (((ob >> 9) & 1) << 5)); }
__host__ __device__ __forceinline__ void stage_rc(int b, int& R, int& C) { const int st = b / 1024, sb = b % 1024, swz = sb ^ (((sb >> 9) & 1) << 5); R = (st >> 1) * 16 + swz / 64; C = (st & 1) * 32 + (swz % 64) / 2; }
__host__ __device__ __forceinline__ int perm32(int rho) { const int n = rho >> 4, i = rho & 15; return 8 * (i >> 2) + 4 * n + (i & 3); }

struct Unit { int pm, pn; };
struct Gemm { const bf16_t* A; const bf16_t* Bt; int M, N, K, lda, ldb; };

struct StaticOrder {
    int nM, nN, nwg, G, c;
    __host__ __device__ void init(int M, int N, int G_, int c_) { nM = M / BM; nN = N / BM; nwg = nM * nN; G = G_; c = c_; }
    __host__ __device__ bool next(int i, Unit& u) const {
        const long L = (long)i * G + c; if (L >= nwg) return false;
        int wgid = (int)L; { const int q = nwg / NXCD, r = nwg % NXCD, xcd = wgid % NXCD, off = wgid / NXCD; wgid = (xcd < r ? xcd * (q + 1) : r * (q + 1) + (xcd - r) * q) + off; }
        const int nig = WGM * nN, gid = wgid / nig, fm = gid * WGM, gsz = (nM - fm) < WGM ? (nM - fm) : WGM;
        u.pm = fm + ((wgid % nig) % gsz); u.pn = (wgid % nig) / gsz; return true;
    }
    __device__ __forceinline__ void a_ready(const Unit&) const {}
    __device__ __forceinline__ void done(const Unit&) const {}
};

__device__ __forceinline__ unsigned cvt_pk_bf16(float lo, float hi) { unsigned r; asm volatile("v_cvt_pk_bf16_f32 %0, %1, %2" : "=v"(r) : "v"(lo), "v"(hi)); return r; }
typedef float f32x2 __attribute__((ext_vector_type(2)));
template <class Epi, class Sched, bool ALIGN_EPI = false, bool SP2 = false>
__device__ __forceinline__ void gemm_phase(PG8_LAS unsigned char* lds, const Gemm g, const Sched& S, const Epi& E) {
    int tid_ = threadIdx.x; asm volatile("" : "+v"(tid_)); const int tid = tid_, wid = __builtin_amdgcn_readfirstlane(tid >> 6), lane = tid & 63, wr = wid >> 2, wc = wid & 3, fr = lane & 15, fq = lane >> 4;
    const int K = g.K, nt = K / BK;
    unsigned voffA[2], voffB[2];
#pragma unroll
    for (int i = 0; i < 2; ++i) { int R, C; stage_rc(tid * 16 + i * 8192, R, C); const int Rb = Epi::PERM ? ((R & ~31) + perm32(R & 31)) : R;
        voffA[i] = (unsigned)(R * g.lda + C) * 2u; voffB[i] = (unsigned)(Rb * g.ldb + C) * 2u; }
    const size_t kstep = (size_t)(BK * 2);
    const size_t hstepA = (size_t)HALF * g.lda * 2, hstepB = (size_t)HALF * g.ldb * 2;
    const size_t tstepA = 2 * hstepA, tstepB = 2 * hstepB;
    const unsigned ldsw = (unsigned)wid * 1024u;
    const int aoff = lds_byte(wr * 64 + fr, fq * 8), boff = lds_byte(wc * 32 + fr, fq * 8);
#define PG8_SA(b, h) (((b) * 2 + (h)) * HTB)
#define PG8_SB(b, h) ((4 + (b) * 2 + (h)) * HTB)
#define PG8_STAGE(bufoff, gbase, voff) do { _Pragma("unroll") for (int _i = 0; _i < 2; ++_i) \
        __builtin_amdgcn_global_load_lds((const unsigned*)((const char*)(gbase) + (voff)[_i]), (PG8_LAS unsigned*)(lds + (bufoff) + ldsw + _i * 8192), 16, 0, 0); } while (0)
#define PG8_LDA(dst, b, h) do { _Pragma("unroll") for (int m = 0; m < 4; ++m) _Pragma("unroll") for (int k = 0; k < 2; ++k) dst[m][k] = *(const PG8_LAS bf16x8*)(lds + PG8_SA(b, h) + aoff + m * 2048 + k * 1024); } while (0)
#define PG8_LDB(dst, b, h) do { _Pragma("unroll") for (int n = 0; n < 2; ++n) _Pragma("unroll") for (int k = 0; k < 2; ++k) dst[n][k] = *(const PG8_LAS bf16x8*)(lds + PG8_SB(b, h) + boff + n * 2048 + k * 1024); } while (0)
#define PG8_MMA(ai, bj, At, Bt) do { __builtin_amdgcn_s_setprio(1); _Pragma("unroll") for (int m = 0; m < 4; ++m) _Pragma("unroll") for (int n = 0; n < 2; ++n) _Pragma("unroll") for (int k = 0; k < 2; ++k) \
        acc[ai][bj][m][n] = __builtin_amdgcn_mfma_f32_16x16x32_bf16(Bt[n][k], At[m][k], acc[ai][bj][m][n], 0, 0, 0); __builtin_amdgcn_s_setprio(0); } while (0)
#define PG8_WAIT_V(n) asm volatile("s_waitcnt vmcnt(" #n ")" ::: "memory")
#define PG8_WAIT_L(n) asm volatile("s_waitcnt lgkmcnt(" #n ")" ::: "memory")
#define PG8_BAR __builtin_amdgcn_s_barrier()
#define PG8_SCHED __builtin_amdgcn_sched_barrier(0)
    Unit cur, nxt; int ui = 0;
    if (!S.next(0, cur)) return;
    f32x4 acc[2][2][4][2];
#pragma unroll
    for (int a = 0; a < 2; ++a)
#pragma unroll
        for (int b = 0; b < 2; ++b)
#pragma unroll
            for (int m = 0; m < 4; ++m)
#pragma unroll
                for (int n = 0; n < 2; ++n) acc[a][b][m][n] = (f32x4){0.f, 0.f, 0.f, 0.f};
    bf16x8 At[4][2], B0[2][2], B1[2][2];
    const char* cA = (const char*)g.A + (size_t)cur.pm * tstepA; const char* cB = (const char*)g.Bt + (size_t)cur.pn * tstepB;
    S.a_ready(cur);
    if constexpr (SP2) {
        PG8_STAGE(PG8_SB(0, 0), cB, voffB); PG8_STAGE(PG8_SB(0, 1), cB + hstepB, voffB); PG8_STAGE(PG8_SA(0, 0), cA, voffA); PG8_STAGE(PG8_SA(0, 1), cA + hstepA, voffA);
        if (wr == 1) PG8_BAR;
        PG8_WAIT_V(2); PG8_BAR;
        PG8_STAGE(PG8_SB(1, 0), cB + kstep, voffB); PG8_STAGE(PG8_SA(1, 0), cA + kstep, voffA); PG8_STAGE(PG8_SB(1, 1), cB + hstepB + kstep, voffB);
        PG8_WAIT_V(6); PG8_BAR;
    } else {
        PG8_STAGE(PG8_SB(0, 0), cB, voffB); PG8_STAGE(PG8_SA(0, 0), cA, voffA); PG8_STAGE(PG8_SB(0, 1), cB + hstepB, voffB); PG8_STAGE(PG8_SA(0, 1), cA + hstepA, voffA);
        if (wr == 1) PG8_BAR;
        PG8_WAIT_V(4); PG8_BAR;
        PG8_STAGE(PG8_SB(1, 0), cB + kstep, voffB); PG8_STAGE(PG8_SA(1, 0), cA + kstep, voffA); PG8_STAGE(PG8_SB(1, 1), cB + hstepB + kstep, voffB);
        PG8_WAIT_V(6); PG8_BAR;
    }
    for (;;) {
        const bool has_next = S.next(ui + 1, nxt);
        const char* nA = has_next ? (const char*)g.A + (size_t)nxt.pm * tstepA : cA; const char* nB = has_next ? (const char*)g.Bt + (size_t)nxt.pn * tstepB : cB;
        for (int t = 0; t < nt; t += 2) {
            const bool last = (t == nt - 2);
            const char* a1 = cA + (size_t)(t + 1) * kstep;
            const char* a2 = last ? nA : cA + (size_t)(t + 2) * kstep; const char* b2 = last ? nB : cB + (size_t)(t + 2) * kstep;
            const char* a3 = a2 + kstep; const char* b3 = b2 + kstep;
            if (last && has_next) S.a_ready(nxt);
            if constexpr (SP2) {
            PG8_LDB(B0, 0, 0); PG8_LDB(B1, 0, 1); PG8_SCHED; PG8_LDA(At, 0, 0); PG8_STAGE(PG8_SA(1, 1), a1 + hstepA, voffA);
            PG8_WAIT_V(8); PG8_WAIT_L(0); PG8_BAR; PG8_MMA(0, 0, At, B0); PG8_MMA(0, 1, At, B1); PG8_BAR; PG8_SCHED;
            PG8_LDA(At, 0, 1); PG8_STAGE(PG8_SB(0, 0), b2, voffB); PG8_STAGE(PG8_SB(0, 1), b2 + hstepB, voffB); PG8_STAGE(PG8_SA(0, 0), a2, voffA);
            PG8_WAIT_V(8); PG8_WAIT_L(0); PG8_BAR; PG8_MMA(1, 0, At, B0); PG8_MMA(1, 1, At, B1); PG8_BAR; PG8_SCHED;
            PG8_LDB(B0, 1, 0); PG8_LDB(B1, 1, 1); PG8_SCHED; PG8_LDA(At, 1, 0); PG8_STAGE(PG8_SA(0, 1), a2 + hstepA, voffA);
            PG8_WAIT_V(8); PG8_WAIT_L(0); PG8_BAR; PG8_MMA(0, 0, At, B0); PG8_MMA(0, 1, At, B1); PG8_BAR; PG8_SCHED;
            PG8_LDA(At, 1, 1); PG8_STAGE(PG8_SB(1, 0), b3, voffB); PG8_STAGE(PG8_SB(1, 1), b3 + hstepB, voffB); PG8_STAGE(PG8_SA(1, 0), a3, voffA);
            PG8_WAIT_V(8); PG8_WAIT_L(0); PG8_BAR; PG8_MMA(1, 0, At, B0); PG8_MMA(1, 1, At, B1); PG8_BAR; PG8_SCHED;
            } else {
            PG8_LDB(B0, 0, 0); PG8_SCHED; PG8_LDA(At, 0, 0); PG8_STAGE(PG8_SA(1, 1), a1 + hstepA, voffA);
            PG8_WAIT_L(8); PG8_BAR; PG8_WAIT_L(0); PG8_MMA(0, 0, At, B0); PG8_BAR; PG8_SCHED;
            PG8_LDB(B1, 0, 1); PG8_STAGE(PG8_SB(0, 0), b2, voffB);
            PG8_BAR; PG8_WAIT_L(0); PG8_MMA(0, 1, At, B1); PG8_BAR;
            PG8_LDA(At, 0, 1); PG8_STAGE(PG8_SA(0, 0), a2, voffA);
            PG8_BAR; PG8_WAIT_L(0); PG8_MMA(1, 0, At, B0); PG8_BAR; PG8_SCHED;
            PG8_STAGE(PG8_SB(0, 1), b2 + hstepB, voffB);
            PG8_WAIT_V(6); PG8_BAR; PG8_MMA(1, 1, At, B1); PG8_BAR;
            PG8_LDB(B0, 1, 0); PG8_SCHED; PG8_LDA(At, 1, 0); PG8_STAGE(PG8_SA(0, 1), a2 + hstepA, voffA);
            PG8_WAIT_L(8); PG8_BAR; PG8_WAIT_L(0); PG8_MMA(0, 0, At, B0); PG8_BAR; PG8_SCHED;
            PG8_LDB(B1, 1, 1); PG8_STAGE(PG8_SB(1, 0), b3, voffB);
            PG8_BAR; PG8_WAIT_L(0); PG8_MMA(0, 1, At, B1); PG8_BAR;
            PG8_LDA(At, 1, 1); PG8_STAGE(PG8_SA(1, 0), a3, voffA);
            PG8_BAR; PG8_WAIT_L(0); PG8_MMA(1, 0, At, B0); PG8_BAR; PG8_SCHED;
            PG8_STAGE(PG8_SB(1, 1), b3 + hstepB, voffB);
            PG8_WAIT_V(6); PG8_BAR; PG8_MMA(1, 1, At, B1); PG8_BAR;
            }
        }
        if constexpr (ALIGN_EPI) { if (wr == 0) PG8_BAR; }
        if constexpr (!Epi::AFTER_DRAIN) { E(acc, cur, wr, wc, fr, fq); S.done(cur); }
        if (!has_next) break;
#pragma unroll
        for (int a = 0; a < 2; ++a)
#pragma unroll
            for (int b = 0; b < 2; ++b)
#pragma unroll
                for (int m = 0; m < 4; ++m)
#pragma unroll
                    for (int n = 0; n < 2; ++n) acc[a][b][m][n] = (f32x4){0.f, 0.f, 0.f, 0.f};
        cur = nxt; cA = nA; cB = nB; ++ui;
        if constexpr (ALIGN_EPI) { if (wr == 1) PG8_BAR; }
    }
    PG8_WAIT_V(0);
    if constexpr (!ALIGN_EPI) { if (wr == 0) PG8_BAR; }
    PG8_BAR;
    if constexpr (Epi::AFTER_DRAIN) { E.fused(acc, cur, wr, wc, fr, fq, lds, wid, lane); S.done(cur); }
#undef PG8_SA
#undef PG8_SB
#undef PG8_STAGE
#undef PG8_LDA
#undef PG8_LDB
#undef PG8_MMA
#undef PG8_WAIT_V
#undef PG8_WAIT_L
#undef PG8_BAR
#undef PG8_SCHED
}
}
namespace pg8 {
__device__ __forceinline__ unsigned cvtpk(float lo, float hi) { typedef float f2_t __attribute__((ext_vector_type(2))); typedef __bf16 b2_t __attribute__((ext_vector_type(2))); f2_t v = {lo, hi}; b2_t b = __builtin_convertvector(v, b2_t); return __builtin_bit_cast(unsigned, b); }
__device__ __forceinline__ u32x4 pack8(const f32x4& v0, const f32x4& v1) { u32x4 w; w.x = cvtpk(v0[0], v0[1]); w.y = cvtpk(v0[2], v0[3]); w.z = cvtpk(v1[0], v1[1]); w.w = cvtpk(v1[2], v1[3]); return w; }
struct EpiPlain {
    static constexpr bool PERM = true, AFTER_DRAIN = false;
    bf16_t* O; int ldc;
    __device__ __forceinline__ void operator()(const f32x4 (&acc)[2][2][4][2], const Unit& u, int wr, int wc, int fr, int fq) const {
        const int row0 = u.pm * BM + wr * 64 + fr, col0 = u.pn * BM + wc * 32 + 8 * fq;
#pragma unroll
        for (int ai = 0; ai < 2; ++ai)
#pragma unroll
            for (int m = 0; m < 4; ++m) { bf16_t* rowp = O + (size_t)(row0 + ai * HALF + m * 16) * ldc + col0;
#pragma unroll
                for (int bj = 0; bj < 2; ++bj) *(u32x4*)(rowp + bj * HALF) = pack8(acc[ai][bj][m][0], acc[ai][bj][m][1]); }
    }
};
struct EpiRowScaleRope {
    static constexpr bool PERM = true, AFTER_DRAIN = false;
    bf16_t* O; int ldc; float mult; int rope_pn0; const float* cs;
    __device__ __forceinline__ void operator()(const f32x4 (&acc)[2][2][4][2], const Unit& u, int wr, int wc, int fr, int fq) const {
        const int row0 = u.pm * BM + wr * 64 + fr, col0 = u.pn * BM + wc * 32 + 8 * fq;
        const bool rope = u.pn >= rope_pn0;
#pragma unroll
        for (int ai = 0; ai < 2; ++ai)
#pragma unroll
            for (int m = 0; m < 4; ++m) { const int row = row0 + ai * HALF + m * 16; const float s = mult;
                f32x4 a0 = acc[ai][0][m][0] * s, a1 = acc[ai][0][m][1] * s, b0 = acc[ai][1][m][0] * s, b1 = acc[ai][1][m][1] * s;
                if (rope) { const f32x4* cp = (const f32x4*)(cs + (size_t)row * 64 + 16 * fq);
                    const f32x4 c0 = cp[0], c1 = cp[1], c2 = cp[2], c3 = cp[3];
                    f32x4 x0, x1, y0, y1;
                    x0[0] = a0[0] * c0[0] - b0[0] * c0[1]; y0[0] = b0[0] * c0[0] + a0[0] * c0[1];
                    x0[1] = a0[1] * c0[2] - b0[1] * c0[3]; y0[1] = b0[1] * c0[2] + a0[1] * c0[3];
                    x0[2] = a0[2] * c1[0] - b0[2] * c1[1]; y0[2] = b0[2] * c1[0] + a0[2] * c1[1];
                    x0[3] = a0[3] * c1[2] - b0[3] * c1[3]; y0[3] = b0[3] * c1[2] + a0[3] * c1[3];
                    x1[0] = a1[0] * c2[0] - b1[0] * c2[1]; y1[0] = b1[0] * c2[0] + a1[0] * c2[1];
                    x1[1] = a1[1] * c2[2] - b1[1] * c2[3]; y1[1] = b1[1] * c2[2] + a1[1] * c2[3];
                    x1[2] = a1[2] * c3[0] - b1[2] * c3[1]; y1[2] = b1[2] * c3[0] + a1[2] * c3[1];
                    x1[3] = a1[3] * c3[2] - b1[3] * c3[3]; y1[3] = b1[3] * c3[2] + a1[3] * c3[3];
                    a0 = x0; a1 = x1; b0 = y0; b1 = y1; }
                bf16_t* rowp = O + (size_t)row * ldc + col0;
                *(u32x4*)(rowp) = pack8(a0, a1); *(u32x4*)(rowp + HALF) = pack8(b0, b1); }
    }
};
struct EpiColScale {
    static constexpr bool PERM = true, AFTER_DRAIN = false;
    bf16_t* O; int ldc; const float* cscale;
    __device__ __forceinline__ void operator()(const f32x4 (&acc)[2][2][4][2], const Unit& u, int wr, int wc, int fr, int fq) const {
        const int row0 = u.pm * BM + wr * 64 + fr, col0 = u.pn * BM + wc * 32 + 8 * fq;
#pragma unroll
        for (int bj = 0; bj < 2; ++bj) { const f32x4 s0 = *(const f32x4*)(cscale + col0 + bj * HALF), s1 = *(const f32x4*)(cscale + col0 + bj * HALF + 4);
#pragma unroll
            for (int ai = 0; ai < 2; ++ai)
#pragma unroll
                for (int m = 0; m < 4; ++m) *(u32x4*)(O + (size_t)(row0 + ai * HALF + m * 16) * ldc + col0 + bj * HALF) = pack8(acc[ai][bj][m][0] * s0, acc[ai][bj][m][1] * s1);
            asm volatile("" ::: "memory"); }
    }
};
struct EpiSwiGLU {
    static constexpr bool PERM = true, AFTER_DRAIN = false;
    bf16_t* O; int ldc;
    __device__ __forceinline__ void operator()(const f32x4 (&acc)[2][2][4][2], const Unit& u, int wr, int wc, int fr, int fq) const {
        const int row0 = u.pm * BM + wr * 64 + fr, col0 = u.pn * HALF + wc * 32 + 8 * fq;
#pragma unroll
        for (int ai = 0; ai < 2; ++ai)
#pragma unroll
            for (int m = 0; m < 4; ++m) { f32x4 r[2];
#pragma unroll
                for (int n = 0; n < 2; ++n) { const f32x4 g = acc[ai][0][m][n], up = acc[ai][1][m][n];
#pragma unroll
                    for (int e = 0; e < 4; ++e) r[n][e] = g[e] * __builtin_amdgcn_rcpf(1.0f + __expf(-g[e])) * up[e]; }
                *(u32x4*)(O + (size_t)(row0 + ai * HALF + m * 16) * ldc + col0) = pack8(r[0], r[1]); }
    }
};
}
#define LAS __attribute__((address_space(3)))
typedef unsigned short bf16_t;
typedef short bf16x8 __attribute__((ext_vector_type(8)));
typedef float f32x4 __attribute__((ext_vector_type(4)));
typedef unsigned u32x4 __attribute__((ext_vector_type(4)));
typedef unsigned u32x2 __attribute__((ext_vector_type(2)));
constexpr int BATCH = 2, SEQ = 8192, DM = 2048, M = BATCH * SEQ, DFF = 5632, NADA = 6 * DM;
constexpr int ZC = 4096;
constexpr int ZO_CQ = 0, ZO_CKV = 512, ZO_QG = 768, ZO_KG = 1280, ZO_VG = 1792, ZO_RG = 2816, ZO_KR = 3840, ZO_AG = 3904;
constexpr int QC = 1536;
constexpr float RMS_EPS = 1e-6f;
constexpr float QSCALE = 0.07216878364870323f * 1.4426950408889634f;
constexpr int KS_ADA = 16;
constexpr size_t MiB = 1u << 20;
constexpr size_t WS_ADAP = 0, WS_ADA = 1536 * 1024, WS_RSTDQ = 1792 * 1024, WS_RSTDKV = 1856 * 1024, WS_DECAY = 2 * MiB, WS_CS = 3 * MiB, WS_KROPE = 7 * MiB;
constexpr size_t WS_WIN = 10 * MiB, WS_WUQ = 26 * MiB, WS_WUK = 28 * MiB, WS_WUV = 29 * MiB, WS_WOUT = 30 * MiB, WS_WGU = 38 * MiB, WS_WD = 82 * MiB;
constexpr size_t WS_XN = 104 * MiB;
constexpr size_t WS_Q = 168 * MiB, WS_KN = 216 * MiB, WS_VT = 248 * MiB, WS_QDEC = 280 * MiB, WS_OI = 296 * MiB, WS_ST = 328 * MiB;
constexpr size_t WS_O = 168 * MiB;
constexpr size_t WS_ACT = 232 * MiB, WS_CQN = 392 * MiB, WS_CKVN = 408 * MiB, WS_X1 = 416 * MiB, WS_END = 480 * MiB;
constexpr size_t WS_CTL = 9 * MiB, CTL_BYTES = 65536;
constexpr int NTHREADS = 512, LDS_BYTES = 147456, MISC_OFF = 131072 + 320;

__device__ const double INVF_REV[32] = {
    1.59154943091895346e-01,
    1.19349370211248862e-01,
    8.94994016088910133e-02,
    6.71150830052272551e-02,
    5.03292121044870353e-02,
    3.77415847174197711e-02,
    2.83021958306233987e-02,
    2.12236527647776604e-02,
    1.59154943091895339e-02,
    1.19349370211248862e-02,
    8.94994016088910237e-03,
    6.71150830052272534e-03,
    5.03292121044870370e-03,
    3.77415847174197719e-03,
    2.83021958306233987e-03,
    2.12236527647776622e-03,
    1.59154943091895356e-03,
    1.19349370211248849e-03,
    8.94994016088910237e-04,
    6.71150830052272599e-04,
    5.03292121044870326e-04,
    3.77415847174197741e-04,
    2.83021958306233954e-04,
    2.12236527647776605e-04,
    1.59154943091895351e-04,
    1.19349370211248862e-04,
    8.94994016088910182e-05,
    6.71150830052272545e-05,
    5.03292121044870354e-05,
    3.77415847174197768e-05,
    2.83021958306233961e-05,
    2.12236527647776592e-05

};

struct Params {
    const float *x, *c; const int* pos; const float *w_ada, *b_ada, *g_pre_mix, *g_post_mix, *w_in, *g_q, *w_uq, *g_kv, *w_uk, *w_uv, *w_gate_up, *b_gate, *g_gla, *w_out, *g_pre_ffn, *g_post_ffn, *w_fg, *w_fu, *w_fd;
    float* out; unsigned char* ws;
};

__device__ __forceinline__ int opaque_tid() { int t = threadIdx.x; asm volatile("" : "+v"(t)); return t; }
__device__ __forceinline__ float bf2f(unsigned short u) { return __uint_as_float((unsigned)u << 16); }
__device__ __forceinline__ unsigned short f2bf(float f) { unsigned u = __float_as_uint(f); return (unsigned short)((u + 0x7fffu + ((u >> 16) & 1u)) >> 16); }
__device__ __forceinline__ unsigned pk2(float lo, float hi) { return pg8::cvtpk(lo, hi); }
__device__ __forceinline__ float wave_sum(float v) {
#pragma unroll
    for (int o = 1; o < 64; o <<= 1) v += __shfl_xor(v, o);
    return v;
}
__device__ __forceinline__ float silu_f(float v) { return v * __builtin_amdgcn_rcpf(1.0f + __expf(-v)); }
#define MFMA16(a, b, c) __builtin_amdgcn_mfma_f32_16x16x32_bf16((a), (b), (c), 0, 0, 0)

struct MapIn { const float* W;
    __device__ __forceinline__ const float* col(int n, int& ld) const { ld = 3920; int s;
        if (n < 768) s = n; else if (n < 1280) s = 832 + (n - 768); else if (n < 1792) s = 1344 + (n - 1280); else if (n < 2816) s = 1856 + (n - 1792);
        else if (n < 3840) s = 2896 + (n - 2816); else if (n < 3904) s = 768 + (n - 3840); else if (n < 3920) s = 2880 + (n - 3904); else return nullptr;
        return W + s; } };
struct MapUq { const float* W;
    __device__ __forceinline__ const float* col(int n, int& ld) const { ld = 1536; int s;
        if (n < 1024) s = (n >> 7) * 192 + (n & 127);
        else { const int mm = n - 1024, tile = mm >> 8, w = mm & 255, half = w >> 7, hh = (w & 127) >> 5, i = w & 31; s = (tile * 4 + hh) * 192 + 128 + half * 32 + i; }
        return W + s; } };
struct MapId { const float* W; int ldw;
    __device__ __forceinline__ const float* col(int n, int& ld) const { ld = ldw; return W + n; } };
struct MapGU { const float* Wg; const float* Wu;
    __device__ __forceinline__ const float* col(int n, int& ld) const { ld = DFF; const int tile = n >> 8, w = n & 255; return (w < 128) ? (Wg + tile * 128 + w) : (Wu + tile * 128 + (w - 128)); } };
template <class Map>
__device__ __forceinline__ void transpose_item(const Map& mp, const float* gain, int K, bf16_t* WT, int item, int nblk, int lane, bool late = false) {
    const int kb = item / nblk, nb = item % nblk, k0 = 64 * kb, n0 = 64 * nb, kq = lane >> 4, nc = lane & 15;
    int ld; const float* src = mp.col(n0 + 4 * nc, ld);
    f32x4 v[16];
    if (src) { src += (size_t)(k0 + 16 * kq) * ld;
#pragma unroll
        for (int i = 0; i < 16; ++i) v[i] = __builtin_nontemporal_load((const f32x4*)(src + (size_t)i * ld));
    } else {
#pragma unroll
        for (int i = 0; i < 16; ++i) v[i] = (f32x4){0.f, 0.f, 0.f, 0.f};
    }
    if (gain) {
#pragma unroll
        for (int i = 0; i < 16; ++i) v[i] *= gain[k0 + 16 * kq + i];
    }
#pragma unroll
    for (int e = 0; e < 4; ++e) { bf16_t* dst = WT + (size_t)(n0 + 4 * nc + e) * K + k0 + 16 * kq;
        u32x4 w0, w1; w0.x = pk2(v[0][e], v[1][e]); w0.y = pk2(v[2][e], v[3][e]); w0.z = pk2(v[4][e], v[5][e]); w0.w = pk2(v[6][e], v[7][e]);
        w1.x = pk2(v[8][e], v[9][e]); w1.y = pk2(v[10][e], v[11][e]); w1.z = pk2(v[12][e], v[13][e]); w1.w = pk2(v[14][e], v[15][e]);
        if (late) { __builtin_nontemporal_store(w0, (u32x4*)dst); __builtin_nontemporal_store(w1, (u32x4*)(dst + 8)); }
        else { *(u32x4*)dst = w0; *(u32x4*)(dst + 8) = w1; } }
}

__device__ __forceinline__ void p0_prologue(const Params& P, LAS unsigned char* lds, int G) {
    const int tid = opaque_tid(), lane = tid & 63, wave = tid >> 6;
    unsigned char* ws = P.ws;
    const int gw = wave * G + blockIdx.x, NGW = G * 8;
    float* adap = (float*)(ws + WS_ADAP);
    for (int it = gw; it < 48 * KS_ADA; it += NGW) {
        const int nc = it % 48, ks = it / 48, n0 = nc * 256 + lane * 4;
        f32x4 a0 = {0.f, 0.f, 0.f, 0.f}, a1 = {0.f, 0.f, 0.f, 0.f};
#pragma unroll 16
        for (int kk = 0; kk < 128; ++kk) { const int k = ks * 128 + kk; const f32x4 w = __builtin_nontemporal_load((const f32x4*)(P.w_ada + (size_t)k * NADA + n0));
            const float s0 = silu_f(P.c[k]), s1 = silu_f(P.c[DM + k]); a0 += w * s0; a1 += w * s1; }
        *(f32x4*)(adap + (size_t)(ks * 2 + 0) * NADA + n0) = a0; *(f32x4*)(adap + (size_t)(ks * 2 + 1) * NADA + n0) = a1;
    }
    constexpr int I_IN = 32 * 64, I_UQ = 8 * 24, I_UK = 4 * 16, I_UV = 4 * 16, I_OUT = 32 * 32, I_GU = 32 * 176, I_D = 88 * 32;
    constexpr int NITEMS = I_IN + I_UQ + I_UK + I_UV + I_OUT + I_GU + I_D;
    for (int it = gw; it < NITEMS; it += NGW) {
        int r = it;
        if (r < I_IN) { transpose_item(MapIn{P.w_in}, nullptr, 2048, (bf16_t*)(ws + WS_WIN), r, 64, lane); continue; } r -= I_IN;
        if (r < I_UQ) { transpose_item(MapUq{P.w_uq}, P.g_q, 512, (bf16_t*)(ws + WS_WUQ), r, 24, lane); continue; } r -= I_UQ;
        if (r < I_UK) { transpose_item(MapId{P.w_uk, 1024}, P.g_kv, 256, (bf16_t*)(ws + WS_WUK), r, 16, lane); continue; } r -= I_UK;
        if (r < I_UV) { transpose_item(MapId{P.w_uv, 1024}, P.g_kv, 256, (bf16_t*)(ws + WS_WUV), r, 16, lane); continue; } r -= I_UV;
        if (r < I_OUT) { transpose_item(MapId{P.w_out, 2048}, nullptr, 2048, (bf16_t*)(ws + WS_WOUT), r, 32, lane, true); continue; } r -= I_OUT;
        if (r < I_GU) { transpose_item(MapGU{P.w_fg, P.w_fu}, nullptr, 2048, (bf16_t*)(ws + WS_WGU), r, 176, lane, true); continue; } r -= I_GU;
        transpose_item(MapId{P.w_fd, 2048}, nullptr, DFF, (bf16_t*)(ws + WS_WD), r, 32, lane, true);
    }
    float* cs = (float*)(ws + WS_CS);
    for (int idx = blockIdx.x * NTHREADS + tid; idx < M * 32; idx += G * NTHREADS) {
        const int m = idx >> 5, i = idx & 31; const double rev = (double)P.pos[m] * INVF_REV[i]; const float fr = (float)(rev - floor(rev));
        cs[2 * idx] = __builtin_amdgcn_cosf(fr); cs[2 * idx + 1] = __builtin_amdgcn_sinf(fr);
    }
}

__device__ __forceinline__ void p1_rows(const Params& P, LAS unsigned char* lds, int G) {
    const int tid = opaque_tid(), lane = tid & 63, wave = tid >> 6;
    const float* adap = (const float*)(P.ws + WS_ADAP); float* ada = (float*)(P.ws + WS_ADA);
    LAS float* TA = (LAS float*)lds;
    LAS float* TC = TA + 2 * DM;
    for (int idx = tid; idx < 2 * DM; idx += NTHREADS) { const int b = idx >> 11, col = idx & (DM - 1);
        float sh = P.b_ada[col], sc = P.b_ada[DM + col];
        for (int ks = 0; ks < KS_ADA; ++ks) { sh += adap[(size_t)(ks * 2 + b) * NADA + col]; sc += adap[(size_t)(ks * 2 + b) * NADA + DM + col]; }
        TA[idx] = P.g_pre_mix[col] * (1.0f + sc); TC[idx] = sh; }
    for (int idx = blockIdx.x * NTHREADS + tid; idx < 2 * NADA; idx += G * NTHREADS) { const int b = idx / NADA, n = idx % NADA; float v = P.b_ada[n];
        for (int ks = 0; ks < KS_ADA; ++ks) v += adap[(size_t)(ks * 2 + b) * NADA + n];
        ada[idx] = v; }
    __syncthreads();
    bf16_t* XN = (bf16_t*)(P.ws + WS_XN);
    for (int m = blockIdx.x * 8 + wave; m < M; m += G * 8) {
        const int b = m >> 13; const f32x4* xr = (const f32x4*)(P.x + (size_t)m * DM) + lane;
        f32x4 v[8]; float ss = 0.f;
#pragma unroll
        for (int j = 0; j < 8; ++j) { v[j] = __builtin_nontemporal_load(xr + 64 * j); ss += (v[j][0] * v[j][0] + v[j][1] * v[j][1]) + (v[j][2] * v[j][2] + v[j][3] * v[j][3]); }
        const float rstd = rsqrtf(wave_sum(ss) * (1.0f / DM) + RMS_EPS);
        u32x2* o = (u32x2*)(XN + (size_t)m * DM) + lane;
#pragma unroll
        for (int j = 0; j < 8; ++j) { const f32x4 a = *(const LAS f32x4*)(TA + b * DM + 256 * j + 4 * lane), c = *(const LAS f32x4*)(TC + b * DM + 256 * j + 4 * lane);
            const f32x4 h = v[j] * rstd * a + c; u32x2 w; w.x = pk2(h[0], h[1]); w.y = pk2(h[2], h[3]); o[64 * j] = w; }
    }
}
__device__ __forceinline__ void p2b_rows(const Params& P, int G) {
    const int tid = opaque_tid(), lane = tid & 63, wave = tid >> 6;
    const bf16_t* Z = (const bf16_t*)P.out; bf16_t* CQN = (bf16_t*)(P.ws + WS_CQN); bf16_t* CKVN = (bf16_t*)(P.ws + WS_CKVN);
    const float* cs = (const float*)(P.ws + WS_CS); bf16_t* KR = (bf16_t*)(P.ws + WS_KROPE);
    for (int m = blockIdx.x * 8 + wave; m < M; m += G * 8) {
        const bf16_t* zr = Z + (size_t)m * ZC;
        const u32x4 a = *(const u32x4*)(zr + ZO_CQ + 8 * lane); const u32x2 k = *(const u32x2*)(zr + ZO_CKV + 4 * lane);
        float s1 = 0.f, s2 = 0.f;
#pragma unroll
        for (int e = 0; e < 4; ++e) { const float lo = __uint_as_float(a[e] << 16), hi = __uint_as_float(a[e] & 0xffff0000u); s1 += lo * lo + hi * hi; }
#pragma unroll
        for (int e = 0; e < 2; ++e) { const float lo = __uint_as_float(k[e] << 16), hi = __uint_as_float(k[e] & 0xffff0000u); s2 += lo * lo + hi * hi; }
        s1 = wave_sum(s1); s2 = wave_sum(s2);
        const float r1 = rsqrtf(s1 * (1.0f / 512.0f) + RMS_EPS), r2 = rsqrtf(s2 * (1.0f / 256.0f) + RMS_EPS);
        { u32x4 w;
#pragma unroll
          for (int e = 0; e < 4; ++e) w[e] = pk2(__uint_as_float(a[e] << 16) * r1, __uint_as_float(a[e] & 0xffff0000u) * r1);
          *(u32x4*)(CQN + (size_t)m * 512 + 8 * lane) = w;
          u32x2 w2;
#pragma unroll
          for (int e = 0; e < 2; ++e) w2[e] = pk2(__uint_as_float(k[e] << 16) * r2, __uint_as_float(k[e] & 0xffff0000u) * r2);
          *(u32x2*)(CKVN + (size_t)m * 256 + 4 * lane) = w2; }
        if (lane < 32) { const float x1 = bf2f(zr[ZO_KR + lane]), x2 = bf2f(zr[ZO_KR + 32 + lane]); const float c = cs[(size_t)m * 64 + 2 * lane], s = cs[(size_t)m * 64 + 2 * lane + 1];
            KR[(size_t)m * 64 + lane] = f2bf(x1 * c - x2 * s); KR[(size_t)m * 64 + 32 + lane] = f2bf(x2 * c + x1 * s); }
    }
}
__device__ __forceinline__ void p7_rows(const Params& P, LAS unsigned char* lds, int G) {
    const int tid = opaque_tid(), lane = tid & 63, wave = tid >> 6;
    const float* ada = (const float*)(P.ws + WS_ADA);
    LAS float* TA = (LAS float*)lds; LAS float* TB = TA + 2 * DM; LAS float* TC = TB + 2 * DM;
    for (int idx = tid; idx < 2 * DM; idx += NTHREADS) { const int b = idx >> 11, col = idx & (DM - 1); const float* ab = ada + (size_t)b * NADA;
        TA[idx] = ab[2 * DM + col] * P.g_post_mix[col]; TB[idx] = P.g_pre_ffn[col] * (1.0f + ab[4 * DM + col]); TC[idx] = ab[3 * DM + col]; }
    __syncthreads();
    const bf16_t* O = (const bf16_t*)(P.ws + WS_O); bf16_t* XN = (bf16_t*)(P.ws + WS_XN);
    for (int m = blockIdx.x * 8 + wave; m < M; m += G * 8) {
        const int b = m >> 13; const f32x4* xr = (const f32x4*)(P.x + (size_t)m * DM) + lane; const u32x2* orow = (const u32x2*)(O + (size_t)m * DM) + lane;
        f32x4 v[8], xv[8]; float ss = 0.f;
#pragma unroll
        for (int j = 0; j < 8; ++j) xv[j] = __builtin_nontemporal_load(xr + 64 * j);
#pragma unroll
        for (int j = 0; j < 8; ++j) { const u32x2 w = __builtin_nontemporal_load(orow + 64 * j); v[j][0] = __uint_as_float(w.x << 16); v[j][1] = __uint_as_float(w.x & 0xffff0000u); v[j][2] = __uint_as_float(w.y << 16); v[j][3] = __uint_as_float(w.y & 0xffff0000u);
            ss += (v[j][0] * v[j][0] + v[j][1] * v[j][1]) + (v[j][2] * v[j][2] + v[j][3] * v[j][3]); }
        const float rstd = rsqrtf(wave_sum(ss) * (1.0f / DM) + RMS_EPS);
        float s2 = 0.f; u32x2* x1r = (u32x2*)((bf16_t*)(P.ws + WS_X1) + (size_t)m * DM) + lane;
#pragma unroll
        for (int j = 0; j < 8; ++j) { const f32x4 a = *(const LAS f32x4*)(TA + b * DM + 256 * j + 4 * lane); const f32x4 x1 = xv[j] + v[j] * rstd * a; v[j] = x1; { u32x2 w; w.x = pk2(x1[0], x1[1]); w.y = pk2(x1[2], x1[3]); __builtin_nontemporal_store(w, x1r + 64 * j); }
            s2 += (x1[0] * x1[0] + x1[1] * x1[1]) + (x1[2] * x1[2] + x1[3] * x1[3]); }
        const float rstd2 = rsqrtf(wave_sum(s2) * (1.0f / DM) + RMS_EPS);
        u32x2* o = (u32x2*)(XN + (size_t)m * DM) + lane;
#pragma unroll
        for (int j = 0; j < 8; ++j) { const f32x4 a = *(const LAS f32x4*)(TB + b * DM + 256 * j + 4 * lane), c = *(const LAS f32x4*)(TC + b * DM + 256 * j + 4 * lane);
            const f32x4 h = v[j] * rstd2 * a + c; u32x2 w; w.x = pk2(h[0], h[1]); w.y = pk2(h[2], h[3]); o[64 * j] = w; }
    }
}
__device__ __forceinline__ void p10_rows(const Params& P, LAS unsigned char* lds, int G) {
    const int tid = opaque_tid(), lane = tid & 63, wave = tid >> 6;
    const float* ada = (const float*)(P.ws + WS_ADA);
    LAS float* TA = (LAS float*)lds;
    for (int idx = tid; idx < 2 * DM; idx += NTHREADS) { const int b = idx >> 11, col = idx & (DM - 1); TA[idx] = ada[(size_t)b * NADA + 5 * DM + col] * P.g_post_ffn[col]; }
    __syncthreads();
    const bf16_t* F = (const bf16_t*)(P.ws + WS_O);
    for (int m = blockIdx.x * 8 + wave; m < M; m += G * 8) {
        const int b = m >> 13; const u32x2* fr = (const u32x2*)(F + (size_t)m * DM) + lane; f32x4* outr = (f32x4*)(P.out + (size_t)m * DM) + lane; const u32x2* x1r = (const u32x2*)((const bf16_t*)(P.ws + WS_X1) + (size_t)m * DM) + lane;
        f32x4 v[8]; u32x2 xw8[8]; float ss = 0.f;
#pragma unroll
        for (int j = 0; j < 8; ++j) xw8[j] = __builtin_nontemporal_load(x1r + 64 * j);
#pragma unroll
        for (int j = 0; j < 8; ++j) { const u32x2 w = __builtin_nontemporal_load(fr + 64 * j); v[j][0] = __uint_as_float(w.x << 16); v[j][1] = __uint_as_float(w.x & 0xffff0000u); v[j][2] = __uint_as_float(w.y << 16); v[j][3] = __uint_as_float(w.y & 0xffff0000u);
            ss += (v[j][0] * v[j][0] + v[j][1] * v[j][1]) + (v[j][2] * v[j][2] + v[j][3] * v[j][3]); }
        const float rstd = rsqrtf(wave_sum(ss) * (1.0f / DM) + RMS_EPS);
#pragma unroll
        for (int j = 0; j < 8; ++j) { const f32x4 a = *(const LAS f32x4*)(TA + b * DM + 256 * j + 4 * lane); const u32x2 xw = xw8[j]; f32x4 x1; x1[0] = __uint_as_float(xw.x << 16); x1[1] = __uint_as_float(xw.x & 0xffff0000u); x1[2] = __uint_as_float(xw.y << 16); x1[3] = __uint_as_float(xw.y & 0xffff0000u); __builtin_nontemporal_store(x1 + v[j] * rstd * a, outr + 64 * j); }
    }
}
constexpr int G1_AG = 0, G1_SEG = 4096, G1_QD = 8192, G1_KI = G1_QD + 64 * 272, G1_KDT = G1_KI + 64 * 272, G1_VT = G1_KDT + 128 * 144, G1_AT = G1_VT + 256 * 144, G1_END = G1_AT + 64 * 144;
static_assert(G1_END <= 131072, "G1 LDS");
__device__ __forceinline__ void gla_intra_unit(const Params& P, LAS unsigned char* lds, int unit) {
    const int tid = opaque_tid(), lane = tid & 63, wid = tid >> 6, fr = lane & 15, fq = lane >> 4;
    const int bh = unit >> 7, n = unit & 127, b = bh >> 2, h = bh & 3;
    const size_t t0 = (size_t)b * SEQ + 64 * n;
    const bf16_t* Z = (const bf16_t*)P.out;
    LAS float* ag = (LAS float*)(lds + G1_AG); LAS float* seg = (LAS float*)(lds + G1_SEG);
    LAS bf16_t* qd = (LAS bf16_t*)(lds + G1_QD); LAS bf16_t* ki = (LAS bf16_t*)(lds + G1_KI); LAS bf16_t* kdT = (LAS bf16_t*)(lds + G1_KDT);
    LAS bf16_t* vT = (LAS bf16_t*)(lds + G1_VT); LAS bf16_t* at = (LAS bf16_t*)(lds + G1_AT);
    bf16_t* qdec_g = (bf16_t*)(P.ws + WS_QDEC); float* decay_g = (float*)(P.ws + WS_DECAY); bf16_t* OI = (bf16_t*)(P.ws + WS_OI); bf16_t* DS = (bf16_t*)(P.ws + WS_XN);
    const int d_ = tid & 127, cgp_ = tid >> 7;
    float wg_[16];
#pragma unroll
    for (int r = 0; r < 16; ++r) wg_[r] = P.w_gate_up[r * 512 + 128 * h + d_];
    const float bias_ = P.b_gate[128 * h + d_];
    bf16_t qraw_[16], kraw_[16];
#pragma unroll
    for (int i = 0; i < 16; ++i) { const size_t zr = (t0 + cgp_ * 16 + i) * ZC; qraw_[i] = Z[zr + ZO_QG + 128 * h + d_]; kraw_[i] = Z[zr + ZO_KG + 128 * h + d_]; }
    { const int idx = tid * 2, c = idx >> 4, r = idx & 15; const unsigned w = *(const unsigned*)(Z + (t0 + c) * ZC + ZO_AG + r); ag[c * 16 + r] = __uint_as_float(w << 16); ag[c * 16 + r + 1] = __uint_as_float(w & 0xffff0000u); }
#pragma unroll
    for (int i = 0; i < 4; ++i) { const int id = tid + NTHREADS * i, c = id & 63, vc = id >> 6;
        const u32x4 w = *(const u32x4*)(Z + (t0 + c) * ZC + ZO_VG + 256 * h + 8 * vc);
#pragma unroll
        for (int e = 0; e < 4; ++e) { vT[(8 * vc + 2 * e) * 72 + c] = (bf16_t)(w[e] & 0xffffu); vT[(8 * vc + 2 * e + 1) * 72 + c] = (bf16_t)(w[e] >> 16); } }
    __syncthreads();
    { const int d = d_, cgp = cgp_;
      float (&w)[16] = wg_; const float bias = bias_;
      float bcv[16]; float run = 0.f;
#pragma unroll
      for (int i = 0; i < 16; ++i) { const int c = cgp * 16 + i; float xg = bias;
#pragma unroll
          for (int r4 = 0; r4 < 4; ++r4) { const f32x4 a = *(const LAS f32x4*)(ag + c * 16 + 4 * r4); xg += a[0] * w[4 * r4] + a[1] * w[4 * r4 + 1] + a[2] * w[4 * r4 + 2] + a[3] * w[4 * r4 + 3]; }
          const float ls = fminf(xg, 0.f) - __logf(1.0f + __expf(-fabsf(xg)));
          run += ls * (1.0f / 16.0f); bcv[i] = run; }
      seg[cgp * 128 + d] = run;
      __syncthreads();
      float off = 0.f, tot = 0.f;
#pragma unroll
      for (int g2 = 0; g2 < 4; ++g2) { const float sv = seg[g2 * 128 + d]; tot += sv; if (g2 < cgp) off += sv; }
      float kd_prev = 0.f;
#pragma unroll
      for (int i = 0; i < 16; ++i) { const int c = cgp * 16 + i; const float bc = bcv[i] + off;
          const float q = bf2f(qraw_[i]), k = bf2f(kraw_[i]);
          const bf16_t qv = f2bf(q * 0.08838834764831845f * __expf(bc));
          qd[c * 136 + d] = qv; ki[c * 136 + d] = f2bf(k * __expf(-bc));
          const float kdv = k * __expf(tot - bc);
          if (i & 1) *(LAS unsigned*)(kdT + d * 72 + c - 1) = pk2(kd_prev, kdv); else kd_prev = kdv; }
      if (cgp == 0) decay_g[(size_t)unit * 128 + d] = __expf(tot);
    }
    __syncthreads();
#pragma unroll
    for (int i = 0; i < 2; ++i) { const int id = tid + NTHREADS * i, c = id >> 4, ch = id & 15; *(u32x4*)(qdec_g + ((size_t)unit * 64 + c) * 128 + 8 * ch) = *(const LAS u32x4*)(qd + c * 136 + 8 * ch); }
    { const int cb = wid >> 1;
#pragma unroll
      for (int jj = 0; jj < 2; ++jj) { const int jb = (wid & 1) * 2 + jj; f32x4 acc = {0.f, 0.f, 0.f, 0.f};
          if (jb <= cb) {
#pragma unroll
              for (int ks = 0; ks < 4; ++ks) { const bf16x8 a = *(const LAS bf16x8*)(qd + (16 * cb + fr) * 136 + 32 * ks + 8 * fq), bb = *(const LAS bf16x8*)(ki + (16 * jb + fr) * 136 + 32 * ks + 8 * fq); acc = MFMA16(a, bb, acc); } }
#pragma unroll
          for (int e = 0; e < 4; ++e) { const int c = 16 * cb + 4 * fq + e, j = 16 * jb + fr; at[c * 72 + j] = f2bf(j <= c ? acc[e] : 0.f); } }
    }
    __syncthreads();
#pragma unroll
    for (int vbi = 0; vbi < 2; ++vbi) { const int vb = 2 * wid + vbi;
        bf16x8 vf[2];
#pragma unroll
        for (int ks = 0; ks < 2; ++ks) vf[ks] = *(const LAS bf16x8*)(vT + (16 * vb + fr) * 72 + 32 * ks + 8 * fq);
#pragma unroll
        for (int cb = 0; cb < 4; ++cb) { f32x4 acc = {0.f, 0.f, 0.f, 0.f};
#pragma unroll
            for (int ks = 0; ks < 2; ++ks) acc = MFMA16(vf[ks], *(const LAS bf16x8*)(at + (16 * cb + fr) * 72 + 32 * ks + 8 * fq), acc);
            u32x2 w; w.x = pk2(acc[0], acc[1]); w.y = pk2(acc[2], acc[3]);
            *(u32x2*)(OI + (t0 + 16 * cb + fr) * 1024 + 256 * h + 16 * vb + 4 * fq) = w; }
#pragma unroll
        for (int db = 0; db < 8; ++db) { f32x4 acc = {0.f, 0.f, 0.f, 0.f};
#pragma unroll
            for (int ks = 0; ks < 2; ++ks) acc = MFMA16(*(const LAS bf16x8*)(kdT + (16 * db + fr) * 72 + 32 * ks + 8 * fq), vf[ks], acc);
            u32x2 w; w.x = pk2(acc[0], acc[1]); w.y = pk2(acc[2], acc[3]);
            *(u32x2*)(DS + ((size_t)unit * 256 + 16 * vb + fr) * 128 + 16 * db + 4 * fq) = w; }
    }
    __syncthreads();
}
__device__ __forceinline__ void gla_scan(const Params& P, int G) {
    const bf16_t* DS = (const bf16_t*)(P.ws + WS_XN); bf16_t* ST = (bf16_t*)(P.ws + WS_ST); const float* decay_g = (const float*)(P.ws + WS_DECAY);
    if (threadIdx.x < 256) for (int gid = blockIdx.x * 256 + threadIdx.x; gid < 8 * 8192; gid += G * 256) {
        const int bh = gid >> 13, e4 = gid & 8191, d = (4 * e4) & 127;
        f32x4 st = {0.f, 0.f, 0.f, 0.f};
#pragma unroll 16
        for (int n = 0; n < 128; ++n) { const size_t unit = (size_t)bh * 128 + n;
            const u32x2 w = *(const u32x2*)(DS + unit * 32768 + 4 * e4); const f32x4 dd = *(const f32x4*)(decay_g + unit * 128 + d);
            u32x2 o; o.x = pk2(st[0], st[1]); o.y = pk2(st[2], st[3]); *(u32x2*)(ST + unit * 32768 + 4 * e4) = o;
            f32x4 in; in[0] = __uint_as_float(w.x << 16); in[1] = __uint_as_float(w.x & 0xffff0000u); in[2] = __uint_as_float(w.y << 16); in[3] = __uint_as_float(w.y & 0xffff0000u);
            st = dd * st + in; }
    }
}
__device__ __forceinline__ void gla_inter_unit(const Params& P, LAS unsigned char* lds, int unit) {
    const int tid = opaque_tid(), lane = tid & 63, wid = tid >> 6, fr = lane & 15, fq = lane >> 4;
    const int bh = unit >> 7, n = unit & 127, b = bh >> 2, h = bh & 3;
    const size_t t0 = (size_t)b * SEQ + 64 * n;
    const bf16_t* Z = (const bf16_t*)P.out; const bf16_t* qdec_g = (const bf16_t*)(P.ws + WS_QDEC); const bf16_t* OI = (const bf16_t*)(P.ws + WS_OI); const bf16_t* ST = (const bf16_t*)(P.ws + WS_ST);
    bf16_t* AO = (bf16_t*)(P.ws + WS_XN);
    LAS float* red = (LAS float*)lds;
    const int cb = wid & 3, vh = wid >> 2; const size_t trow = t0 + 16 * cb + fr;
    bf16x8 qf[4];
#pragma unroll
    for (int ks = 0; ks < 4; ++ks) qf[ks] = *(const bf16x8*)(qdec_g + ((size_t)unit * 64 + 16 * cb + fr) * 128 + 32 * ks + 8 * fq);
    f32x4 o[8]; float ss = 0.f;
    bf16x8 sf[8][4]; u32x2 oiw[8];
#pragma unroll
    for (int vbi = 0; vbi < 8; ++vbi) { const int vb = vh * 8 + vbi;
#pragma unroll
        for (int ks = 0; ks < 4; ++ks) sf[vbi][ks] = *(const bf16x8*)(ST + ((size_t)unit * 256 + 16 * vb + fr) * 128 + 32 * ks + 8 * fq);
        oiw[vbi] = *(const u32x2*)(OI + trow * 1024 + 256 * h + 16 * vb + 4 * fq); }
#pragma unroll
    for (int vbi = 0; vbi < 8; ++vbi) { f32x4 acc = {0.f, 0.f, 0.f, 0.f};
#pragma unroll
        for (int ks = 0; ks < 4; ++ks) acc = MFMA16(sf[vbi][ks], qf[ks], acc);
        const u32x2 w = oiw[vbi];
        acc[0] += __uint_as_float(w.x << 16); acc[1] += __uint_as_float(w.x & 0xffff0000u); acc[2] += __uint_as_float(w.y << 16); acc[3] += __uint_as_float(w.y & 0xffff0000u);
        o[vbi] = acc; ss += (acc[0] * acc[0] + acc[1] * acc[1]) + (acc[2] * acc[2] + acc[3] * acc[3]); }
    ss += __shfl_xor(ss, 16); ss += __shfl_xor(ss, 32);
    if (fq == 0) red[wid * 16 + fr] = ss;
    __syncthreads();
    const float tot = red[cb * 16 + fr] + red[(cb + 4) * 16 + fr];
    const float rstd = rsqrtf(tot * (1.0f / 256.0f) + RMS_EPS);
#pragma unroll
    for (int vbi = 0; vbi < 8; ++vbi) { const int vcol = 16 * (vh * 8 + vbi) + 4 * fq;
        const f32x4 g = *(const f32x4*)(P.g_gla + vcol); const u32x2 rw = *(const u32x2*)(Z + trow * ZC + ZO_RG + 256 * h + vcol);
        const float r0 = __uint_as_float(rw.x << 16), r1 = __uint_as_float(rw.x & 0xffff0000u), r2 = __uint_as_float(rw.y << 16), r3 = __uint_as_float(rw.y & 0xffff0000u);
        u32x2 w; w.x = pk2(o[vbi][0] * rstd * g[0] * silu_f(r0), o[vbi][1] * rstd * g[1] * silu_f(r1)); w.y = pk2(o[vbi][2] * rstd * g[2] * silu_f(r2), o[vbi][3] * rstd * g[3] * silu_f(r3));
        *(u32x2*)(AO + trow * DM + 1024 + 256 * h + vcol) = w; }
    __syncthreads();
}

constexpr int AT_KB = 64 * 512, AT_VB = 128 * 144, AT_BUF = AT_KB + AT_VB;
constexpr float AT_THR = 8.0f;
__device__ __forceinline__ float xmax16(float m) { const auto r = __builtin_amdgcn_permlane16_swap(__float_as_uint(m), __float_as_uint(m), false, false); return fmaxf(__uint_as_float(r[0]), __uint_as_float(r[1])); }
__device__ __forceinline__ float xmax32(float m) { const auto r = __builtin_amdgcn_permlane32_swap(__float_as_uint(m), __float_as_uint(m), false, false); return fmaxf(__uint_as_float(r[0]), __uint_as_float(r[1])); }
#ifndef AT_SGB
#define AT_SGB 1
#endif
#ifndef AT_QK_AHEAD
#define AT_QK_AHEAD 4
#endif
#ifndef AT_PV_AHEAD
#define AT_PV_AHEAD 4
#endif
#ifndef AT_SCHED
#define AT_SCHED
#endif
__device__ __forceinline__ void attn_unit(const Params& P, LAS unsigned char* lds, int bh, int qb) {
    const int tid = opaque_tid(), lane = tid & 63, wid = __builtin_amdgcn_readfirstlane(tid >> 6), fr = lane & 15, fq = lane >> 4;
    const int b = bh >> 3, h = bh & 7; const size_t rowb = (size_t)b * SEQ; const int q0 = qb * 256 + wid * 32;
    const bf16_t* Q = (const bf16_t*)(P.ws + WS_Q); const bf16_t* KN = (const bf16_t*)(P.ws + WS_KN); const bf16_t* KR = (const bf16_t*)(P.ws + WS_KROPE); const bf16_t* VT = (const bf16_t*)(P.ws + WS_VT);
    bf16_t* AO = (bf16_t*)(P.ws + WS_XN);
    bf16x8 qf[6][2];
#pragma unroll
    for (int qk = 0; qk < 2; ++qk) { const bf16_t* qp = Q + (rowb + q0 + 16 * qk + fr) * QC;
#pragma unroll
        for (int ks = 0; ks < 4; ++ks) qf[ks][qk] = *(const bf16x8*)(qp + 128 * h + 32 * ks + 8 * fq);
        qf[4][qk] = *(const bf16x8*)(qp + 1024 + (h >> 2) * 256 + (h & 3) * 32 + 8 * fq); qf[5][qk] = *(const bf16x8*)(qp + 1024 + (h >> 2) * 256 + 128 + (h & 3) * 32 + 8 * fq); }
    const int NT = (qb + 1) * 4;
    const bf16_t* KNh = KN + rowb * 1024 + 128 * h; const bf16_t* KRb = KR + rowb * 64; const bf16_t* VTh = VT + (size_t)(128 * h) * M + rowb;
    const unsigned char* dsrc[7]; unsigned dstr[7];
#pragma unroll
    for (int j_ = 0; j_ < 7; ++j_) { const int c_ = wid + 8 * j_; const int L_ = 1024 * c_ + 16 * lane; const bf16_t* src_ = KNh; unsigned st_ = 0;
        if (L_ < AT_KB) { const int row_ = L_ >> 9, pp_ = (L_ & 511) >> 4; int pc_ = (pp_ & 16) | ((pp_ & 15) ^ (row_ & 15)); if (pc_ >= 24) pc_ = 0;
            if (pc_ < 16) { src_ = KNh + (size_t)row_ * 1024 + 8 * pc_; st_ = 64u * 1024u * 2u; } else { src_ = KRb + (size_t)row_ * 64 + 8 * (pc_ - 16); st_ = 64u * 64u * 2u; } }
        else if (c_ < 50) { const int L2_ = L_ - AT_KB, dv_ = L2_ / 144, cb_ = L2_ - dv_ * 144; int pc_ = cb_ >> 4; if (pc_ >= 8) pc_ = 0; src_ = VTh + (size_t)dv_ * M + 8 * pc_; st_ = 128u; }
        dsrc[j_] = (const unsigned char*)src_; dstr[j_] = st_; }
#define AT_DMA(t, buf) do { _Pragma("unroll") for (int j_ = 0; j_ < 7; ++j_) { const int c_ = wid + 8 * j_; if (c_ < 50) { \
            __builtin_amdgcn_global_load_lds((const unsigned*)dsrc[j_], (LAS unsigned*)(lds + (buf) * AT_BUF + 1024 * c_), 16, 0, 0); dsrc[j_] += dstr[j_]; } } } while (0)
    int kxo[4];
#pragma unroll
    for (int j = 0; j < 4; ++j) kxo[j] = fr * 512 + (((4 * j + fq) ^ fr) << 4);
    float mrow[2] = {0.f, 0.f}; f32x4 lacc[2] = {(f32x4){0.f, 0.f, 0.f, 0.f}, (f32x4){0.f, 0.f, 0.f, 0.f}};
    const bf16x8 ones = {16256, 16256, 16256, 16256, 16256, 16256, 16256, 16256};
    f32x4 o[8][2];
#pragma unroll
    for (int dvb = 0; dvb < 8; ++dvb) { o[dvb][0] = (f32x4){0.f, 0.f, 0.f, 0.f}; o[dvb][1] = (f32x4){0.f, 0.f, 0.f, 0.f}; }
    AT_DMA(0, 0);
    asm volatile("s_waitcnt vmcnt(0)" ::: "memory"); __syncthreads();
#pragma clang loop unroll(disable)
    for (int t = 0; t < NT; ++t) {
        const int buf = t & 1; const bool more = (t + 1 < NT);
        if (more) AT_DMA(t + 1, buf ^ 1);
        const LAS unsigned char* Kl = lds + buf * AT_BUF; const LAS unsigned char* Vl = Kl + AT_KB;
        const int k0 = 64 * t;
        if (k0 <= q0) {
#define AT_SB __builtin_amdgcn_sched_barrier(0)
#define AT_KLD(dst, ks_) do { _Pragma("unroll") for (int kvb = 0; kvb < 4; ++kvb) dst[kvb] = *(const LAS bf16x8*)(Kl + kxo[(ks_) & 3] + ((ks_) >> 2) * 256 + kvb * (16 * 512)); } while (0)
#define AT_VLD(dst, g_) do { _Pragma("unroll") for (int i_ = 0; i_ < 4; ++i_) { const LAS unsigned char* vp = Vl + (16 * (4 * ((g_) & 1) + i_) + fr) * 144 + (32 * ((g_) >> 1) + 4 * fq) * 2; \
            const u32x2 lo = *(const LAS u32x2*)vp, hi = *(const LAS u32x2*)(vp + 32); u32x4 w; w.x = lo.x; w.y = lo.y; w.z = hi.x; w.w = hi.y; dst[i_] = __builtin_bit_cast(bf16x8, w); } } while (0)
            bf16x8 kc[4], kn[4];
            AT_KLD(kc, 0);
            f32x4 s[4][2];
#pragma unroll
            for (int kvb = 0; kvb < 4; ++kvb) { s[kvb][0] = (f32x4){-mrow[0], -mrow[0], -mrow[0], -mrow[0]}; s[kvb][1] = (f32x4){-mrow[1], -mrow[1], -mrow[1], -mrow[1]}; }
#pragma unroll
            for (int ks = 0; ks < 6; ++ks) {
                if (ks < 5) AT_KLD(kn, ks + 1);
                AT_SB;
#pragma unroll
                for (int kvb = 0; kvb < 4; ++kvb) { s[kvb][0] = MFMA16(kc[kvb], qf[ks][0], s[kvb][0]); s[kvb][1] = MFMA16(kc[kvb], qf[ks][1], s[kvb][1]); }
                AT_SB;
                if (ks < 5) {
#pragma unroll
                    for (int kvb = 0; kvb < 4; ++kvb) kc[kvb] = kn[kvb]; }
            }
            bf16x8 vc[4], vn[4];
            AT_VLD(vc, 0);
            AT_SB;
            if (k0 + 63 > q0) {
#pragma unroll
                for (int kvb = 0; kvb < 4; ++kvb)
#pragma unroll
                    for (int qk = 0; qk < 2; ++qk)
#pragma unroll
                        for (int e = 0; e < 4; ++e) { const int kv = k0 + 16 * kvb + 4 * fq + e, q = q0 + 16 * qk + fr; if (kv > q) s[kvb][qk][e] = -INFINITY; }
            }
            float mx[2];
#pragma unroll
            for (int qk = 0; qk < 2; ++qk) { float m_ = fmaxf(fmaxf(s[0][qk][0], s[0][qk][1]), fmaxf(s[0][qk][2], s[0][qk][3]));
#pragma unroll
                for (int kvb = 1; kvb < 4; ++kvb) m_ = fmaxf(m_, fmaxf(fmaxf(s[kvb][qk][0], s[kvb][qk][1]), fmaxf(s[kvb][qk][2], s[kvb][qk][3])));
                m_ = xmax16(m_); m_ = xmax32(m_); mx[qk] = m_; }
            if (t == 0 || __any((mx[0] > AT_THR) || (mx[1] > AT_THR))) {
#pragma unroll
                for (int qk = 0; qk < 2; ++qk) { const float dl = (t == 0) ? mx[qk] : fmaxf(mx[qk], 0.f), alpha = __builtin_amdgcn_exp2f(-dl); mrow[qk] += dl; lacc[qk] *= alpha;
#pragma unroll
                    for (int kvb = 0; kvb < 4; ++kvb) s[kvb][qk] -= dl;
#pragma unroll
                    for (int dvb = 0; dvb < 8; ++dvb) o[dvb][qk] *= alpha; }
            }
            bf16x8 pf[2][2];
#pragma unroll
            for (int qk = 0; qk < 2; ++qk) {
#pragma unroll
                for (int kvb = 0; kvb < 4; ++kvb)
#pragma unroll
                    for (int e = 0; e < 4; ++e) s[kvb][qk][e] = __builtin_amdgcn_exp2f(s[kvb][qk][e]);
#pragma unroll
                for (int s2 = 0; s2 < 2; ++s2) { u32x4 w; w.x = pk2(s[2 * s2][qk][0], s[2 * s2][qk][1]); w.y = pk2(s[2 * s2][qk][2], s[2 * s2][qk][3]);
                    w.z = pk2(s[2 * s2 + 1][qk][0], s[2 * s2 + 1][qk][1]); w.w = pk2(s[2 * s2 + 1][qk][2], s[2 * s2 + 1][qk][3]); pf[s2][qk] = __builtin_bit_cast(bf16x8, w); } }
            AT_SB;
#pragma unroll
            for (int g = 0; g < 4; ++g) {
                if (g < 3) AT_VLD(vn, g + 1);
                AT_SB;
                if ((g & 1) == 0) { lacc[0] = MFMA16(ones, pf[g >> 1][0], lacc[0]); lacc[1] = MFMA16(ones, pf[g >> 1][1], lacc[1]); }
#pragma unroll
                for (int i = 0; i < 4; ++i) { const int dvb = 4 * (g & 1) + i; o[dvb][0] = MFMA16(vc[i], pf[g >> 1][0], o[dvb][0]); o[dvb][1] = MFMA16(vc[i], pf[g >> 1][1], o[dvb][1]); }
                AT_SB;
                if (g < 3) {
#pragma unroll
                    for (int i = 0; i < 4; ++i) vc[i] = vn[i]; }
            }
#undef AT_SB
#undef AT_KLD
#undef AT_VLD
        }
        asm volatile("s_waitcnt vmcnt(0)" ::: "memory"); __syncthreads();
    }
#pragma unroll
    for (int qk = 0; qk < 2; ++qk) { const float rl = 1.0f / lacc[qk][0];
        bf16_t* op = AO + (rowb + q0 + 16 * qk + fr) * DM + 128 * h + 4 * fq;
#pragma unroll
        for (int dvb = 0; dvb < 8; ++dvb) { u32x2 w; w.x = pk2(o[dvb][qk][0] * rl, o[dvb][qk][1] * rl); w.y = pk2(o[dvb][qk][2] * rl, o[dvb][qk][3] * rl); *(u32x2*)(op + 16 * dvb) = w; } }
#undef AT_DMA
}

#define GAS __attribute__((address_space(1)))
typedef GAS unsigned gu32;
typedef GAS unsigned long long gu64;
#define RLX_AGENT __ATOMIC_RELAXED, __HIP_MEMORY_SCOPE_AGENT
#define LDS_WAIT() asm volatile("s_waitcnt lgkmcnt(0)" ::: "memory")
#define VM_WAIT() asm volatile("s_waitcnt vmcnt(0)" ::: "memory")
__device__ __forceinline__ unsigned long long rt() { return __builtin_amdgcn_s_memrealtime(); }

#define XB_TMO      128
#define XB_XCNT(j)  (256  + 64 * (j))
#define XB_XSUB(j)  (1280 + 64 * (j))
#define XB_XGEN(j)  (2304 + 64 * (j))
#define XB_TOP      3328
#define XB_TOPGEN   3392
#define XCD_BAR_WORDS 3456
#define XB_SPIN_CAP (1u << 18)

__device__ __forceinline__ unsigned xb_ld(unsigned* p)              { return __hip_atomic_load(p, __ATOMIC_RELAXED, __HIP_MEMORY_SCOPE_AGENT); }
__device__ __forceinline__ unsigned xb_add(unsigned* p, unsigned v) { return __hip_atomic_fetch_add(p, v, __ATOMIC_RELAXED, __HIP_MEMORY_SCOPE_AGENT); }
__device__ __forceinline__ unsigned xb_xcc_id() { return (unsigned)__builtin_amdgcn_s_getreg((3 << 11) | 20) & 0xFu; }
#define XB_SPIN(cond, bar) do { unsigned _sp = 0; while (cond) { __builtin_amdgcn_s_sleep(1); \
    if ((++_sp & 255u) == 0u) { if (xb_ld(&(bar)[XB_TMO])) break; if (_sp > XB_SPIN_CAP) { atomicAdd(&(bar)[XB_TMO], 1u); break; } } } } while (0)

struct XcdBarrier {
    unsigned* bar; unsigned x;
    volatile LAS unsigned* st;
};

__device__ __forceinline__ XcdBarrier xcd_barrier_post(unsigned* bar, volatile LAS unsigned* st) {
    XcdBarrier b; b.bar = bar; b.x = xb_xcc_id(); b.st = st;
    if (threadIdx.x == 0) (void)xb_add(&bar[XB_XCNT(b.x)], 1u);
    return b;
}
__device__ __forceinline__ void xcd_barrier_complete(unsigned* bar, unsigned x, unsigned& nloc, unsigned& nx) {
    const unsigned G = gridDim.x * gridDim.y * gridDim.z;
    unsigned sum, cnt, mine, sp = 0u;
    for (;;) {
        sum = 0u; cnt = 0u; mine = 0u;
#pragma unroll
        for (unsigned j = 0; j < 16; ++j) { const unsigned c = xb_ld(&bar[XB_XCNT(j)]); sum += c; cnt += (c > 0u) ? 1u : 0u; mine = (j == x) ? c : mine; }
        if (sum == G) break;
        __builtin_amdgcn_s_sleep(1);
        if ((++sp & 255u) == 0u) { if (xb_ld(&bar[XB_TMO])) break; if (sp > XB_SPIN_CAP) { atomicAdd(&bar[XB_TMO], 1u); break; } }
    }
    nloc = mine > 0u ? mine : 1u; nx = cnt > 0u ? cnt : 1u;
}

__device__ __forceinline__ void xcd_barrier(const XcdBarrier& b) {
    asm volatile("s_waitcnt vmcnt(0)" ::: "memory");
    __syncthreads();
    if (threadIdx.x == 0) {
        unsigned* bar = b.bar;
        __builtin_amdgcn_s_waitcnt(0);
        unsigned nloc = b.st[0], nx = b.st[1];
        if (nloc == 0u) { xcd_barrier_complete(bar, b.x, nloc, nx); b.st[0] = nloc; b.st[1] = nx; }
        const unsigned old = xb_add(&bar[XB_XSUB(b.x)], 1u);
        const unsigned gen = old / nloc;
        if (old + 1u == (gen + 1u) * nloc) {
            __builtin_amdgcn_fence(__ATOMIC_RELEASE, "agent");
            asm volatile("s_waitcnt vmcnt(0)" ::: "memory");
            const unsigned og = xb_add(&bar[XB_TOP], 1u);
            const unsigned tg = og / nx;
            if (og + 1u == (tg + 1u) * nx) xb_add(&bar[XB_TOPGEN], 1u);
            else XB_SPIN(xb_ld(&bar[XB_TOPGEN]) == tg, bar);
            __builtin_amdgcn_fence(__ATOMIC_ACQUIRE, "agent");
            xb_add(&bar[XB_XGEN(b.x)], 1u);
            asm volatile("s_waitcnt vmcnt(0)" ::: "memory");
        } else {
            XB_SPIN(xb_ld(&bar[XB_XGEN(b.x)]) == gen, bar);
            __builtin_amdgcn_fence(__ATOMIC_ACQUIRE, "agent");
            asm volatile("s_waitcnt vmcnt(0)" ::: "memory");
        }
    }
    __syncthreads();
}


#ifndef PHASES
#define PHASES 0xFFFF
#endif
#define PH(k) ((PHASES >> (k)) & 1)
#ifndef REP_ATT
#define REP_ATT 1
#endif
#ifndef REP_P0
#define REP_P0 1
#endif
#ifndef REP_GLA
#define REP_GLA 1
#endif
#ifndef REP_A
#define REP_A 1
#endif
#ifndef REP_B
#define REP_B 1
#endif
#ifndef REP_C
#define REP_C 1
#endif
#ifndef REP_D
#define REP_D 1
#endif
#ifndef P2_SP2
#define P2_SP2 true
#endif
#ifndef P2_ALIGN
#define P2_ALIGN true
#endif
#ifndef P69_ALIGN
#define P69_ALIGN true
#endif
#ifndef P3_ALIGN
#define P3_ALIGN false
#endif
#ifndef P3_SP2
#define P3_SP2 true
#endif
#ifndef REP_P8
#define REP_P8 1
#endif
#ifndef REP_ROWS
#define REP_ROWS 1
#endif
#ifndef REP_SYNC
#define REP_SYNC 1
#endif
__global__ void __launch_bounds__(NTHREADS, 2) hybrid_block_fwd(Params P) {
    extern __shared__ __attribute__((aligned(16))) unsigned char lds_raw[];
    LAS unsigned char* lds = (LAS unsigned char*)lds_raw;
    cg::grid_group grid = cg::this_grid();
    volatile LAS unsigned* MISC = (volatile LAS unsigned*)(lds + MISC_OFF);
    if (threadIdx.x < 32) MISC[threadIdx.x] = 0u;
    __syncthreads();
    XcdBarrier bar = xcd_barrier_post((unsigned*)(P.ws + WS_CTL), MISC + 8);
#define GSYNC() xcd_barrier(bar)
    const int G = gridDim.x, bx = blockIdx.x;
    unsigned char* ws = P.ws;
    bf16_t* Zb = (bf16_t*)P.out;
    if (PH(0)) for (int rep = 0; rep < REP_P0; ++rep) p0_prologue(P, lds, G);
    if (P.out == nullptr) grid.sync();
    GSYNC();
    if (PH(1)) p1_rows(P, lds, G);
#if defined(DUP_A)
    __syncthreads(); p1_rows(P, lds, G);
#endif
    for (int rep = 0; rep < REP_SYNC; ++rep) GSYNC();
    if (PH(2)) { pg8::Gemm g{(const bf16_t*)(ws + WS_XN), (const bf16_t*)(ws + WS_WIN), M, ZC, DM, DM, DM}; pg8::StaticOrder S; S.init(M, ZC, G, bx);
      pg8::EpiPlain E{Zb, ZC}; pg8::gemm_phase<pg8::EpiPlain, pg8::StaticOrder, P2_ALIGN, P2_SP2>(lds, g, S, E); }
#if defined(DUP_P2)
    if (PH(2)) { pg8::Gemm g{(const bf16_t*)(ws + WS_XN), (const bf16_t*)(ws + WS_WIN), M, ZC, DM, DM, DM}; pg8::StaticOrder S; S.init(M, ZC, G, bx);
      pg8::EpiPlain E{Zb, ZC}; pg8::gemm_phase<pg8::EpiPlain, pg8::StaticOrder, P2_ALIGN, P2_SP2>(lds, g, S, E); }
#endif
    GSYNC();
    if (PH(3)) p2b_rows(P, G);
#if defined(DUP_A)
    p2b_rows(P, G);
#endif
    GSYNC();
    if (PH(4)) { pg8::Gemm g{(const bf16_t*)(ws + WS_CQN), (const bf16_t*)(ws + WS_WUQ), M, QC, 512, 512, 512}; pg8::StaticOrder S; S.init(M, QC, G, bx);
      pg8::EpiRowScaleRope E{(bf16_t*)(ws + WS_Q), QC, QSCALE, 4, (const float*)(ws + WS_CS)};
      pg8::gemm_phase<pg8::EpiRowScaleRope, pg8::StaticOrder, P3_ALIGN, P3_SP2>(lds, g, S, E); }
    if (PH(5)) { pg8::Gemm g{(const bf16_t*)(ws + WS_CKVN), (const bf16_t*)(ws + WS_WUK), M, 1024, 256, 256, 256}; pg8::StaticOrder S; S.init(M, 1024, G, bx);
      pg8::EpiPlain E{(bf16_t*)(ws + WS_KN), 1024}; pg8::gemm_phase<pg8::EpiPlain, pg8::StaticOrder, P3_ALIGN, P3_SP2>(lds, g, S, E); }
    if (PH(6)) { pg8::Gemm g{(const bf16_t*)(ws + WS_WUV), (const bf16_t*)(ws + WS_CKVN), 1024, M, 256, 256, 256}; pg8::StaticOrder S; S.init(1024, M, G, bx);
      pg8::EpiPlain E{(bf16_t*)(ws + WS_VT), M}; pg8::gemm_phase<pg8::EpiPlain, pg8::StaticOrder, P3_ALIGN, P3_SP2>(lds, g, S, E); }
#if defined(DUP_P3)
    if (PH(4)) { pg8::Gemm g{(const bf16_t*)(ws + WS_CQN), (const bf16_t*)(ws + WS_WUQ), M, QC, 512, 512, 512}; pg8::StaticOrder S; S.init(M, QC, G, bx);
      pg8::EpiRowScaleRope E{(bf16_t*)(ws + WS_Q), QC, QSCALE, 4, (const float*)(ws + WS_CS)};
      pg8::gemm_phase<pg8::EpiRowScaleRope, pg8::StaticOrder, true, true>(lds, g, S, E); }
    if (PH(5)) { pg8::Gemm g{(const bf16_t*)(ws + WS_CKVN), (const bf16_t*)(ws + WS_WUK), M, 1024, 256, 256, 256}; pg8::StaticOrder S; S.init(M, 1024, G, bx);
      pg8::EpiPlain E{(bf16_t*)(ws + WS_KN), 1024}; pg8::gemm_phase<pg8::EpiPlain, pg8::StaticOrder, true, true>(lds, g, S, E); }
    if (PH(6)) { pg8::Gemm g{(const bf16_t*)(ws + WS_WUV), (const bf16_t*)(ws + WS_CKVN), 1024, M, 256, 256, 256}; pg8::StaticOrder S; S.init(1024, M, G, bx);
      pg8::EpiPlain E{(bf16_t*)(ws + WS_VT), M}; pg8::gemm_phase<pg8::EpiPlain, pg8::StaticOrder, true, true>(lds, g, S, E); }
#endif
    if (PH(7)) for (int rep = 0; rep < REP_GLA; ++rep) for (int u = bx; u < 1024; u += G) gla_intra_unit(P, lds, u);
    GSYNC();
    if (PH(8)) for (int rep = 0; rep < REP_B; ++rep) gla_scan(P, G);
    GSYNC();
    if (PH(9)) for (int u = bx; u < 1024; u += G) gla_inter_unit(P, lds, u);
#if defined(DUP_C)
    for (int u = bx; u < 1024; u += G) gla_inter_unit(P, lds, u);
#endif
    if (PH(10)) { const int vcu = (G % 8 == 0) ? (bx % 8) * (G / 8) + bx / 8 : bx;
      for (int rep = 0; rep < REP_ATT; ++rep) for (int p2 = 2 * vcu; p2 < 512; p2 += 2 * G) {
#pragma clang loop unroll(disable)
          for (int i2 = 0; i2 < 2; ++i2) { const int p = p2 >> 1, bh = p >> 4, s = p & 15; attn_unit(P, lds, bh, i2 ? s : 31 - s); } } }
    GSYNC();
    if (PH(11)) { pg8::Gemm g{(const bf16_t*)(ws + WS_XN), (const bf16_t*)(ws + WS_WOUT), M, DM, DM, DM, DM}; pg8::StaticOrder S; S.init(M, DM, G, bx);
      pg8::EpiPlain E{(bf16_t*)(ws + WS_O), DM}; pg8::gemm_phase<pg8::EpiPlain, pg8::StaticOrder, P69_ALIGN, true>(lds, g, S, E); }
#if defined(DUP_P6)
    if (PH(11)) { pg8::Gemm g{(const bf16_t*)(ws + WS_XN), (const bf16_t*)(ws + WS_WOUT), M, DM, DM, DM, DM}; pg8::StaticOrder S; S.init(M, DM, G, bx);
      pg8::EpiPlain E{(bf16_t*)(ws + WS_O), DM}; pg8::gemm_phase<pg8::EpiPlain, pg8::StaticOrder, P69_ALIGN, true>(lds, g, S, E); }
#endif
    GSYNC();
    if (PH(12)) for (int rep = 0; rep < REP_D; ++rep) { p7_rows(P, lds, G); __syncthreads(); }
    GSYNC();
    if (PH(13)) { pg8::Gemm g{(const bf16_t*)(ws + WS_XN), (const bf16_t*)(ws + WS_WGU), M, 2 * DFF, DM, DM, DM}; pg8::StaticOrder S; S.init(M, 2 * DFF, G, bx);
      pg8::EpiSwiGLU E{(bf16_t*)(ws + WS_ACT), DFF}; pg8::gemm_phase<pg8::EpiSwiGLU, pg8::StaticOrder, true, true>(lds, g, S, E); }
#if defined(DUP_P8)
    if (PH(13)) { pg8::Gemm g{(const bf16_t*)(ws + WS_XN), (const bf16_t*)(ws + WS_WGU), M, 2 * DFF, DM, DM, DM}; pg8::StaticOrder S; S.init(M, 2 * DFF, G, bx);
      pg8::EpiSwiGLU E{(bf16_t*)(ws + WS_ACT), DFF}; pg8::gemm_phase<pg8::EpiSwiGLU, pg8::StaticOrder, true, true>(lds, g, S, E); }
#endif
    GSYNC();
    if (PH(14)) { pg8::Gemm g{(const bf16_t*)(ws + WS_ACT), (const bf16_t*)(ws + WS_WD), M, DM, DFF, DFF, DFF}; pg8::StaticOrder S; S.init(M, DM, G, bx);
      pg8::EpiPlain E{(bf16_t*)(ws + WS_O), DM}; pg8::gemm_phase<pg8::EpiPlain, pg8::StaticOrder, P69_ALIGN, true>(lds, g, S, E); }
#if defined(DUP_P9)
    if (PH(14)) { pg8::Gemm g{(const bf16_t*)(ws + WS_ACT), (const bf16_t*)(ws + WS_WD), M, DM, DFF, DFF, DFF}; pg8::StaticOrder S; S.init(M, DM, G, bx);
      pg8::EpiPlain E{(bf16_t*)(ws + WS_O), DM}; pg8::gemm_phase<pg8::EpiPlain, pg8::StaticOrder, P69_ALIGN, true>(lds, g, S, E); }
#endif
    GSYNC();
    if (PH(15)) for (int rep = 0; rep < REP_D; ++rep) { p10_rows(P, lds, G); __syncthreads(); }
}

extern "C" void kernel_launch(void* const* d_in, const int* in_sizes, int n_in, void* d_out, int out_size, void* d_ws, size_t ws_size, hipStream_t stream) {
    static int grid = 0;
    if (grid == 0) {
        if (n_in != 22 || in_sizes[0] != M * DM || out_size != M * DM || ws_size < WS_END) { fprintf(stderr, "kernel_launch: unexpected shapes (n_in %d, in0 %d, out %d, ws %zu)\n", n_in, n_in > 0 ? in_sizes[0] : -1, out_size, ws_size); grid = -1; return; }
        int dev = 0, cus = 0, per_cu = 0;
        (void)hipGetDevice(&dev); (void)hipDeviceGetAttribute(&cus, hipDeviceAttributeMultiprocessorCount, dev);
        if (hipFuncSetAttribute((const void*)hybrid_block_fwd, hipFuncAttributeMaxDynamicSharedMemorySize, LDS_BYTES) != hipSuccess) { fprintf(stderr, "kernel_launch: hipFuncSetAttribute failed\n"); grid = -1; return; }
        if (hipOccupancyMaxActiveBlocksPerMultiprocessor(&per_cu, (const void*)hybrid_block_fwd, NTHREADS, LDS_BYTES) != hipSuccess || per_cu < 1) { fprintf(stderr, "kernel_launch: occupancy query failed (%d)\n", per_cu); (void)hipGetLastError(); grid = -1; return; }
        grid = cus;
    }
    if (grid < 0) return;
    Params p{};
    const float* const* fin = (const float* const*)d_in;
    p.x = fin[0]; p.c = fin[1]; p.pos = (const int*)d_in[2]; p.w_ada = fin[3]; p.b_ada = fin[4]; p.g_pre_mix = fin[5]; p.g_post_mix = fin[6]; p.w_in = fin[7]; p.g_q = fin[8]; p.w_uq = fin[9];
    p.g_kv = fin[10]; p.w_uk = fin[11]; p.w_uv = fin[12]; p.w_gate_up = fin[13]; p.b_gate = fin[14]; p.g_gla = fin[15]; p.w_out = fin[16]; p.g_pre_ffn = fin[17]; p.g_post_ffn = fin[18];
    p.w_fg = fin[19]; p.w_fu = fin[20]; p.w_fd = fin[21]; p.out = (float*)d_out; p.ws = (unsigned char*)d_ws;
    if (hipMemsetAsync((char*)d_ws + WS_CTL, 0, CTL_BYTES, stream) != hipSuccess) { fprintf(stderr, "kernel_launch: memset failed\n"); return; }
    void* args[] = {&p};
    hipError_t e = hipLaunchCooperativeKernel((const void*)hybrid_block_fwd, dim3(grid), dim3(NTHREADS), args, LDS_BYTES, stream);
    if (e != hipSuccess) fprintf(stderr, "cooperative launch failed: %s (grid %d)\n", hipGetErrorString(e), grid);
}
```

```cpp
#define P3_SP2 false
#include <hip/hip_runtime.h>
#include <hip/hip_cooperative_groups.h>
#include <cstdio>
#include <cstdint>
#include <cmath>
namespace cg = cooperative_groups;
namespace pg8 {
#define PG8_LAS __attribute__((address_space(3)))
typedef unsigned short bf16_t;
typedef short bf16x8 __attribute__((ext_vector_type(8)));
typedef float f32x4 __attribute__((ext_vector_type(4)));
typedef unsigned u32x4 __attribute__((ext_vector_type(4)));
constexpr int BM = 256, BK = 64, HALF = 128, HTB = HALF * BK * 2  , STAGE_BYTES = 8 * HTB, NXCD = 8, WGM = 8;

__host__ __device__ __forceinline__ int lds_byte(int r, int c) { const int st = (r >> 4) * 2 + (c >> 5), rr = r & 15, cc = c & 31, ob = rr * 64 + cc * 2; return st * 1024 + (ob ^ (((ob >> 9) & 1) << 5)); }
__host__ __device__ __forceinline__ void stage_rc(int b, int& R, int& C) { const int st = b / 1024, sb = b % 1024, swz = sb ^ (((sb >> 9) & 1) << 5); R = (st >> 1) * 16 + swz / 64; C = (st & 1) * 32 + (swz % 64) / 2; }
__host__ __device__ __forceinline__ int perm32(int rho) { const int n = rho >> 4, i = rho & 15; return 8 * (i >> 2) + 4 * n + (i & 3); }

struct Unit { int pm, pn; };
struct Gemm { const bf16_t* A; const bf16_t* Bt; int M, N, K, lda, ldb; };

struct StaticOrder {
    int nM, nN, nwg, G, c;
    __host__ __device__ void init(int M, int N, int G_, int c_) { nM = M / BM; nN = N / BM; nwg = nM * nN; G = G_; c = c_; }
    __host__ __device__ bool next(int i, Unit& u) const {
        const long L = (long)i * G + c; if (L >= nwg) return false;
        int wgid = (int)L; { const int q = nwg / NXCD, r = nwg % NXCD, xcd = wgid % NXCD, off = wgid / NXCD; wgid = (xcd < r ? xcd * (q + 1) : r * (q + 1) + (xcd - r) * q) + off; }
        const int nig = WGM * nN, gid = wgid / nig, fm = gid * WGM, gsz = (nM - fm) < WGM ? (nM - fm) : WGM;
        u.pm = fm + ((wgid % nig) % gsz); u.pn = (wgid % nig) / gsz; return true;
    }
    __device__ __forceinline__ void a_ready(const Unit&) const {}
    __device__ __forceinline__ void done(const Unit&) const {}
};

__device__ __forceinline__ unsigned cvt_pk_bf16(float lo, float hi) { unsigned r; asm volatile("v_cvt_pk_bf16_f32 %0, %1, %2" : "=v"(r) : "v"(lo), "v"(hi)); return r; }
typedef float f32x2 __attribute__((ext_vector_type(2)));
template <class Epi, class Sched, bool ALIGN_EPI = false, bool SP2 = false>
__device__ __forceinline__ void gemm_phase(PG8_LAS unsigned char* lds, const Gemm g, const Sched& S, const Epi& E) {
    int tid_ = threadIdx.x; asm volatile("" : "+v"(tid_)); const int tid = tid_, wid = __builtin_amdgcn_readfirstlane(tid >> 6), lane = tid & 63, wr = wid >> 2, wc = wid & 3, fr = lane & 15, fq = lane >> 4;
    const int K = g.K, nt = K / BK;
    unsigned voffA[2], voffB[2];
#pragma unroll
    for (int i = 0; i < 2; ++i) { int R, C; stage_rc(tid * 16 + i * 8192, R, C); const int Rb = Epi::PERM ? ((R & ~31) + perm32(R & 31)) : R;
        voffA[i] = (unsigned)(R * g.lda + C) * 2u; voffB[i] = (unsigned)(Rb * g.ldb + C) * 2u; }
    const size_t kstep = (size_t)(BK * 2);
    const size_t hstepA = (size_t)HALF * g.lda * 2, hstepB = (size_t)HALF * g.ldb * 2;
    const size_t tstepA = 2 * hstepA, tstepB = 2 * hstepB;
    const unsigned ldsw = (unsigned)wid * 1024u;
    const int aoff = lds_byte(wr * 64 + fr, fq * 8), boff = lds_byte(wc * 32 + fr, fq * 8);
#define PG8_SA(b, h) (((b) * 2 + (h)) * HTB)
#define PG8_SB(b, h) ((4 + (b) * 2 + (h)) * HTB)
#define PG8_STAGE(bufoff, gbase, voff) do { _Pragma("unroll") for (int _i = 0; _i < 2; ++_i) \
        __builtin_amdgcn_global_load_lds((const unsigned*)((const char*)(gbase) + (voff)[_i]), (PG8_LAS unsigned*)(lds + (bufoff) + ldsw + _i * 8192), 16, 0, 0); } while (0)
#define PG8_LDA(dst, b, h) do { _Pragma("unroll") for (int m = 0; m < 4; ++m) _Pragma("unroll") for (int k = 0; k < 2; ++k) dst[m][k] = *(const PG8_LAS bf16x8*)(lds + PG8_SA(b, h) + aoff + m * 2048 + k * 1024); } while (0)
#define PG8_LDB(dst, b, h) do { _Pragma("unroll") for (int n = 0; n < 2; ++n) _Pragma("unroll") for (int k = 0; k < 2; ++k) dst[n][k] = *(const PG8_LAS bf16x8*)(lds + PG8_SB(b, h) + boff + n * 2048 + k * 1024); } while (0)
#define PG8_MMA(ai, bj, At, Bt) do { __builtin_amdgcn_s_setprio(1); _Pragma("unroll") for (int m = 0; m < 4; ++m) _Pragma("unroll") for (int n = 0; n < 2; ++n) _Pragma("unroll") for (int k = 0; k < 2; ++k) \
        acc[ai][bj][m][n] = __builtin_amdgcn_mfma_f32_16x16x32_bf16(Bt[n][k], At[m][k], acc[ai][bj][m][n], 0, 0, 0); __builtin_amdgcn_s_setprio(0); } while (0)
#define PG8_WAIT_V(n) asm volatile("s_waitcnt vmcnt(" #n ")" ::: "memory")
#define PG8_WAIT_L(n) asm volatile("s_waitcnt lgkmcnt(" #n ")" ::: "memory")
#define PG8_BAR __builtin_amdgcn_s_barrier()
#define PG8_SCHED __builtin_amdgcn_sched_barrier(0)
    Unit cur, nxt; int ui = 0;
    if (!S.next(0, cur)) return;
    f32x4 acc[2][2][4][2];
#pragma unroll
    for (int a = 0; a < 2; ++a)
#pragma unroll
        for (int b = 0; b < 2; ++b)
#pragma unroll
            for (int m = 0; m < 4; ++m)
#pragma unroll
                for (int n = 0; n < 2; ++n) acc[a][b][m][n] = (f32x4){0.f, 0.f, 0.f, 0.f};
    bf16x8 At[4][2], B0[2][2], B1[2][2];
    const char* cA = (const char*)g.A + (size_t)cur.pm * tstepA; const char* cB = (const char*)g.Bt + (size_t)cur.pn * tstepB;
    S.a_ready(cur);
    if constexpr (SP2) {
        PG8_STAGE(PG8_SB(0, 0), cB, voffB); PG8_STAGE(PG8_SB(0, 1), cB + hstepB, voffB); PG8_STAGE(PG8_SA(0, 0), cA, voffA); PG8_STAGE(PG8_SA(0, 1), cA + hstepA, voffA);
        if (wr == 1) PG8_BAR;
        PG8_WAIT_V(2); PG8_BAR;
        PG8_STAGE(PG8_SB(1, 0), cB + kstep, voffB); PG8_STAGE(PG8_SA(1, 0), cA + kstep, voffA); PG8_STAGE(PG8_SB(1, 1), cB + hstepB + kstep, voffB);
        PG8_WAIT_V(6); PG8_BAR;
    } else {
        PG8_STAGE(PG8_SB(0, 0), cB, voffB); PG8_STAGE(PG8_SA(0, 0), cA, voffA); PG8_STAGE(PG8_SB(0, 1), cB + hstepB, voffB); PG8_STAGE(PG8_SA(0, 1), cA + hstepA, voffA);
        if (wr == 1) PG8_BAR;
        PG8_WAIT_V(4); PG8_BAR;
        PG8_STAGE(PG8_SB(1, 0), cB + kstep, voffB); PG8_STAGE(PG8_SA(1, 0), cA + kstep, voffA); PG8_STAGE(PG8_SB(1, 1), cB + hstepB + kstep, voffB);
        PG8_WAIT_V(6); PG8_BAR;
    }
    for (;;) {
        const bool has_next = S.next(ui + 1, nxt);
        const char* nA = has_next ? (const char*)g.A + (size_t)nxt.pm * tstepA : cA; const char* nB = has_next ? (const char*)g.Bt + (size_t)nxt.pn * tstepB : cB;
        for (int t = 0; t < nt; t += 2) {
            const bool last = (t == nt - 2);
            const char* a1 = cA + (size_t)(t + 1) * kstep;
            const char* a2 = last ? nA : cA + (size_t)(t + 2) * kstep; const char* b2 = last ? nB : cB + (size_t)(t + 2) * kstep;
            const char* a3 = a2 + kstep; const char* b3 = b2 + kstep;
            if (last && has_next) S.a_ready(nxt);
            if constexpr (SP2) {
            PG8_LDB(B0, 0, 0); PG8_LDB(B1, 0, 1); PG8_SCHED; PG8_LDA(At, 0, 0); PG8_STAGE(PG8_SA(1, 1), a1 + hstepA, voffA);
            PG8_WAIT_V(8); PG8_WAIT_L(0); PG8_BAR; PG8_MMA(0, 0, At, B0); PG8_MMA(0, 1, At, B1); PG8_BAR; PG8_SCHED;
            PG8_LDA(At, 0, 1); PG8_STAGE(PG8_SB(0, 0), b2, voffB); PG8_STAGE(PG8_SB(0, 1), b2 + hstepB, voffB); PG8_STAGE(PG8_SA(0, 0), a2, voffA);
            PG8_WAIT_V(8); PG8_WAIT_L(0); PG8_BAR; PG8_MMA(1, 0, At, B0); PG8_MMA(1, 1, At, B1); PG8_BAR; PG8_SCHED;
            PG8_LDB(B0, 1, 0); PG8_LDB(B1, 1, 1); PG8_SCHED; PG8_LDA(At, 1, 0); PG8_STAGE(PG8_SA(0, 1), a2 + hstepA, voffA);
            PG8_WAIT_V(8); PG8_WAIT_L(0); PG8_BAR; PG8_MMA(0, 0, At, B0); PG8_MMA(0, 1, At, B1); PG8_BAR; PG8_SCHED;
            PG8_LDA(At, 1, 1); PG8_STAGE(PG8_SB(1, 0), b3, voffB); PG8_STAGE(PG8_SB(1, 1), b3 + hstepB, voffB); PG8_STAGE(PG8_SA(1, 0), a3, voffA);
            PG8_WAIT_V(8); PG8_WAIT_L(0); PG8_BAR; PG8_MMA(1, 0, At, B0); PG8_MMA(1, 1, At, B1); PG8_BAR; PG8_SCHED;
            } else {
            PG8_LDB(B0, 0, 0); PG8_SCHED; PG8_LDA(At, 0, 0); PG8_STAGE(PG8_SA(1, 1), a1 + hstepA, voffA);
            PG8_WAIT_L(8); PG8_BAR; PG8_WAIT_L(0); PG8_MMA(0, 0, At, B0); PG8_BAR; PG8_SCHED;
            PG8_LDB(B1, 0, 1); PG8_STAGE(PG8_SB(0, 0), b2, voffB);
            PG8_BAR; PG8_WAIT_L(0); PG8_MMA(0, 1, At, B1); PG8_BAR;
            PG8_LDA(At, 0, 1); PG8_STAGE(PG8_SA(0, 0), a2, voffA);
            PG8_BAR; PG8_WAIT_L(0); PG8_MMA(1, 0, At, B0); PG8_BAR; PG8_SCHED;
            PG8_STAGE(PG8_SB(0, 1), b2 + hstepB, voffB);
            PG8_WAIT_V(6); PG8_BAR; PG8_MMA(1, 1, At, B1); PG8_BAR;
            PG8_LDB(B0, 1, 0); PG8_SCHED; PG8_LDA(At, 1, 0); PG8_STAGE(PG8_SA(0, 1), a2 + hstepA, voffA);
            PG8_WAIT_L(8); PG8_BAR; PG8_WAIT_L(0); PG8_MMA(0, 0, At, B0); PG8_BAR; PG8_SCHED;
            PG8_LDB(B1, 1, 1); PG8_STAGE(PG8_SB(1, 0), b3, voffB);
            PG8_BAR; PG8_WAIT_L(0); PG8_MMA(0, 1, At, B1); PG8_BAR;
            PG8_LDA(At, 1, 1); PG8_STAGE(PG8_SA(1, 0), a3, voffA);
            PG8_BAR; PG8_WAIT_L(0); PG8_MMA(1, 0, At, B0); PG8_BAR; PG8_SCHED;
            PG8_STAGE(PG8_SB(1, 1), b3 + hstepB, voffB);
            PG8_WAIT_V(6); PG8_BAR; PG8_MMA(1, 1, At, B1); PG8_BAR;
            }
        }
        if constexpr (ALIGN_EPI) { if (wr == 0) PG8_BAR; }
        if constexpr (!Epi::AFTER_DRAIN) { E(acc, cur, wr, wc, fr, fq); S.done(cur); }
        if (!has_next) break;
#pragma unroll
        for (int a = 0; a < 2; ++a)
#pragma unroll
            for (int b = 0; b < 2; ++b)
#pragma unroll
                for (int m = 0; m < 4; ++m)
#pragma unroll
                    for (int n = 0; n < 2; ++n) acc[a][b][m][n] = (f32x4){0.f, 0.f, 0.f, 0.f};
        cur = nxt; cA = nA; cB = nB; ++ui;
        if constexpr (ALIGN_EPI) { if (wr == 1) PG8_BAR; }
    }
    PG8_WAIT_V(0);
    if constexpr (!ALIGN_EPI) { if (wr == 0) PG8_BAR; }
    PG8_BAR;
    if constexpr (Epi::AFTER_DRAIN) { E.fused(acc, cur, wr, wc, fr, fq, lds, wid, lane); S.done(cur); }
#undef PG8_SA
#undef PG8_SB
#undef PG8_STAGE
#undef PG8_LDA
#undef PG8_LDB
#undef PG8_MMA
#undef PG8_WAIT_V
#undef PG8_WAIT_L
#undef PG8_BAR
#undef PG8_SCHED
}
}
namespace pg8 {
__device__ __forceinline__ unsigned cvtpk(float lo, float hi) { typedef float f2_t __attribute__((ext_vector_type(2))); typedef __bf16 b2_t __attribute__((ext_vector_type(2))); f2_t v = {lo, hi}; b2_t b = __builtin_convertvector(v, b2_t); return __builtin_bit_cast(unsigned, b); }
__device__ __forceinline__ u32x4 pack8(const f32x4& v0, const f32x4& v1) { u32x4 w; w.x = cvtpk(v0[0], v0[1]); w.y = cvtpk(v0[2], v0[3]); w.z = cvtpk(v1[0], v1[1]); w.w = cvtpk(v1[2], v1[3]); return w; }
struct EpiPlain {
    static constexpr bool PERM = true, AFTER_DRAIN = false;
    bf16_t* O; int ldc;
    __device__ __forceinline__ void operator()(const f32x4 (&acc)[2][2][4][2], const Unit& u, int wr, int wc, int fr, int fq) const {
        const int row0 = u.pm * BM + wr * 64 + fr, col0 = u.pn * BM + wc * 32 + 8 * fq;
#pragma unroll
        for (int ai = 0; ai < 2; ++ai)
#pragma unroll
            for (int m = 0; m < 4; ++m) { bf16_t* rowp = O + (size_t)(row0 + ai * HALF + m * 16) * ldc + col0;
#pragma unroll
                for (int bj = 0; bj < 2; ++bj) *(u32x4*)(rowp + bj * HALF) = pack8(acc[ai][bj][m][0], acc[ai][bj][m][1]); }
    }
};
struct EpiRowScaleRope {
    static constexpr bool PERM = true, AFTER_DRAIN = false;
    bf16_t* O; int ldc; float mult; int rope_pn0; const float* cs;
    __device__ __forceinline__ void operator()(const f32x4 (&acc)[2][2][4][2], const Unit& u, int wr, int wc, int fr, int fq) const {
        const int row0 = u.pm * BM + wr * 64 + fr, col0 = u.pn * BM + wc * 32 + 8 * fq;
        const bool rope = u.pn >= rope_pn0;
#pragma unroll
        for (int ai = 0; ai < 2; ++ai)
#pragma unroll
            for (int m = 0; m < 4; ++m) { const int row = row0 + ai * HALF + m * 16; const float s = mult;
                f32x4 a0 = acc[ai][0][m][0] * s, a1 = acc[ai][0][m][1] * s, b0 = acc[ai][1][m][0] * s, b1 = acc[ai][1][m][1] * s;
                if (rope) { const f32x4* cp = (const f32x4*)(cs + (size_t)row * 64 + 16 * fq);
                    const f32x4 c0 = cp[0], c1 = cp[1], c2 = cp[2], c3 = cp[3];
                    f32x4 x0, x1, y0, y1;
                    x0[0] = a0[0] * c0[0] - b0[0] * c0[1]; y0[0] = b0[0] * c0[0] + a0[0] * c0[1];
                    x0[1] = a0[1] * c0[2] - b0[1] * c0[3]; y0[1] = b0[1] * c0[2] + a0[1] * c0[3];
                    x0[2] = a0[2] * c1[0] - b0[2] * c1[1]; y0[2] = b0[2] * c1[0] + a0[2] * c1[1];
                    x0[3] = a0[3] * c1[2] - b0[3] * c1[3]; y0[3] = b0[3] * c1[2] + a0[3] * c1[3];
                    x1[0] = a1[0] * c2[0] - b1[0] * c2[1]; y1[0] = b1[0] * c2[0] + a1[0] * c2[1];
                    x1[1] = a1[1] * c2[2] - b1[1] * c2[3]; y1[1] = b1[1] * c2[2] + a1[1] * c2[3];
                    x1[2] = a1[2] * c3[0] - b1[2] * c3[1]; y1[2] = b1[2] * c3[0] + a1[2] * c3[1];
                    x1[3] = a1[3] * c3[2] - b1[3] * c3[3]; y1[3] = b1[3] * c3[2] + a1[3] * c3[3];
                    a0 = x0; a1 = x1; b0 = y0; b1 = y1; }
                bf16_t* rowp = O + (size_t)row * ldc + col0;
                *(u32x4*)(rowp) = pack8(a0, a1); *(u32x4*)(rowp + HALF) = pack8(b0, b1); }
    }
};
struct EpiColScale {
    static constexpr bool PERM = true, AFTER_DRAIN = false;
    bf16_t* O; int ldc; const float* cscale;
    __device__ __forceinline__ void operator()(const f32x4 (&acc)[2][2][4][2], const Unit& u, int wr, int wc, int fr, int fq) const {
        const int row0 = u.pm * BM + wr * 64 + fr, col0 = u.pn * BM + wc * 32 + 8 * fq;
#pragma unroll
        for (int bj = 0; bj < 2; ++bj) { const f32x4 s0 = *(const f32x4*)(cscale + col0 + bj * HALF), s1 = *(const f32x4*)(cscale + col0 + bj * HALF + 4);
#pragma unroll
            for (int ai = 0; ai < 2; ++ai)
#pragma unroll
                for (int m = 0; m < 4; ++m) *(u32x4*)(O + (size_t)(row0 + ai * HALF + m * 16) * ldc + col0 + bj * HALF) = pack8(acc[ai][bj][m][0] * s0, acc[ai][bj][m][1] * s1);
            asm volatile("" ::: "memory"); }
    }
};
struct EpiSwiGLU {
    static constexpr bool PERM = true, AFTER_DRAIN = false;
    bf16_t* O; int ldc;
    __device__ __forceinline__ void operator()(const f32x4 (&acc)[2][2][4][2], const Unit& u, int wr, int wc, int fr, int fq) const {
        const int row0 = u.pm * BM + wr * 64 + fr, col0 = u.pn * HALF + wc * 32 + 8 * fq;
#pragma unroll
        for (int ai = 0; ai < 2; ++ai)
#pragma unroll
            for (int m = 0; m < 4; ++m) { f32x4 r[2];
#pragma unroll
                for (int n = 0; n < 2; ++n) { const f32x4 g = acc[ai][0][m][n], up = acc[ai][1][m][n];
#pragma unroll
                    for (int e = 0; e < 4; ++e) r[n][e] = g[e] * __builtin_amdgcn_rcpf(1.0f + __expf(-g[e])) * up[e]; }
                *(u32x4*)(O + (size_t)(row0 + ai * HALF + m * 16) * ldc + col0) = pack8(r[0], r[1]); }
    }
};
}
#define LAS __attribute__((address_space(3)))
typedef unsigned short bf16_t;
typedef short bf16x8 __attribute__((ext_vector_type(8)));
typedef float f32x4 __attribute__((ext_vector_type(4)));
typedef unsigned u32x4 __attribute__((ext_vector_type(4)));
typedef unsigned u32x2 __attribute__((ext_vector_type(2)));
constexpr int BATCH = 2, SEQ = 8192, DM = 2048, M = BATCH * SEQ, DFF = 5632, NADA = 6 * DM;
constexpr int ZC = 4096;
constexpr int ZO_CQ = 0, ZO_CKV = 512, ZO_QG = 768, ZO_KG = 1280, ZO_VG = 1792, ZO_RG = 2816, ZO_KR = 3840, ZO_AG = 3904;
constexpr int QC = 1536;
constexpr float RMS_EPS = 1e-6f;
constexpr float QSCALE = 0.07216878364870323f * 1.4426950408889634f;
constexpr int KS_ADA = 16;
constexpr size_t MiB = 1u << 20;
constexpr size_t WS_ADAP = 0, WS_ADA = 1536 * 1024, WS_RSTDQ = 1792 * 1024, WS_RSTDKV = 1856 * 1024, WS_DECAY = 2 * MiB, WS_CS = 3 * MiB, WS_KROPE = 7 * MiB;
constexpr size_t WS_WIN = 10 * MiB, WS_WUQ = 26 * MiB, WS_WUK = 28 * MiB, WS_WUV = 29 * MiB, WS_WOUT = 30 * MiB, WS_WGU = 38 * MiB, WS_WD = 82 * MiB;
constexpr size_t WS_XN = 104 * MiB;
constexpr size_t WS_Q = 168 * MiB, WS_KN = 216 * MiB, WS_VT = 248 * MiB, WS_QDEC = 280 * MiB, WS_OI = 296 * MiB, WS_ST = 328 * MiB;
constexpr size_t WS_O = 168 * MiB;
constexpr size_t WS_ACT = 232 * MiB, WS_CQN = 392 * MiB, WS_CKVN = 408 * MiB, WS_X1 = 416 * MiB, WS_END = 480 * MiB;
constexpr size_t WS_CTL = 9 * MiB, CTL_BYTES = 65536;
constexpr int NTHREADS = 512, LDS_BYTES = 147456, MISC_OFF = 131072 + 320;

__device__ const double INVF_REV[32] = {
    1.59154943091895346e-01,
    1.19349370211248862e-01,
    8.94994016088910133e-02,
    6.71150830052272551e-02,
    5.03292121044870353e-02,
    3.77415847174197711e-02,
    2.83021958306233987e-02,
    2.12236527647776604e-02,
    1.59154943091895339e-02,
    1.19349370211248862e-02,
    8.94994016088910237e-03,
    6.71150830052272534e-03,
    5.03292121044870370e-03,
    3.77415847174197719e-03,
    2.83021958306233987e-03,
    2.12236527647776622e-03,
    1.59154943091895356e-03,
    1.19349370211248849e-03,
    8.94994016088910237e-04,
    6.71150830052272599e-04,
    5.03292121044870326e-04,
    3.77415847174197741e-04,
    2.83021958306233954e-04,
    2.12236527647776605e-04,
    1.59154943091895351e-04,
    1.19349370211248862e-04,
    8.94994016088910182e-05,
    6.71150830052272545e-05,
    5.03292121044870354e-05,
    3.77415847174197768e-05,
    2.83021958306233961e-05,
    2.12236527647776592e-05

};

struct Params {
    const float *x, *c; const int* pos; const float *w_ada, *b_ada, *g_pre_mix, *g_post_mix, *w_in, *g_q, *w_uq, *g_kv, *w_uk, *w_uv, *w_gate_up, *b_gate, *g_gla, *w_out, *g_pre_ffn, *g_post_ffn, *w_fg, *w_fu, *w_fd;
    float* out; unsigned char* ws;
};

__device__ __forceinline__ int opaque_tid() { int t = threadIdx.x; asm volatile("" : "+v"(t)); return t; }
__device__ __forceinline__ float bf2f(unsigned short u) { return __uint_as_float((unsigned)u << 16); }
__device__ __forceinline__ unsigned short f2bf(float f) { unsigned u = __float_as_uint(f); return (unsigned short)((u + 0x7fffu + ((u >> 16) & 1u)) >> 16); }
__device__ __forceinline__ unsigned pk2(float lo, float hi) { return pg8::cvtpk(lo, hi); }
__device__ __forceinline__ float xsum16(float v) { const auto r = __builtin_amdgcn_permlane16_swap(__float_as_uint(v), __float_as_uint(v), false, false); return __uint_as_float(r[0]) + __uint_as_float(r[1]); }
__device__ __forceinline__ float xsum32(float v) { const auto r = __builtin_amdgcn_permlane32_swap(__float_as_uint(v), __float_as_uint(v), false, false); return __uint_as_float(r[0]) + __uint_as_float(r[1]); }
__device__ __forceinline__ float wave_sum(float v) {
#pragma unroll
    for (int o = 1; o < 16; o <<= 1) v += __shfl_xor(v, o);
    return xsum32(xsum16(v));
}
__device__ __forceinline__ float silu_f(float v) { return v * __builtin_amdgcn_rcpf(1.0f + __expf(-v)); }
#define MFMA16(a, b, c) __builtin_amdgcn_mfma_f32_16x16x32_bf16((a), (b), (c), 0, 0, 0)

struct MapIn { const float* W;
    __device__ __forceinline__ const float* col(int n, int& ld) const { ld = 3920; int s;
        if (n < 768) s = n; else if (n < 1280) s = 832 + (n - 768); else if (n < 1792) s = 1344 + (n - 1280); else if (n < 2816) s = 1856 + (n - 1792);
        else if (n < 3840) s = 2896 + (n - 2816); else if (n < 3904) s = 768 + (n - 3840); else if (n < 3920) s = 2880 + (n - 3904); else return nullptr;
        return W + s; } };
struct MapUq { const float* W;
    __device__ __forceinline__ const float* col(int n, int& ld) const { ld = 1536; int s;
        if (n < 1024) s = (n >> 7) * 192 + (n & 127);
        else { const int mm = n - 1024, tile = mm >> 8, w = mm & 255, half = w >> 7, hh = (w & 127) >> 5, i = w & 31; s = (tile * 4 + hh) * 192 + 128 + half * 32 + i; }
        return W + s; } };
struct MapId { const float* W; int ldw;
    __device__ __forceinline__ const float* col(int n, int& ld) const { ld = ldw; return W + n; } };
struct MapGU { const float* Wg; const float* Wu;
    __device__ __forceinline__ const float* col(int n, int& ld) const { ld = DFF; const int tile = n >> 8, w = n & 255; return (w < 128) ? (Wg + tile * 128 + w) : (Wu + tile * 128 + (w - 128)); } };
template <class Map>
__device__ __forceinline__ void transpose_item(const Map& mp, const float* gain, int K, bf16_t* WT, int item, int nblk, int lane, bool late = false) {
    const int kb = item / nblk, nb = item % nblk, k0 = 64 * kb, n0 = 64 * nb, kq = lane >> 4, nc = lane & 15;
    int ld; const float* src = mp.col(n0 + 4 * nc, ld);
    f32x4 v[16];
    if (src) { src += (size_t)(k0 + 16 * kq) * ld;
#pragma unroll
        for (int i = 0; i < 16; ++i) v[i] = __builtin_nontemporal_load((const f32x4*)(src + (size_t)i * ld));
    } else {
#pragma unroll
        for (int i = 0; i < 16; ++i) v[i] = (f32x4){0.f, 0.f, 0.f, 0.f};
    }
    if (gain) {
#pragma unroll
        for (int i = 0; i < 16; ++i) v[i] *= gain[k0 + 16 * kq + i];
    }
#pragma unroll
    for (int e = 0; e < 4; ++e) { bf16_t* dst = WT + (size_t)(n0 + 4 * nc + e) * K + k0 + 16 * kq;
        u32x4 w0, w1; w0.x = pk2(v[0][e], v[1][e]); w0.y = pk2(v[2][e], v[3][e]); w0.z = pk2(v[4][e], v[5][e]); w0.w = pk2(v[6][e], v[7][e]);
        w1.x = pk2(v[8][e], v[9][e]); w1.y = pk2(v[10][e], v[11][e]); w1.z = pk2(v[12][e], v[13][e]); w1.w = pk2(v[14][e], v[15][e]);
        if (late) { __builtin_nontemporal_store(w0, (u32x4*)dst); __builtin_nontemporal_store(w1, (u32x4*)(dst + 8)); }
        else { *(u32x4*)dst = w0; *(u32x4*)(dst + 8) = w1; } }
}

__device__ __forceinline__ void p0_prologue(const Params& P, LAS unsigned char* lds, int G) {
    const int tid = opaque_tid(), lane = tid & 63, wave = tid >> 6;
    unsigned char* ws = P.ws;
    const int gw = wave * G + blockIdx.x, NGW = G * 8;
    float* adap = (float*)(ws + WS_ADAP);
    for (int it = gw; it < 48 * KS_ADA; it += NGW) {
        const int nc = it % 48, ks = it / 48, n0 = nc * 256 + lane * 4;
        f32x4 a0 = {0.f, 0.f, 0.f, 0.f}, a1 = {0.f, 0.f, 0.f, 0.f};
#pragma unroll 16
        for (int kk = 0; kk < 128; ++kk) { const int k = ks * 128 + kk; const f32x4 w = __builtin_nontemporal_load((const f32x4*)(P.w_ada + (size_t)k * NADA + n0));
            const float s0 = silu_f(P.c[k]), s1 = silu_f(P.c[DM + k]); a0 += w * s0; a1 += w * s1; }
        *(f32x4*)(adap + (size_t)(ks * 2 + 0) * NADA + n0) = a0; *(f32x4*)(adap + (size_t)(ks * 2 + 1) * NADA + n0) = a1;
    }
    constexpr int I_IN = 32 * 64, I_UQ = 8 * 24, I_UK = 4 * 16, I_UV = 4 * 16, I_OUT = 32 * 32, I_GU = 32 * 176, I_D = 88 * 32;
    constexpr int NITEMS = I_IN + I_UQ + I_UK + I_UV + I_OUT + I_GU + I_D;
    for (int it = gw; it < NITEMS; it += NGW) {
        int r = it;
        if (r < I_IN) { transpose_item(MapIn{P.w_in}, nullptr, 2048, (bf16_t*)(ws + WS_WIN), r, 64, lane); continue; } r -= I_IN;
        if (r < I_UQ) { transpose_item(MapUq{P.w_uq}, P.g_q, 512, (bf16_t*)(ws + WS_WUQ), r, 24, lane); continue; } r -= I_UQ;
        if (r < I_UK) { transpose_item(MapId{P.w_uk, 1024}, P.g_kv, 256, (bf16_t*)(ws + WS_WUK), r, 16, lane); continue; } r -= I_UK;
        if (r < I_UV) { transpose_item(MapId{P.w_uv, 1024}, P.g_kv, 256, (bf16_t*)(ws + WS_WUV), r, 16, lane); continue; } r -= I_UV;
        if (r < I_OUT) { transpose_item(MapId{P.w_out, 2048}, nullptr, 2048, (bf16_t*)(ws + WS_WOUT), r, 32, lane, true); continue; } r -= I_OUT;
        if (r < I_GU) { transpose_item(MapGU{P.w_fg, P.w_fu}, nullptr, 2048, (bf16_t*)(ws + WS_WGU), r, 176, lane, true); continue; } r -= I_GU;
        transpose_item(MapId{P.w_fd, 2048}, nullptr, DFF, (bf16_t*)(ws + WS_WD), r, 32, lane, true);
    }
    float* cs = (float*)(ws + WS_CS);
    for (int idx = blockIdx.x * NTHREADS + tid; idx < M * 32; idx += G * NTHREADS) {
        const int m = idx >> 5, i = idx & 31; const double rev = (double)P.pos[m] * INVF_REV[i]; const float fr = (float)(rev - floor(rev));
        cs[2 * idx] = __builtin_amdgcn_cosf(fr); cs[2 * idx + 1] = __builtin_amdgcn_sinf(fr);
    }
}

__device__ __forceinline__ void p1_rows(const Params& P, LAS unsigned char* lds, int G) {
    const int tid = opaque_tid(), lane = tid & 63, wave = tid >> 6;
    const float* adap = (const float*)(P.ws + WS_ADAP); float* ada = (float*)(P.ws + WS_ADA);
    LAS float* TA = (LAS float*)lds;
    LAS float* TC = TA + 2 * DM;
    for (int idx = tid; idx < 2 * DM; idx += NTHREADS) { const int b = idx >> 11, col = idx & (DM - 1);
        float sh = P.b_ada[col], sc = P.b_ada[DM + col];
        for (int ks = 0; ks < KS_ADA; ++ks) { sh += adap[(size_t)(ks * 2 + b) * NADA + col]; sc += adap[(size_t)(ks * 2 + b) * NADA + DM + col]; }
        TA[idx] = P.g_pre_mix[col] * (1.0f + sc); TC[idx] = sh; }
    for (int idx = blockIdx.x * NTHREADS + tid; idx < 2 * NADA; idx += G * NTHREADS) { const int b = idx / NADA, n = idx % NADA; float v = P.b_ada[n];
        for (int ks = 0; ks < KS_ADA; ++ks) v += adap[(size_t)(ks * 2 + b) * NADA + n];
        ada[idx] = v; }
    __syncthreads();
    bf16_t* XN = (bf16_t*)(P.ws + WS_XN);
    for (int m = blockIdx.x * 8 + wave; m < M; m += G * 8) {
        const int b = m >> 13; const f32x4* xr = (const f32x4*)(P.x + (size_t)m * DM) + lane;
        f32x4 v[8]; float ss = 0.f;
#pragma unroll
        for (int j = 0; j < 8; ++j) { v[j] = __builtin_nontemporal_load(xr + 64 * j); ss += (v[j][0] * v[j][0] + v[j][1] * v[j][1]) + (v[j][2] * v[j][2] + v[j][3] * v[j][3]); }
        const float rstd = rsqrtf(wave_sum(ss) * (1.0f / DM) + RMS_EPS);
        u32x2* o = (u32x2*)(XN + (size_t)m * DM) + lane;
#pragma unroll
        for (int j = 0; j < 8; ++j) { const f32x4 a = *(const LAS f32x4*)(TA + b * DM + 256 * j + 4 * lane), c = *(const LAS f32x4*)(TC + b * DM + 256 * j + 4 * lane);
            const f32x4 h = v[j] * rstd * a + c; u32x2 w; w.x = pk2(h[0], h[1]); w.y = pk2(h[2], h[3]); o[64 * j] = w; }
    }
}
__device__ __forceinline__ void p2b_rows(const Params& P, int G) {
    const int tid = opaque_tid(), lane = tid & 63, wave = tid >> 6;
    const bf16_t* Z = (const bf16_t*)P.out; bf16_t* CQN = (bf16_t*)(P.ws + WS_CQN); bf16_t* CKVN = (bf16_t*)(P.ws + WS_CKVN);
    const float* cs = (const float*)(P.ws + WS_CS); bf16_t* KR = (bf16_t*)(P.ws + WS_KROPE);
    for (int m = blockIdx.x * 8 + wave; m < M; m += G * 8) {
        const bf16_t* zr = Z + (size_t)m * ZC;
        const u32x4 a = *(const u32x4*)(zr + ZO_CQ + 8 * lane); const u32x2 k = *(const u32x2*)(zr + ZO_CKV + 4 * lane);
        float s1 = 0.f, s2 = 0.f;
#pragma unroll
        for (int e = 0; e < 4; ++e) { const float lo = __uint_as_float(a[e] << 16), hi = __uint_as_float(a[e] & 0xffff0000u); s1 += lo * lo + hi * hi; }
#pragma unroll
        for (int e = 0; e < 2; ++e) { const float lo = __uint_as_float(k[e] << 16), hi = __uint_as_float(k[e] & 0xffff0000u); s2 += lo * lo + hi * hi; }
        s1 = wave_sum(s1); s2 = wave_sum(s2);
        const float r1 = rsqrtf(s1 * (1.0f / 512.0f) + RMS_EPS), r2 = rsqrtf(s2 * (1.0f / 256.0f) + RMS_EPS);
        { u32x4 w;
#pragma unroll
          for (int e = 0; e < 4; ++e) w[e] = pk2(__uint_as_float(a[e] << 16) * r1, __uint_as_float(a[e] & 0xffff0000u) * r1);
          *(u32x4*)(CQN + (size_t)m * 512 + 8 * lane) = w;
          u32x2 w2;
#pragma unroll
          for (int e = 0; e < 2; ++e) w2[e] = pk2(__uint_as_float(k[e] << 16) * r2, __uint_as_float(k[e] & 0xffff0000u) * r2);
          *(u32x2*)(CKVN + (size_t)m * 256 + 4 * lane) = w2; }
        if (lane < 32) { const float x1 = bf2f(zr[ZO_KR + lane]), x2 = bf2f(zr[ZO_KR + 32 + lane]); const float c = cs[(size_t)m * 64 + 2 * lane], s = cs[(size_t)m * 64 + 2 * lane + 1];
            KR[(size_t)m * 64 + lane] = f2bf(x1 * c - x2 * s); KR[(size_t)m * 64 + 32 + lane] = f2bf(x2 * c + x1 * s); }
    }
}
__device__ __forceinline__ void p7_rows(const Params& P, LAS unsigned char* lds, int G) {
    const int tid = opaque_tid(), lane = tid & 63, wave = tid >> 6;
    const float* ada = (const float*)(P.ws + WS_ADA);
    LAS float* TA = (LAS float*)lds; LAS float* TB = TA + 2 * DM; LAS float* TC = TB + 2 * DM;
    for (int idx = tid; idx < 2 * DM; idx += NTHREADS) { const int b = idx >> 11, col = idx & (DM - 1); const float* ab = ada + (size_t)b * NADA;
        TA[idx] = ab[2 * DM + col] * P.g_post_mix[col]; TB[idx] = P.g_pre_ffn[col] * (1.0f + ab[4 * DM + col]); TC[idx] = ab[3 * DM + col]; }
    __syncthreads();
    const bf16_t* O = (const bf16_t*)(P.ws + WS_O); bf16_t* XN = (bf16_t*)(P.ws + WS_XN);
    for (int m = blockIdx.x * 8 + wave; m < M; m += G * 8) {
        const int b = m >> 13; const f32x4* xr = (const f32x4*)(P.x + (size_t)m * DM) + lane; const u32x2* orow = (const u32x2*)(O + (size_t)m * DM) + lane;
        f32x4 v[8], xv[8]; float ss = 0.f;
#pragma unroll
        for (int j = 0; j < 8; ++j) xv[j] = __builtin_nontemporal_load(xr + 64 * j);
#pragma unroll
        for (int j = 0; j < 8; ++j) { const u32x2 w = __builtin_nontemporal_load(orow + 64 * j); v[j][0] = __uint_as_float(w.x << 16); v[j][1] = __uint_as_float(w.x & 0xffff0000u); v[j][2] = __uint_as_float(w.y << 16); v[j][3] = __uint_as_float(w.y & 0xffff0000u);
            ss += (v[j][0] * v[j][0] + v[j][1] * v[j][1]) + (v[j][2] * v[j][2] + v[j][3] * v[j][3]); }
        const float rstd = rsqrtf(wave_sum(ss) * (1.0f / DM) + RMS_EPS);
        float s2 = 0.f; u32x2* x1r = (u32x2*)((bf16_t*)(P.ws + WS_X1) + (size_t)m * DM) + lane;
#pragma unroll
        for (int j = 0; j < 8; ++j) { const f32x4 a = *(const LAS f32x4*)(TA + b * DM + 256 * j + 4 * lane); const f32x4 x1 = xv[j] + v[j] * rstd * a; v[j] = x1; { u32x2 w; w.x = pk2(x1[0], x1[1]); w.y = pk2(x1[2], x1[3]); __builtin_nontemporal_store(w, x1r + 64 * j); }
            s2 += (x1[0] * x1[0] + x1[1] * x1[1]) + (x1[2] * x1[2] + x1[3] * x1[3]); }
        const float rstd2 = rsqrtf(wave_sum(s2) * (1.0f / DM) + RMS_EPS);
        u32x2* o = (u32x2*)(XN + (size_t)m * DM) + lane;
#pragma unroll
        for (int j = 0; j < 8; ++j) { const f32x4 a = *(const LAS f32x4*)(TB + b * DM + 256 * j + 4 * lane), c = *(const LAS f32x4*)(TC + b * DM + 256 * j + 4 * lane);
            const f32x4 h = v[j] * rstd2 * a + c; u32x2 w; w.x = pk2(h[0], h[1]); w.y = pk2(h[2], h[3]); o[64 * j] = w; }
    }
}
__device__ __forceinline__ void p10_rows(const Params& P, LAS unsigned char* lds, int G) {
    const int tid = opaque_tid(), lane = tid & 63, wave = tid >> 6;
    const float* ada = (const float*)(P.ws + WS_ADA);
    LAS float* TA = (LAS float*)lds;
    for (int idx = tid; idx < 2 * DM; idx += NTHREADS) { const int b = idx >> 11, col = idx & (DM - 1); TA[idx] = ada[(size_t)b * NADA + 5 * DM + col] * P.g_post_ffn[col]; }
    __syncthreads();
    const bf16_t* F = (const bf16_t*)(P.ws + WS_O);
    for (int m = blockIdx.x * 8 + wave; m < M; m += G * 8) {
        const int b = m >> 13; const u32x2* fr = (const u32x2*)(F + (size_t)m * DM) + lane; f32x4* outr = (f32x4*)(P.out + (size_t)m * DM) + lane; const u32x2* x1r = (const u32x2*)((const bf16_t*)(P.ws + WS_X1) + (size_t)m * DM) + lane;
        f32x4 v[8]; u32x2 xw8[8]; float ss = 0.f;
#pragma unroll
        for (int j = 0; j < 8; ++j) xw8[j] = __builtin_nontemporal_load(x1r + 64 * j);
#pragma unroll
        for (int j = 0; j < 8; ++j) { const u32x2 w = __builtin_nontemporal_load(fr + 64 * j); v[j][0] = __uint_as_float(w.x << 16); v[j][1] = __uint_as_float(w.x & 0xffff0000u); v[j][2] = __uint_as_float(w.y << 16); v[j][3] = __uint_as_float(w.y & 0xffff0000u);
            ss += (v[j][0] * v[j][0] + v[j][1] * v[j][1]) + (v[j][2] * v[j][2] + v[j][3] * v[j][3]); }
        const float rstd = rsqrtf(wave_sum(ss) * (1.0f / DM) + RMS_EPS);
#pragma unroll
        for (int j = 0; j < 8; ++j) { const f32x4 a = *(const LAS f32x4*)(TA + b * DM + 256 * j + 4 * lane); const u32x2 xw = xw8[j]; f32x4 x1; x1[0] = __uint_as_float(xw.x << 16); x1[1] = __uint_as_float(xw.x & 0xffff0000u); x1[2] = __uint_as_float(xw.y << 16); x1[3] = __uint_as_float(xw.y & 0xffff0000u); __builtin_nontemporal_store(x1 + v[j] * rstd * a, outr + 64 * j); }
    }
}
constexpr int G1_AG = 0, G1_SEG = 4096, G1_QD = 8192, G1_KI = G1_QD + 64 * 272, G1_KDT = G1_KI + 64 * 272, G1_VT = G1_KDT + 128 * 144, G1_AT = G1_VT + 256 * 144, G1_END = G1_AT + 64 * 144;
static_assert(G1_END <= 131072, "G1 LDS");
__device__ __forceinline__ void gla_intra_unit(const Params& P, LAS unsigned char* lds, int unit) {
    const int tid = opaque_tid(), lane = tid & 63, wid = tid >> 6, fr = lane & 15, fq = lane >> 4;
    const int bh = unit >> 7, n = unit & 127, b = bh >> 2, h = bh & 3;
    const size_t t0 = (size_t)b * SEQ + 64 * n;
    const bf16_t* Z = (const bf16_t*)P.out;
    LAS float* ag = (LAS float*)(lds + G1_AG); LAS float* seg = (LAS float*)(lds + G1_SEG);
    LAS bf16_t* qd = (LAS bf16_t*)(lds + G1_QD); LAS bf16_t* ki = (LAS bf16_t*)(lds + G1_KI); LAS bf16_t* kdT = (LAS bf16_t*)(lds + G1_KDT);
    LAS bf16_t* vT = (LAS bf16_t*)(lds + G1_VT); LAS bf16_t* at = (LAS bf16_t*)(lds + G1_AT);
    bf16_t* qdec_g = (bf16_t*)(P.ws + WS_QDEC); float* decay_g = (float*)(P.ws + WS_DECAY); bf16_t* OI = (bf16_t*)(P.ws + WS_OI); bf16_t* DS = (bf16_t*)(P.ws + WS_XN);
    const int d_ = tid & 127, cgp_ = tid >> 7;
    float wg_[16];
#pragma unroll
    for (int r = 0; r < 16; ++r) wg_[r] = P.w_gate_up[r * 512 + 128 * h + d_];
    const float bias_ = P.b_gate[128 * h + d_];
    bf16_t qraw_[16], kraw_[16];
#pragma unroll
    for (int i = 0; i < 16; ++i) { const size_t zr = (t0 + cgp_ * 16 + i) * ZC; qraw_[i] = Z[zr + ZO_QG + 128 * h + d_]; kraw_[i] = Z[zr + ZO_KG + 128 * h + d_]; }
    { const int idx = tid * 2, c = idx >> 4, r = idx & 15; const unsigned w = *(const unsigned*)(Z + (t0 + c) * ZC + ZO_AG + r); ag[c * 16 + r] = __uint_as_float(w << 16); ag[c * 16 + r + 1] = __uint_as_float(w & 0xffff0000u); }
#pragma unroll
    for (int i = 0; i < 4; ++i) { const int id = tid + NTHREADS * i, c = id & 63, vc = id >> 6;
        const u32x4 w = *(const u32x4*)(Z + (t0 + c) * ZC + ZO_VG + 256 * h + 8 * vc);
#pragma unroll
        for (int e = 0; e < 4; ++e) { vT[(8 * vc + 2 * e) * 72 + c] = (bf16_t)(w[e] & 0xffffu); vT[(8 * vc + 2 * e + 1) * 72 + c] = (bf16_t)(w[e] >> 16); } }
    __syncthreads();
    { const int d = d_, cgp = cgp_;
      float (&w)[16] = wg_; const float bias = bias_;
      float bcv[16]; float run = 0.f;
#pragma unroll
      for (int i = 0; i < 16; ++i) { const int c = cgp * 16 + i; float xg = bias;
#pragma unroll
          for (int r4 = 0; r4 < 4; ++r4) { const f32x4 a = *(const LAS f32x4*)(ag + c * 16 + 4 * r4); xg += a[0] * w[4 * r4] + a[1] * w[4 * r4 + 1] + a[2] * w[4 * r4 + 2] + a[3] * w[4 * r4 + 3]; }
          const float ls = fminf(xg, 0.f) - __logf(1.0f + __expf(-fabsf(xg)));
          run += ls * (1.0f / 16.0f); bcv[i] = run; }
      seg[cgp * 128 + d] = run;
      __syncthreads();
      float off = 0.f, tot = 0.f;
#pragma unroll
      for (int g2 = 0; g2 < 4; ++g2) { const float sv = seg[g2 * 128 + d]; tot += sv; if (g2 < cgp) off += sv; }
      float kd_prev = 0.f;
#pragma unroll
      for (int i = 0; i < 16; ++i) { const int c = cgp * 16 + i; const float bc = bcv[i] + off;
          const float q = bf2f(qraw_[i]), k = bf2f(kraw_[i]);
          const bf16_t qv = f2bf(q * 0.08838834764831845f * __expf(bc));
          qd[c * 136 + d] = qv; ki[c * 136 + d] = f2bf(k * __expf(-bc));
          const float kdv = k * __expf(tot - bc);
          if (i & 1) *(LAS unsigned*)(kdT + d * 72 + c - 1) = pk2(kd_prev, kdv); else kd_prev = kdv; }
      if (cgp == 0) decay_g[(size_t)unit * 128 + d] = __expf(tot);
    }
    __syncthreads();
#pragma unroll
    for (int i = 0; i < 2; ++i) { const int id = tid + NTHREADS * i, c = id >> 4, ch = id & 15; *(u32x4*)(qdec_g + ((size_t)unit * 64 + c) * 128 + 8 * ch) = *(const LAS u32x4*)(qd + c * 136 + 8 * ch); }
    { const int cb = wid >> 1;
#pragma unroll
      for (int jj = 0; jj < 2; ++jj) { const int jb = (wid & 1) * 2 + jj; f32x4 acc = {0.f, 0.f, 0.f, 0.f};
          if (jb <= cb) {
#pragma unroll
              for (int ks = 0; ks < 4; ++ks) { const bf16x8 a = *(const LAS bf16x8*)(qd + (16 * cb + fr) * 136 + 32 * ks + 8 * fq), bb = *(const LAS bf16x8*)(ki + (16 * jb + fr) * 136 + 32 * ks + 8 * fq); acc = MFMA16(a, bb, acc); } }
#pragma unroll
          for (int e = 0; e < 4; ++e) { const int c = 16 * cb + 4 * fq + e, j = 16 * jb + fr; at[c * 72 + j] = f2bf(j <= c ? acc[e] : 0.f); } }
    }
    __syncthreads();
#pragma unroll
    for (int vbi = 0; vbi < 2; ++vbi) { const int vb = 2 * wid + vbi;
        bf16x8 vf[2];
#pragma unroll
        for (int ks = 0; ks < 2; ++ks) vf[ks] = *(const LAS bf16x8*)(vT + (16 * vb + fr) * 72 + 32 * ks + 8 * fq);
#pragma unroll
        for (int cb = 0; cb < 4; ++cb) { f32x4 acc = {0.f, 0.f, 0.f, 0.f};
#pragma unroll
            for (int ks = 0; ks < 2; ++ks) acc = MFMA16(vf[ks], *(const LAS bf16x8*)(at + (16 * cb + fr) * 72 + 32 * ks + 8 * fq), acc);
            u32x2 w; w.x = pk2(acc[0], acc[1]); w.y = pk2(acc[2], acc[3]);
            *(u32x2*)(OI + (t0 + 16 * cb + fr) * 1024 + 256 * h + 16 * vb + 4 * fq) = w; }
#pragma unroll
        for (int db = 0; db < 8; ++db) { f32x4 acc = {0.f, 0.f, 0.f, 0.f};
#pragma unroll
            for (int ks = 0; ks < 2; ++ks) acc = MFMA16(*(const LAS bf16x8*)(kdT + (16 * db + fr) * 72 + 32 * ks + 8 * fq), vf[ks], acc);
            u32x2 w; w.x = pk2(acc[0], acc[1]); w.y = pk2(acc[2], acc[3]);
            *(u32x2*)(DS + ((size_t)unit * 256 + 16 * vb + fr) * 128 + 16 * db + 4 * fq) = w; }
    }
    __syncthreads();
}
__device__ __forceinline__ void gla_scan(const Params& P, int G) {
    const bf16_t* DS = (const bf16_t*)(P.ws + WS_XN); bf16_t* ST = (bf16_t*)(P.ws + WS_ST); const float* decay_g = (const float*)(P.ws + WS_DECAY);
    if (threadIdx.x < 256) for (int gid = blockIdx.x * 256 + threadIdx.x; gid < 8 * 8192; gid += G * 256) {
        const int bh = gid >> 13, e4 = gid & 8191, d = (4 * e4) & 127;
        f32x4 st = {0.f, 0.f, 0.f, 0.f};
#pragma unroll 16
        for (int n = 0; n < 128; ++n) { const size_t unit = (size_t)bh * 128 + n;
            const u32x2 w = *(const u32x2*)(DS + unit * 32768 + 4 * e4); const f32x4 dd = *(const f32x4*)(decay_g + unit * 128 + d);
            u32x2 o; o.x = pk2(st[0], st[1]); o.y = pk2(st[2], st[3]); *(u32x2*)(ST + unit * 32768 + 4 * e4) = o;
            f32x4 in; in[0] = __uint_as_float(w.x << 16); in[1] = __uint_as_float(w.x & 0xffff0000u); in[2] = __uint_as_float(w.y << 16); in[3] = __uint_as_float(w.y & 0xffff0000u);
            st = dd * st + in; }
    }
}
__device__ __forceinline__ void gla_inter_unit(const Params& P, LAS unsigned char* lds, int unit) {
    const int tid = opaque_tid(), lane = tid & 63, wid = tid >> 6, fr = lane & 15, fq = lane >> 4;
    const int bh = unit >> 7, n = unit & 127, b = bh >> 2, h = bh & 3;
    const size_t t0 = (size_t)b * SEQ + 64 * n;
    const bf16_t* Z = (const bf16_t*)P.out; const bf16_t* qdec_g = (const bf16_t*)(P.ws + WS_QDEC); const bf16_t* OI = (const bf16_t*)(P.ws + WS_OI); const bf16_t* ST = (const bf16_t*)(P.ws + WS_ST);
    bf16_t* AO = (bf16_t*)(P.ws + WS_XN);
    LAS float* red = (LAS float*)lds;
    const int cb = wid & 3, vh = wid >> 2; const size_t trow = t0 + 16 * cb + fr;
    bf16x8 qf[4];
#pragma unroll
    for (int ks = 0; ks < 4; ++ks) qf[ks] = *(const bf16x8*)(qdec_g + ((size_t)unit * 64 + 16 * cb + fr) * 128 + 32 * ks + 8 * fq);
    f32x4 o[8]; float ss = 0.f;
    bf16x8 sf[8][4]; u32x2 oiw[8];
#pragma unroll
    for (int vbi = 0; vbi < 8; ++vbi) { const int vb = vh * 8 + vbi;
#pragma unroll
        for (int ks = 0; ks < 4; ++ks) sf[vbi][ks] = *(const bf16x8*)(ST + ((size_t)unit * 256 + 16 * vb + fr) * 128 + 32 * ks + 8 * fq);
        oiw[vbi] = *(const u32x2*)(OI + trow * 1024 + 256 * h + 16 * vb + 4 * fq); }
#pragma unroll
    for (int vbi = 0; vbi < 8; ++vbi) { f32x4 acc = {0.f, 0.f, 0.f, 0.f};
#pragma unroll
        for (int ks = 0; ks < 4; ++ks) acc = MFMA16(sf[vbi][ks], qf[ks], acc);
        const u32x2 w = oiw[vbi];
        acc[0] += __uint_as_float(w.x << 16); acc[1] += __uint_as_float(w.x & 0xffff0000u); acc[2] += __uint_as_float(w.y << 16); acc[3] += __uint_as_float(w.y & 0xffff0000u);
        o[vbi] = acc; ss += (acc[0] * acc[0] + acc[1] * acc[1]) + (acc[2] * acc[2] + acc[3] * acc[3]); }
    ss = xsum32(xsum16(ss));
    if (fq == 0) red[wid * 16 + fr] = ss;
    __syncthreads();
    const float tot = red[cb * 16 + fr] + red[(cb + 4) * 16 + fr];
    const float rstd = rsqrtf(tot * (1.0f / 256.0f) + RMS_EPS);
#pragma unroll
    for (int vbi = 0; vbi < 8; ++vbi) { const int vcol = 16 * (vh * 8 + vbi) + 4 * fq;
        const f32x4 g = *(const f32x4*)(P.g_gla + vcol); const u32x2 rw = *(const u32x2*)(Z + trow * ZC + ZO_RG + 256 * h + vcol);
        const float r0 = __uint_as_float(rw.x << 16), r1 = __uint_as_float(rw.x & 0xffff0000u), r2 = __uint_as_float(rw.y << 16), r3 = __uint_as_float(rw.y & 0xffff0000u);
        u32x2 w; w.x = pk2(o[vbi][0] * rstd * g[0] * silu_f(r0), o[vbi][1] * rstd * g[1] * silu_f(r1)); w.y = pk2(o[vbi][2] * rstd * g[2] * silu_f(r2), o[vbi][3] * rstd * g[3] * silu_f(r3));
        *(u32x2*)(AO + trow * DM + 1024 + 256 * h + vcol) = w; }
    __syncthreads();
}

constexpr int AT_KB = 64 * 512, AT_VB = 128 * 144, AT_BUF = AT_KB + AT_VB;
constexpr float AT_THR = 8.0f;
__device__ __forceinline__ float xmax16(float m) { const auto r = __builtin_amdgcn_permlane16_swap(__float_as_uint(m), __float_as_uint(m), false, false); return fmaxf(__uint_as_float(r[0]), __uint_as_float(r[1])); }
__device__ __forceinline__ float xmax32(float m) { const auto r = __builtin_amdgcn_permlane32_swap(__float_as_uint(m), __float_as_uint(m), false, false); return fmaxf(__uint_as_float(r[0]), __uint_as_float(r[1])); }
#ifndef AT_SGB
#define AT_SGB 1
#endif
#ifndef AT_QK_AHEAD
#define AT_QK_AHEAD 4
#endif
#ifndef AT_PV_AHEAD
#define AT_PV_AHEAD 4
#endif
#ifndef AT_SCHED
#define AT_SCHED
#endif
__device__ __forceinline__ void attn_unit(const Params& P, LAS unsigned char* lds, int bh, int qb) {
    const int tid = opaque_tid(), lane = tid & 63, wid = __builtin_amdgcn_readfirstlane(tid >> 6), fr = lane & 15, fq = lane >> 4;
    const int b = bh >> 3, h = bh & 7; const size_t rowb = (size_t)b * SEQ; const int q0 = qb * 256 + wid * 32;
    const bf16_t* Q = (const bf16_t*)(P.ws + WS_Q); const bf16_t* KN = (const bf16_t*)(P.ws + WS_KN); const bf16_t* KR = (const bf16_t*)(P.ws + WS_KROPE); const bf16_t* VT = (const bf16_t*)(P.ws + WS_VT);
    bf16_t* AO = (bf16_t*)(P.ws + WS_XN);
    bf16x8 qf[6][2];
#pragma unroll
    for (int qk = 0; qk < 2; ++qk) { const bf16_t* qp = Q + (rowb + q0 + 16 * qk + fr) * QC;
#pragma unroll
        for (int ks = 0; ks < 4; ++ks) qf[ks][qk] = *(const bf16x8*)(qp + 128 * h + 32 * ks + 8 * fq);
        qf[4][qk] = *(const bf16x8*)(qp + 1024 + (h >> 2) * 256 + (h & 3) * 32 + 8 * fq); qf[5][qk] = *(const bf16x8*)(qp + 1024 + (h >> 2) * 256 + 128 + (h & 3) * 32 + 8 * fq); }
    const int NT = (qb + 1) * 4;
    const bf16_t* KNh = KN + rowb * 1024 + 128 * h; const bf16_t* KRb = KR + rowb * 64; const bf16_t* VTh = VT + (size_t)(128 * h) * M + rowb;
    const unsigned char* dsrc[7]; unsigned dstr[7];
#pragma unroll
    for (int j_ = 0; j_ < 7; ++j_) { const int c_ = wid + 8 * j_; const int L_ = 1024 * c_ + 16 * lane; const bf16_t* src_ = KNh; unsigned st_ = 0;
        if (L_ < AT_KB) { const int row_ = L_ >> 9, pp_ = (L_ & 511) >> 4; int pc_ = (pp_ & 16) | ((pp_ & 15) ^ (row_ & 15)); if (pc_ >= 24) pc_ = 0;
            if (pc_ < 16) { src_ = KNh + (size_t)row_ * 1024 + 8 * pc_; st_ = 64u * 1024u * 2u; } else { src_ = KRb + (size_t)row_ * 64 + 8 * (pc_ - 16); st_ = 64u * 64u * 2u; } }
        else if (c_ < 50) { const int L2_ = L_ - AT_KB, dv_ = L2_ / 144, cb_ = L2_ - dv_ * 144; int pc_ = cb_ >> 4; if (pc_ >= 8) pc_ = 0; src_ = VTh + (size_t)dv_ * M + 8 * pc_; st_ = 128u; }
        dsrc[j_] = (const unsigned char*)src_; dstr[j_] = st_; }
#define AT_DMA(t, buf) do { _Pragma("unroll") for (int j_ = 0; j_ < 7; ++j_) { const int c_ = wid + 8 * j_; if (c_ < 50) { \
            __builtin_amdgcn_global_load_lds((const unsigned*)dsrc[j_], (LAS unsigned*)(lds + (buf) * AT_BUF + 1024 * c_), 16, 0, 0); dsrc[j_] += dstr[j_]; } } } while (0)
    int kxo[4];
#pragma unroll
    for (int j = 0; j < 4; ++j) kxo[j] = fr * 512 + (((4 * j + fq) ^ fr) << 4);
    float mrow[2] = {0.f, 0.f}; f32x4 lacc[2] = {(f32x4){0.f, 0.f, 0.f, 0.f}, (f32x4){0.f, 0.f, 0.f, 0.f}};
    const bf16x8 ones = {16256, 16256, 16256, 16256, 16256, 16256, 16256, 16256};
    f32x4 o[8][2];
#pragma unroll
    for (int dvb = 0; dvb < 8; ++dvb) { o[dvb][0] = (f32x4){0.f, 0.f, 0.f, 0.f}; o[dvb][1] = (f32x4){0.f, 0.f, 0.f, 0.f}; }
    AT_DMA(0, 0);
    asm volatile("s_waitcnt vmcnt(0)" ::: "memory"); __syncthreads();
#pragma clang loop unroll(disable)
    for (int t = 0; t < NT; ++t) {
        const int buf = t & 1; const bool more = (t + 1 < NT);
        if (more) AT_DMA(t + 1, buf ^ 1);
        const LAS unsigned char* Kl = lds + buf * AT_BUF; const LAS unsigned char* Vl = Kl + AT_KB;
        const int k0 = 64 * t;
        if (k0 <= q0) {
#define AT_SB __builtin_amdgcn_sched_barrier(0)
#define AT_KLD(dst, ks_) do { _Pragma("unroll") for (int kvb = 0; kvb < 4; ++kvb) dst[kvb] = *(const LAS bf16x8*)(Kl + kxo[(ks_) & 3] + ((ks_) >> 2) * 256 + kvb * (16 * 512)); } while (0)
#define AT_VLD(dst, g_) do { _Pragma("unroll") for (int i_ = 0; i_ < 4; ++i_) { const LAS unsigned char* vp = Vl + (16 * (4 * ((g_) & 1) + i_) + fr) * 144 + (32 * ((g_) >> 1) + 4 * fq) * 2; \
            const u32x2 lo = *(const LAS u32x2*)vp, hi = *(const LAS u32x2*)(vp + 32); u32x4 w; w.x = lo.x; w.y = lo.y; w.z = hi.x; w.w = hi.y; dst[i_] = __builtin_bit_cast(bf16x8, w); } } while (0)
            bf16x8 kc[4], kn[4];
            AT_KLD(kc, 0);
            f32x4 s[4][2];
#pragma unroll
            for (int kvb = 0; kvb < 4; ++kvb) { s[kvb][0] = (f32x4){-mrow[0], -mrow[0], -mrow[0], -mrow[0]}; s[kvb][1] = (f32x4){-mrow[1], -mrow[1], -mrow[1], -mrow[1]}; }
#pragma unroll
            for (int ks = 0; ks < 6; ++ks) {
                if (ks < 5) AT_KLD(kn, ks + 1);
                AT_SB;
#pragma unroll
                for (int kvb = 0; kvb < 4; ++kvb) { s[kvb][0] = MFMA16(kc[kvb], qf[ks][0], s[kvb][0]); s[kvb][1] = MFMA16(kc[kvb], qf[ks][1], s[kvb][1]); }
                AT_SB;
                if (ks < 5) {
#pragma unroll
                    for (int kvb = 0; kvb < 4; ++kvb) kc[kvb] = kn[kvb]; }
            }
            bf16x8 vc[4], vn[4];
            AT_VLD(vc, 0);
            AT_SB;
            if (k0 + 63 > q0) {
#pragma unroll
                for (int kvb = 0; kvb < 4; ++kvb)
#pragma unroll
                    for (int qk = 0; qk < 2; ++qk)
#pragma unroll
                        for (int e = 0; e < 4; ++e) { const int kv = k0 + 16 * kvb + 4 * fq + e, q = q0 + 16 * qk + fr; if (kv > q) s[kvb][qk][e] = -INFINITY; }
            }
            float mx[2];
#pragma unroll
            for (int qk = 0; qk < 2; ++qk) { float m_ = fmaxf(fmaxf(s[0][qk][0], s[0][qk][1]), fmaxf(s[0][qk][2], s[0][qk][3]));
#pragma unroll
                for (int kvb = 1; kvb < 4; ++kvb) m_ = fmaxf(m_, fmaxf(fmaxf(s[kvb][qk][0], s[kvb][qk][1]), fmaxf(s[kvb][qk][2], s[kvb][qk][3])));
                m_ = xmax16(m_); m_ = xmax32(m_); mx[qk] = m_; }
            if (t == 0 || __any((mx[0] > AT_THR) || (mx[1] > AT_THR))) {
#pragma unroll
                for (int qk = 0; qk < 2; ++qk) { const float dl = (t == 0) ? mx[qk] : fmaxf(mx[qk], 0.f), alpha = __builtin_amdgcn_exp2f(-dl); mrow[qk] += dl; lacc[qk] *= alpha;
#pragma unroll
                    for (int kvb = 0; kvb < 4; ++kvb) s[kvb][qk] -= dl;
#pragma unroll
                    for (int dvb = 0; dvb < 8; ++dvb) o[dvb][qk] *= alpha; }
            }
            bf16x8 pf[2][2];
#pragma unroll
            for (int qk = 0; qk < 2; ++qk) {
#pragma unroll
                for (int kvb = 0; kvb < 4; ++kvb)
#pragma unroll
                    for (int e = 0; e < 4; ++e) s[kvb][qk][e] = __builtin_amdgcn_exp2f(s[kvb][qk][e]);
#pragma unroll
                for (int s2 = 0; s2 < 2; ++s2) { u32x4 w; w.x = pk2(s[2 * s2][qk][0], s[2 * s2][qk][1]); w.y = pk2(s[2 * s2][qk][2], s[2 * s2][qk][3]);
                    w.z = pk2(s[2 * s2 + 1][qk][0], s[2 * s2 + 1][qk][1]); w.w = pk2(s[2 * s2 + 1][qk][2], s[2 * s2 + 1][qk][3]); pf[s2][qk] = __builtin_bit_cast(bf16x8, w); } }
            AT_SB;
#pragma unroll
            for (int g = 0; g < 4; ++g) {
                if (g < 3) AT_VLD(vn, g + 1);
                AT_SB;
                if ((g & 1) == 0) { lacc[0] = MFMA16(ones, pf[g >> 1][0], lacc[0]); lacc[1] = MFMA16(ones, pf[g >> 1][1], lacc[1]); }
#pragma unroll
                for (int i = 0; i < 4; ++i) { const int dvb = 4 * (g & 1) + i; o[dvb][0] = MFMA16(vc[i], pf[g >> 1][0], o[dvb][0]); o[dvb][1] = MFMA16(vc[i], pf[g >> 1][1], o[dvb][1]); }
                AT_SB;
                if (g < 3) {
#pragma unroll
                    for (int i = 0; i < 4; ++i) vc[i] = vn[i]; }
            }
#undef AT_SB
#undef AT_KLD
#undef AT_VLD
        }
        asm volatile("s_waitcnt vmcnt(0)" ::: "memory"); __syncthreads();
    }
#pragma unroll
    for (int qk = 0; qk < 2; ++qk) { const float rl = 1.0f / lacc[qk][0];
        bf16_t* op = AO + (rowb + q0 + 16 * qk + fr) * DM + 128 * h + 4 * fq;
#pragma unroll
        for (int dvb = 0; dvb < 8; ++dvb) { u32x2 w; w.x = pk2(o[dvb][qk][0] * rl, o[dvb][qk][1] * rl); w.y = pk2(o[dvb][qk][2] * rl, o[dvb][qk][3] * rl); *(u32x2*)(op + 16 * dvb) = w; } }
#undef AT_DMA
}

#define GAS __attribute__((address_space(1)))
typedef GAS unsigned gu32;
typedef GAS unsigned long long gu64;
#define RLX_AGENT __ATOMIC_RELAXED, __HIP_MEMORY_SCOPE_AGENT
#define LDS_WAIT() asm volatile("s_waitcnt lgkmcnt(0)" ::: "memory")
#define VM_WAIT() asm volatile("s_waitcnt vmcnt(0)" ::: "memory")
__device__ __forceinline__ unsigned long long rt() { return __builtin_amdgcn_s_memrealtime(); }

#define XB_TMO      128
#define XB_XCNT(j)  (256  + 64 * (j))
#define XB_XSUB(j)  (1280 + 64 * (j))
#define XB_XGEN(j)  (2304 + 64 * (j))
#define XB_TOP      3328
#define XB_TOPGEN   3392
#define XCD_BAR_WORDS 3456
#define XB_SPIN_CAP (1u << 18)

__device__ __forceinline__ unsigned xb_ld(unsigned* p)              { return __hip_atomic_load(p, __ATOMIC_RELAXED, __HIP_MEMORY_SCOPE_AGENT); }
__device__ __forceinline__ unsigned xb_add(unsigned* p, unsigned v) { return __hip_atomic_fetch_add(p, v, __ATOMIC_RELAXED, __HIP_MEMORY_SCOPE_AGENT); }
__device__ __forceinline__ unsigned xb_xcc_id() { return (unsigned)__builtin_amdgcn_s_getreg((3 << 11) | 20) & 0xFu; }
#define XB_SPIN(cond, bar) do { unsigned _sp = 0; while (cond) { __builtin_amdgcn_s_sleep(1); \
    if ((++_sp & 255u) == 0u) { if (xb_ld(&(bar)[XB_TMO])) break; if (_sp > XB_SPIN_CAP) { atomicAdd(&(bar)[XB_TMO], 1u); break; } } } } while (0)

struct XcdBarrier {
    unsigned* bar; unsigned x;
    volatile LAS unsigned* st;
};

__device__ __forceinline__ XcdBarrier xcd_barrier_post(unsigned* bar, volatile LAS unsigned* st) {
    XcdBarrier b; b.bar = bar; b.x = xb_xcc_id(); b.st = st;
    if (threadIdx.x == 0) (void)xb_add(&bar[XB_XCNT(b.x)], 1u);
    return b;
}
__device__ __forceinline__ void xcd_barrier_complete(unsigned* bar, unsigned x, unsigned& nloc, unsigned& nx) {
    const unsigned G = gridDim.x * gridDim.y * gridDim.z;
    unsigned sum, cnt, mine, sp = 0u;
    for (;;) {
        sum = 0u; cnt = 0u; mine = 0u;
#pragma unroll
        for (unsigned j = 0; j < 16; ++j) { const unsigned c = xb_ld(&bar[XB_XCNT(j)]); sum += c; cnt += (c > 0u) ? 1u : 0u; mine = (j == x) ? c : mine; }
        if (sum == G) break;
        __builtin_amdgcn_s_sleep(1);
        if ((++sp & 255u) == 0u) { if (xb_ld(&bar[XB_TMO])) break; if (sp > XB_SPIN_CAP) { atomicAdd(&bar[XB_TMO], 1u); break; } }
    }
    nloc = mine > 0u ? mine : 1u; nx = cnt > 0u ? cnt : 1u;
}

__device__ __forceinline__ void xcd_barrier(const XcdBarrier& b) {
    asm volatile("s_waitcnt vmcnt(0)" ::: "memory");
    __syncthreads();
    if (threadIdx.x == 0) {
        unsigned* bar = b.bar;
        __builtin_amdgcn_s_waitcnt(0);
        unsigned nloc = b.st[0], nx = b.st[1];
        if (nloc == 0u) { xcd_barrier_complete(bar, b.x, nloc, nx); b.st[0] = nloc; b.st[1] = nx; }
        const unsigned old = xb_add(&bar[XB_XSUB(b.x)], 1u);
        const unsigned gen = old / nloc;
        if (old + 1u == (gen + 1u) * nloc) {
            __builtin_amdgcn_fence(__ATOMIC_RELEASE, "agent");
            asm volatile("s_waitcnt vmcnt(0)" ::: "memory");
            const unsigned og = xb_add(&bar[XB_TOP], 1u);
            const unsigned tg = og / nx;
            if (og + 1u == (tg + 1u) * nx) xb_add(&bar[XB_TOPGEN], 1u);
            else XB_SPIN(xb_ld(&bar[XB_TOPGEN]) == tg, bar);
            __builtin_amdgcn_fence(__ATOMIC_ACQUIRE, "agent");
            xb_add(&bar[XB_XGEN(b.x)], 1u);
            asm volatile("s_waitcnt vmcnt(0)" ::: "memory");
        } else {
            XB_SPIN(xb_ld(&bar[XB_XGEN(b.x)]) == gen, bar);
            __builtin_amdgcn_fence(__ATOMIC_ACQUIRE, "agent");
            asm volatile("s_waitcnt vmcnt(0)" ::: "memory");
        }
    }
    __syncthreads();
}


#ifndef PHASES
#define PHASES 0xFFFF
#endif
#define PH(k) ((PHASES >> (k)) & 1)
#ifndef REP_ATT
#define REP_ATT 1
#endif
#ifndef REP_P0
#define REP_P0 1
#endif
#ifndef REP_GLA
#define REP_GLA 1
#endif
#ifndef REP_A
#define REP_A 1
#endif
#ifndef REP_B
#define REP_B 1
#endif
#ifndef REP_C
#define REP_C 1
#endif
#ifndef REP_D
#define REP_D 1
#endif
#ifndef P2_SP2
#define P2_SP2 true
#endif
#ifndef P2_ALIGN
#define P2_ALIGN true
#endif
#ifndef P69_ALIGN
#define P69_ALIGN true
#endif
#ifndef P3_ALIGN
#define P3_ALIGN false
#endif
#ifndef P3_SP2
#define P3_SP2 true
#endif
#ifndef REP_P8
#define REP_P8 1
#endif
#ifndef REP_ROWS
#define REP_ROWS 1
#endif
#ifndef REP_SYNC
#define REP_SYNC 1
#endif
__global__ void __launch_bounds__(NTHREADS, 2) hybrid_block_fwd(Params P) {
    extern __shared__ __attribute__((aligned(16))) unsigned char lds_raw[];
    LAS unsigned char* lds = (LAS unsigned char*)lds_raw;
    cg::grid_group grid = cg::this_grid();
    volatile LAS unsigned* MISC = (volatile LAS unsigned*)(lds + MISC_OFF);
    if (threadIdx.x < 32) MISC[threadIdx.x] = 0u;
    __syncthreads();
    XcdBarrier bar = xcd_barrier_post((unsigned*)(P.ws + WS_CTL), MISC + 8);
#define GSYNC() xcd_barrier(bar)
    const int G = gridDim.x, bx = blockIdx.x;
    unsigned char* ws = P.ws;
    bf16_t* Zb = (bf16_t*)P.out;
    if (PH(0)) for (int rep = 0; rep < REP_P0; ++rep) p0_prologue(P, lds, G);
    if (P.out == nullptr) grid.sync();
    GSYNC();
    if (PH(1)) p1_rows(P, lds, G);
#if defined(DUP_A)
    __syncthreads(); p1_rows(P, lds, G);
#endif
    for (int rep = 0; rep < REP_SYNC; ++rep) GSYNC();
    if (PH(2)) { pg8::Gemm g{(const bf16_t*)(ws + WS_XN), (const bf16_t*)(ws + WS_WIN), M, ZC, DM, DM, DM}; pg8::StaticOrder S; S.init(M, ZC, G, bx);
      pg8::EpiPlain E{Zb, ZC}; pg8::gemm_phase<pg8::EpiPlain, pg8::StaticOrder, P2_ALIGN, P2_SP2>(lds, g, S, E); }
#if defined(DUP_P2)
    if (PH(2)) { pg8::Gemm g{(const bf16_t*)(ws + WS_XN), (const bf16_t*)(ws + WS_WIN), M, ZC, DM, DM, DM}; pg8::StaticOrder S; S.init(M, ZC, G, bx);
      pg8::EpiPlain E{Zb, ZC}; pg8::gemm_phase<pg8::EpiPlain, pg8::StaticOrder, P2_ALIGN, P2_SP2>(lds, g, S, E); }
#endif
    GSYNC();
    if (PH(3)) p2b_rows(P, G);
#if defined(DUP_A)
    p2b_rows(P, G);
#endif
    GSYNC();
    if (PH(4)) { pg8::Gemm g{(const bf16_t*)(ws + WS_CQN), (const bf16_t*)(ws + WS_WUQ), M, QC, 512, 512, 512}; pg8::StaticOrder S; S.init(M, QC, G, bx);
      pg8::EpiRowScaleRope E{(bf16_t*)(ws + WS_Q), QC, QSCALE, 4, (const float*)(ws + WS_CS)};
      pg8::gemm_phase<pg8::EpiRowScaleRope, pg8::StaticOrder, P3_ALIGN, P3_SP2>(lds, g, S, E); }
    if (PH(5)) { pg8::Gemm g{(const bf16_t*)(ws + WS_CKVN), (const bf16_t*)(ws + WS_WUK), M, 1024, 256, 256, 256}; pg8::StaticOrder S; S.init(M, 1024, G, bx);
      pg8::EpiPlain E{(bf16_t*)(ws + WS_KN), 1024}; pg8::gemm_phase<pg8::EpiPlain, pg8::StaticOrder, P3_ALIGN, P3_SP2>(lds, g, S, E); }
    if (PH(6)) { pg8::Gemm g{(const bf16_t*)(ws + WS_WUV), (const bf16_t*)(ws + WS_CKVN), 1024, M, 256, 256, 256}; pg8::StaticOrder S; S.init(1024, M, G, bx);
      pg8::EpiPlain E{(bf16_t*)(ws + WS_VT), M}; pg8::gemm_phase<pg8::EpiPlain, pg8::StaticOrder, P3_ALIGN, P3_SP2>(lds, g, S, E); }
#if defined(DUP_P3)
    if (PH(4)) { pg8::Gemm g{(const bf16_t*)(ws + WS_CQN), (const bf16_t*)(ws + WS_WUQ), M, QC, 512, 512, 512}; pg8::StaticOrder S; S.init(M, QC, G, bx);
      pg8::EpiRowScaleRope E{(bf16_t*)(ws + WS_Q), QC, QSCALE, 4, (const float*)(ws + WS_CS)};
      pg8::gemm_phase<pg8::EpiRowScaleRope, pg8::StaticOrder, true, true>(lds, g, S, E); }
    if (PH(5)) { pg8::Gemm g{(const bf16_t*)(ws + WS_CKVN), (const bf16_t*)(ws + WS_WUK), M, 1024, 256, 256, 256}; pg8::StaticOrder S; S.init(M, 1024, G, bx);
      pg8::EpiPlain E{(bf16_t*)(ws + WS_KN), 1024}; pg8::gemm_phase<pg8::EpiPlain, pg8::StaticOrder, true, true>(lds, g, S, E); }
    if (PH(6)) { pg8::Gemm g{(const bf16_t*)(ws + WS_WUV), (const bf16_t*)(ws + WS_CKVN), 1024, M, 256, 256, 256}; pg8::StaticOrder S; S.init(1024, M, G, bx);
      pg8::EpiPlain E{(bf16_t*)(ws + WS_VT), M}; pg8::gemm_phase<pg8::EpiPlain, pg8::StaticOrder, true, true>(lds, g, S, E); }
#endif
    if (PH(7)) for (int rep = 0; rep < REP_GLA; ++rep) for (int u = bx; u < 1024; u += G) gla_intra_unit(P, lds, u);
    GSYNC();
    if (PH(8)) for (int rep = 0; rep < REP_B; ++rep) gla_scan(P, G);
    GSYNC();
    if (PH(9)) for (int u = bx; u < 1024; u += G) gla_inter_unit(P, lds, u);
#if defined(DUP_C)
    for (int u = bx; u < 1024; u += G) gla_inter_unit(P, lds, u);
#endif
    if (PH(10)) { const int vcu = (G % 8 == 0) ? (bx % 8) * (G / 8) + bx / 8 : bx;
      for (int rep = 0; rep < REP_ATT; ++rep) for (int p2 = 2 * vcu; p2 < 512; p2 += 2 * G) {
#pragma clang loop unroll(disable)
          for (int i2 = 0; i2 < 2; ++i2) { const int p = p2 >> 1, bh = p >> 4, s = p & 15; attn_unit(P, lds, bh, i2 ? s : 31 - s); } } }
    GSYNC();
    if (PH(11)) { pg8::Gemm g{(const bf16_t*)(ws + WS_XN), (const bf16_t*)(ws + WS_WOUT), M, DM, DM, DM, DM}; pg8::StaticOrder S; S.init(M, DM, G, bx);
      pg8::EpiPlain E{(bf16_t*)(ws + WS_O), DM}; pg8::gemm_phase<pg8::EpiPlain, pg8::StaticOrder, P69_ALIGN, true>(lds, g, S, E); }
#if defined(DUP_P6)
    if (PH(11)) { pg8::Gemm g{(const bf16_t*)(ws + WS_XN), (const bf16_t*)(ws + WS_WOUT), M, DM, DM, DM, DM}; pg8::StaticOrder S; S.init(M, DM, G, bx);
      pg8::EpiPlain E{(bf16_t*)(ws + WS_O), DM}; pg8::gemm_phase<pg8::EpiPlain, pg8::StaticOrder, P69_ALIGN, true>(lds, g, S, E); }
#endif
    GSYNC();
    if (PH(12)) for (int rep = 0; rep < REP_D; ++rep) { p7_rows(P, lds, G); __syncthreads(); }
    GSYNC();
    if (PH(13)) { pg8::Gemm g{(const bf16_t*)(ws + WS_XN), (const bf16_t*)(ws + WS_WGU), M, 2 * DFF, DM, DM, DM}; pg8::StaticOrder S; S.init(M, 2 * DFF, G, bx);
      pg8::EpiSwiGLU E{(bf16_t*)(ws + WS_ACT), DFF}; pg8::gemm_phase<pg8::EpiSwiGLU, pg8::StaticOrder, true, true>(lds, g, S, E); }
#if defined(DUP_P8)
    if (PH(13)) { pg8::Gemm g{(const bf16_t*)(ws + WS_XN), (const bf16_t*)(ws + WS_WGU), M, 2 * DFF, DM, DM, DM}; pg8::StaticOrder S; S.init(M, 2 * DFF, G, bx);
      pg8::EpiSwiGLU E{(bf16_t*)(ws + WS_ACT), DFF}; pg8::gemm_phase<pg8::EpiSwiGLU, pg8::StaticOrder, true, true>(lds, g, S, E); }
#endif
    GSYNC();
    if (PH(14)) { pg8::Gemm g{(const bf16_t*)(ws + WS_ACT), (const bf16_t*)(ws + WS_WD), M, DM, DFF, DFF, DFF}; pg8::StaticOrder S; S.init(M, DM, G, bx);
      pg8::EpiPlain E{(bf16_t*)(ws + WS_O), DM}; pg8::gemm_phase<pg8::EpiPlain, pg8::StaticOrder, P69_ALIGN, true>(lds, g, S, E); }
#if defined(DUP_P9)
    if (PH(14)) { pg8::Gemm g{(const bf16_t*)(ws + WS_ACT), (const bf16_t*)(ws + WS_WD), M, DM, DFF, DFF, DFF}; pg8::StaticOrder S; S.init(M, DM, G, bx);
      pg8::EpiPlain E{(bf16_t*)(ws + WS_O), DM}; pg8::gemm_phase<pg8::EpiPlain, pg8::StaticOrder, P69_ALIGN, true>(lds, g, S, E); }
#endif
    GSYNC();
    if (PH(15)) for (int rep = 0; rep < REP_D; ++rep) { p10_rows(P, lds, G); __syncthreads(); }
}

extern "C" void kernel_launch(void* const* d_in, const int* in_sizes, int n_in, void* d_out, int out_size, void* d_ws, size_t ws_size, hipStream_t stream) {
    static int grid = 0;
    if (grid == 0) {
        if (n_in != 22 || in_sizes[0] != M * DM || out_size != M * DM || ws_size < WS_END) { fprintf(stderr, "kernel_launch: unexpected shapes (n_in %d, in0 %d, out %d, ws %zu)\n", n_in, n_in > 0 ? in_sizes[0] : -1, out_size, ws_size); grid = -1; return; }
        int dev = 0, cus = 0, per_cu = 0;
        (void)hipGetDevice(&dev); (void)hipDeviceGetAttribute(&cus, hipDeviceAttributeMultiprocessorCount, dev);
        if (hipFuncSetAttribute((const void*)hybrid_block_fwd, hipFuncAttributeMaxDynamicSharedMemorySize, LDS_BYTES) != hipSuccess) { fprintf(stderr, "kernel_launch: hipFuncSetAttribute failed\n"); grid = -1; return; }
        if (hipOccupancyMaxActiveBlocksPerMultiprocessor(&per_cu, (const void*)hybrid_block_fwd, NTHREADS, LDS_BYTES) != hipSuccess || per_cu < 1) { fprintf(stderr, "kernel_launch: occupancy query failed (%d)\n", per_cu); (void)hipGetLastError(); grid = -1; return; }
        grid = cus;
    }
    if (grid < 0) return;
    Params p{};
    const float* const* fin = (const float* const*)d_in;
    p.x = fin[0]; p.c = fin[1]; p.pos = (const int*)d_in[2]; p.w_ada = fin[3]; p.b_ada = fin[4]; p.g_pre_mix = fin[5]; p.g_post_mix = fin[6]; p.w_in = fin[7]; p.g_q = fin[8]; p.w_uq = fin[9];
    p.g_kv = fin[10]; p.w_uk = fin[11]; p.w_uv = fin[12]; p.w_gate_up = fin[13]; p.b_gate = fin[14]; p.g_gla = fin[15]; p.w_out = fin[16]; p.g_pre_ffn = fin[17]; p.g_post_ffn = fin[18];
    p.w_fg = fin[19]; p.w_fu = fin[20]; p.w_fd = fin[21]; p.out = (float*)d_out; p.ws = (unsigned char*)d_ws;
    if (hipMemsetAsync((char*)d_ws + WS_CTL, 0, CTL_BYTES, stream) != hipSuccess) { fprintf(stderr, "kernel_launch: memset failed\n"); return; }
    void* args[] = {&p};
    hipError_t e = hipLaunchCooperativeKernel((const void*)hybrid_block_fwd, dim3(grid), dim3(NTHREADS), args, LDS_BYTES, stream);
    if (e != hipSuccess) fprintf(stderr, "cooperative launch failed: %s (grid %d)\n", hipGetErrorString(e), grid);
}
```

```cpp
#define P3_SP2 false
#include <hip/hip_runtime.h>
#include <hip/hip_cooperative_groups.h>
#include <cstdio>
#include <cstdint>
#include <cmath>
namespace cg = cooperative_groups;
namespace pg8 {
#define PG8_LAS __attribute__((address_space(3)))
typedef unsigned short bf16_t;
typedef short bf16x8 __attribute__((ext_vector_type(8)));
typedef float f32x4 __attribute__((ext_vector_type(4)));
typedef unsigned u32x4 __attribute__((ext_vector_type(4)));
constexpr int BM = 256, BK = 64, HALF = 128, HTB = HALF * BK * 2  , STAGE_BYTES = 8 * HTB, NXCD = 8, WGM = 8;

__host__ __device__ __forceinline__ int lds_byte(int r, int c) { const int st = (r >> 4) * 2 + (c >> 5), rr = r & 15, cc = c & 31, ob = rr * 64 + cc * 2; return st * 1024 + (ob ^ (((ob >> 9) & 1) << 5)); }
__host__ __device__ __forceinline__ void stage_rc(int b, int& R, int& C) { const int st = b / 1024, sb = b % 1024, swz = sb ^ (((sb >> 9) & 1) << 5); R = (st >> 1) * 16 + swz / 64; C = (st & 1) * 32 + (swz % 64) / 2; }
__host__ __device__ __forceinline__ int perm32(int rho) { const int n = rho >> 4, i = rho & 15; return 8 * (i >> 2) + 4 * n + (i & 3); }

struct Unit { int pm, pn; };
struct Gemm { const bf16_t* A; const bf16_t* Bt; int M, N, K, lda, ldb; };

struct StaticOrder {
    int nM, nN, nwg, G, c;
    __host__ __device__ void init(int M, int N, int G_, int c_) { nM = M / BM; nN = N / BM; nwg = nM * nN; G = G_; c = c_; }
    __host__ __device__ bool next(int i, Unit& u) const {
        const long L = (long)i * G + c; if (L >= nwg) return false;
        int wgid = (int)L; { const int q = nwg / NXCD, r = nwg % NXCD, xcd = wgid % NXCD, off = wgid / NXCD; wgid = (xcd < r ? xcd * (q + 1) : r * (q + 1) + (xcd - r) * q) + off; }
        const int nig = WGM * nN, gid = wgid / nig, fm = gid * WGM, gsz = (nM - fm) < WGM ? (nM - fm) : WGM;
        u.pm = fm + ((wgid % nig) % gsz); u.pn = (wgid % nig) / gsz; return true;
    }
    __device__ __forceinline__ void a_ready(const Unit&) const {}
    __device__ __forceinline__ void done(const Unit&) const {}
};

__device__ __forceinline__ unsigned cvt_pk_bf16(float lo, float hi) { unsigned r; asm volatile("v_cvt_pk_bf16_f32 %0, %1, %2" : "=v"(r) : "v"(lo), "v"(hi)); return r; }
typedef float f32x2 __attribute__((ext_vector_type(2)));
template <class Epi, class Sched, bool ALIGN_EPI = false, bool SP2 = false>
__device__ __forceinline__ void gemm_phase(PG8_LAS unsigned char* lds, const Gemm g, const Sched& S, const Epi& E) {
    int tid_ = threadIdx.x; asm volatile("" : "+v"(tid_)); const int tid = tid_, wid = __builtin_amdgcn_readfirstlane(tid >> 6), lane = tid & 63, wr = wid >> 2, wc = wid & 3, fr = lane & 15, fq = lane >> 4;
    const int K = g.K, nt = K / BK;
    unsigned voffA[2], voffB[2];
#pragma unroll
    for (int i = 0; i < 2; ++i) { int R, C; stage_rc(tid * 16 + i * 8192, R, C); const int Rb = Epi::PERM ? ((R & ~31) + perm32(R & 31)) : R;
        voffA[i] = (unsigned)(R * g.lda + C) * 2u; voffB[i] = (unsigned)(Rb * g.ldb + C) * 2u; }
    const size_t kstep = (size_t)(BK * 2);
    const size_t hstepA = (size_t)HALF * g.lda * 2, hstepB = (size_t)HALF * g.ldb * 2;
    const size_t tstepA = 2 * hstepA, tstepB = 2 * hstepB;
    const unsigned ldsw = (unsigned)wid * 1024u;
    const int aoff = lds_byte(wr * 64 + fr, fq * 8), boff = lds_byte(wc * 32 + fr, fq * 8);
#define PG8_SA(b, h) (((b) * 2 + (h)) * HTB)
#define PG8_SB(b, h) ((4 + (b) * 2 + (h)) * HTB)
#define PG8_STAGE(bufoff, gbase, voff) do { _Pragma("unroll") for (int _i = 0; _i < 2; ++_i) \
        __builtin_amdgcn_global_load_lds((const unsigned*)((const char*)(gbase) + (voff)[_i]), (PG8_LAS unsigned*)(lds + (bufoff) + ldsw + _i * 8192), 16, 0, 0); } while (0)
#define PG8_LDA(dst, b, h) do { _Pragma("unroll") for (int m = 0; m < 4; ++m) _Pragma("unroll") for (int k = 0; k < 2; ++k) dst[m][k] = *(const PG8_LAS bf16x8*)(lds + PG8_SA(b, h) + aoff + m * 2048 + k * 1024); } while (0)
#define PG8_LDB(dst, b, h) do { _Pragma("unroll") for (int n = 0; n < 2; ++n) _Pragma("unroll") for (int k = 0; k < 2; ++k) dst[n][k] = *(const PG8_LAS bf16x8*)(lds + PG8_SB(b, h) + boff + n * 2048 + k * 1024); } while (0)
#define PG8_MMA(ai, bj, At, Bt) do { __builtin_amdgcn_s_setprio(1); _Pragma("unroll") for (int m = 0; m < 4; ++m) _Pragma("unroll") for (int n = 0; n < 2; ++n) _Pragma("unroll") for (int k = 0; k < 2; ++k) \
        acc[ai][bj][m][n] = __builtin_amdgcn_mfma_f32_16x16x32_bf16(Bt[n][k], At[m][k], acc[ai][bj][m][n], 0, 0, 0); __builtin_amdgcn_s_setprio(0); } while (0)
#define PG8_WAIT_V(n) asm volatile("s_waitcnt vmcnt(" #n ")" ::: "memory")
#define PG8_WAIT_L(n) asm volatile("s_waitcnt lgkmcnt(" #n ")" ::: "memory")
#define PG8_BAR __builtin_amdgcn_s_barrier()
#define PG8_SCHED __builtin_amdgcn_sched_barrier(0)
    Unit cur, nxt; int ui = 0;
    if (!S.next(0, cur)) return;
    f32x4 acc[2][2][4][2];
#pragma unroll
    for (int a = 0; a < 2; ++a)
#pragma unroll
        for (int b = 0; b < 2; ++b)
#pragma unroll
            for (int m = 0; m < 4; ++m)
#pragma unroll
                for (int n = 0; n < 2; ++n) acc[a][b][m][n] = (f32x4){0.f, 0.f, 0.f, 0.f};
    bf16x8 At[4][2], B0[2][2], B1[2][2];
    const char* cA = (const char*)g.A + (size_t)cur.pm * tstepA; const char* cB = (const char*)g.Bt + (size_t)cur.pn * tstepB;
    S.a_ready(cur);
    if constexpr (SP2) {
        PG8_STAGE(PG8_SB(0, 0), cB, voffB); PG8_STAGE(PG8_SB(0, 1), cB + hstepB, voffB); PG8_STAGE(PG8_SA(0, 0), cA, voffA); PG8_STAGE(PG8_SA(0, 1), cA + hstepA, voffA);
        if (wr == 1) PG8_BAR;
        PG8_WAIT_V(2); PG8_BAR;
        PG8_STAGE(PG8_SB(1, 0), cB + kstep, voffB); PG8_STAGE(PG8_SA(1, 0), cA + kstep, voffA); PG8_STAGE(PG8_SB(1, 1), cB + hstepB + kstep, voffB);
        PG8_WAIT_V(6); PG8_BAR;
    } else {
        PG8_STAGE(PG8_SB(0, 0), cB, voffB); PG8_STAGE(PG8_SA(0, 0), cA, voffA); PG8_STAGE(PG8_SB(0, 1), cB + hstepB, voffB); PG8_STAGE(PG8_SA(0, 1), cA + hstepA, voffA);
        if (wr == 1) PG8_BAR;
        PG8_WAIT_V(4); PG8_BAR;
        PG8_STAGE(PG8_SB(1, 0), cB + kstep, voffB); PG8_STAGE(PG8_SA(1, 0), cA + kstep, voffA); PG8_STAGE(PG8_SB(1, 1), cB + hstepB + kstep, voffB);
        PG8_WAIT_V(6); PG8_BAR;
    }
    for (;;) {
        const bool has_next = S.next(ui + 1, nxt);
        const char* nA = has_next ? (const char*)g.A + (size_t)nxt.pm * tstepA : cA; const char* nB = has_next ? (const char*)g.Bt + (size_t)nxt.pn * tstepB : cB;
        for (int t = 0; t < nt; t += 2) {
            const bool last = (t == nt - 2);
            const char* a1 = cA + (size_t)(t + 1) * kstep;
            const char* a2 = last ? nA : cA + (size_t)(t + 2) * kstep; const char* b2 = last ? nB : cB + (size_t)(t + 2) * kstep;
            const char* a3 = a2 + kstep; const char* b3 = b2 + kstep;
            if (last && has_next) S.a_ready(nxt);
            if constexpr (SP2) {
            PG8_LDB(B0, 0, 0); PG8_LDB(B1, 0, 1); PG8_SCHED; PG8_LDA(At, 0, 0); PG8_STAGE(PG8_SA(1, 1), a1 + hstepA, voffA);
            PG8_WAIT_V(8); PG8_WAIT_L(0); PG8_BAR; PG8_MMA(0, 0, At, B0); PG8_MMA(0, 1, At, B1); PG8_BAR; PG8_SCHED;
            PG8_LDA(At, 0, 1); PG8_STAGE(PG8_SB(0, 0), b2, voffB); PG8_STAGE(PG8_SB(0, 1), b2 + hstepB, voffB); PG8_STAGE(PG8_SA(0, 0), a2, voffA);
            PG8_WAIT_V(8); PG8_WAIT_L(0); PG8_BAR; PG8_MMA(1, 0, At, B0); PG8_MMA(1, 1, At, B1); PG8_BAR; PG8_SCHED;
            PG8_LDB(B0, 1, 0); PG8_LDB(B1, 1, 1); PG8_SCHED; PG8_LDA(At, 1, 0); PG8_STAGE(PG8_SA(0, 1), a2 + hstepA, voffA);
            PG8_WAIT_V(8); PG8_WAIT_L(0); PG8_BAR; PG8_MMA(0, 0, At, B0); PG8_MMA(0, 1, At, B1); PG8_BAR; PG8_SCHED;
            PG8_LDA(At, 1, 1); PG8_STAGE(PG8_SB(1, 0), b3, voffB); PG8_STAGE(PG8_SB(1, 1), b3 + hstepB, voffB); PG8_STAGE(PG8_SA(1, 0), a3, voffA);
            PG8_WAIT_V(8); PG8_WAIT_L(0); PG8_BAR; PG8_MMA(1, 0, At, B0); PG8_MMA(1, 1, At, B1); PG8_BAR; PG8_SCHED;
            } else {
            PG8_LDB(B0, 0, 0); PG8_SCHED; PG8_LDA(At, 0, 0); PG8_STAGE(PG8_SA(1, 1), a1 + hstepA, voffA);
            PG8_WAIT_L(8); PG8_BAR; PG8_WAIT_L(0); PG8_MMA(0, 0, At, B0); PG8_BAR; PG8_SCHED;
            PG8_LDB(B1, 0, 1); PG8_STAGE(PG8_SB(0, 0), b2, voffB);
            PG8_BAR; PG8_WAIT_L(0); PG8_MMA(0, 1, At, B1); PG8_BAR;
            PG8_LDA(At, 0, 1); PG8_STAGE(PG8_SA(0, 0), a2, voffA);
            PG8_BAR; PG8_WAIT_L(0); PG8_MMA(1, 0, At, B0); PG8_BAR; PG8_SCHED;
            PG8_STAGE(PG8_SB(0, 1), b2 + hstepB, voffB);
            PG8_WAIT_V(6); PG8_BAR; PG8_MMA(1, 1, At, B1); PG8_BAR;
            PG8_LDB(B0, 1, 0); PG8_SCHED; PG8_LDA(At, 1, 0); PG8_STAGE(PG8_SA(0, 1), a2 + hstepA, voffA);
            PG8_WAIT_L(8); PG8_BAR; PG8_WAIT_L(0); PG8_MMA(0, 0, At, B0); PG8_BAR; PG8_SCHED;
            PG8_LDB(B1, 1, 1); PG8_STAGE(PG8_SB(1, 0), b3, voffB);
            PG8_BAR; PG8_WAIT_L(0); PG8_MMA(0, 1, At, B1); PG8_BAR;
            PG8_LDA(At, 1, 1); PG8_STAGE(PG8_SA(1, 0), a3, voffA);
            PG8_BAR; PG8_WAIT_L(0); PG8_MMA(1, 0, At, B0); PG8_BAR; PG8_SCHED;
            PG8_STAGE(PG8_SB(1, 1), b3 + hstepB, voffB);
            PG8_WAIT_V(6); PG8_BAR; PG8_MMA(1, 1, At, B1); PG8_BAR;
            }
        }
        if constexpr (ALIGN_EPI) { if (wr == 0) PG8_BAR; }
        if constexpr (!Epi::AFTER_DRAIN) { E(acc, cur, wr, wc, fr, fq); S.done(cur); }
        if (!has_next) break;
#pragma unroll
        for (int a = 0; a < 2; ++a)
#pragma unroll
            for (int b = 0; b < 2; ++b)
#pragma unroll
                for (int m = 0; m < 4; ++m)
#pragma unroll
                    for (int n = 0; n < 2; ++n) acc[a][b][m][n] = (f32x4){0.f, 0.f, 0.f, 0.f};
        cur = nxt; cA = nA; cB = nB; ++ui;
        if constexpr (ALIGN_EPI) { if (wr == 1) PG8_BAR; }
    }
    PG8_WAIT_V(0);
    if constexpr (!ALIGN_EPI) { if (wr == 0) PG8_BAR; }
    PG8_BAR;
    if constexpr (Epi::AFTER_DRAIN) { E.fused(acc, cur, wr, wc, fr, fq, lds, wid, lane); S.done(cur); }
#undef PG8_SA
#undef PG8_SB
#undef PG8_STAGE
#undef PG8_LDA
#undef PG8_LDB
#undef PG8_MMA
#undef PG8_WAIT_V
#undef PG8_WAIT_L
#undef PG8_BAR
#undef PG8_SCHED
}
}
namespace pg8 {
__device__ __forceinline__ unsigned cvtpk(float lo, float hi) { typedef float f2_t __attribute__((ext_vector_type(2))); typedef __bf16 b2_t __attribute__((ext_vector_type(2))); f2_t v = {lo, hi}; b2_t b = __builtin_convertvector(v, b2_t); return __builtin_bit_cast(unsigned, b); }
__device__ __forceinline__ u32x4 pack8(const f32x4& v0, const f32x4& v1) { u32x4 w; w.x = cvtpk(v0[0], v0[1]); w.y = cvtpk(v0[2], v0[3]); w.z = cvtpk(v1[0], v1[1]); w.w = cvtpk(v1[2], v1[3]); return w; }
struct EpiPlain {
    static constexpr bool PERM = true, AFTER_DRAIN = false;
    bf16_t* O; int ldc;
    __device__ __forceinline__ void operator()(const f32x4 (&acc)[2][2][4][2], const Unit& u, int wr, int wc, int fr, int fq) const {
        const int row0 = u.pm * BM + wr * 64 + fr, col0 = u.pn * BM + wc * 32 + 8 * fq;
#pragma unroll
        for (int ai = 0; ai < 2; ++ai)
#pragma unroll
            for (int m = 0; m < 4; ++m) { bf16_t* rowp = O + (size_t)(row0 + ai * HALF + m * 16) * ldc + col0;
#pragma unroll
                for (int bj = 0; bj < 2; ++bj) *(u32x4*)(rowp + bj * HALF) = pack8(acc[ai][bj][m][0], acc[ai][bj][m][1]); }
    }
};
struct EpiRowScaleRope {
    static constexpr bool PERM = true, AFTER_DRAIN = false;
    bf16_t* O; int ldc; float mult; int rope_pn0; const float* cs;
    __device__ __forceinline__ void operator()(const f32x4 (&acc)[2][2][4][2], const Unit& u, int wr, int wc, int fr, int fq) const {
        const int row0 = u.pm * BM + wr * 64 + fr, col0 = u.pn * BM + wc * 32 + 8 * fq;
        const bool rope = u.pn >= rope_pn0;
#pragma unroll
        for (int ai = 0; ai < 2; ++ai)
#pragma unroll
            for (int m = 0; m < 4; ++m) { const int row = row0 + ai * HALF + m * 16; const float s = mult;
                f32x4 a0 = acc[ai][0][m][0] * s, a1 = acc[ai][0][m][1] * s, b0 = acc[ai][1][m][0] * s, b1 = acc[ai][1][m][1] * s;
                if (rope) { const f32x4* cp = (const f32x4*)(cs + (size_t)row * 64 + 16 * fq);
                    const f32x4 c0 = cp[0], c1 = cp[1], c2 = cp[2], c3 = cp[3];
                    f32x4 x0, x1, y0, y1;
                    x0[0] = a0[0] * c0[0] - b0[0] * c0[1]; y0[0] = b0[0] * c0[0] + a0[0] * c0[1];
                    x0[1] = a0[1] * c0[2] - b0[1] * c0[3]; y0[1] = b0[1] * c0[2] + a0[1] * c0[3];
                    x0[2] = a0[2] * c1[0] - b0[2] * c1[1]; y0[2] = b0[2] * c1[0] + a0[2] * c1[1];
                    x0[3] = a0[3] * c1[2] - b0[3] * c1[3]; y0[3] = b0[3] * c1[2] + a0[3] * c1[3];
                    x1[0] = a1[0] * c2[0] - b1[0] * c2[1]; y1[0] = b1[0] * c2[0] + a1[0] * c2[1];
                    x1[1] = a1[1] * c2[2] - b1[1] * c2[3]; y1[1] = b1[1] * c2[2] + a1[1] * c2[3];
                    x1[2] = a1[2] * c3[0] - b1[2] * c3[1]; y1[2] = b1[2] * c3[0] + a1[2] * c3[1];
                    x1[3] = a1[3] * c3[2] - b1[3] * c3[3]; y1[3] = b1[3] * c3[2] + a1[3] * c3[3];
                    a0 = x0; a1 = x1; b0 = y0; b1 = y1; }
                bf16_t* rowp = O + (size_t)row * ldc + col0;
                *(u32x4*)(rowp) = pack8(a0, a1); *(u32x4*)(rowp + HALF) = pack8(b0, b1); }
    }
};
struct EpiColScale {
    static constexpr bool PERM = true, AFTER_DRAIN = false;
    bf16_t* O; int ldc; const float* cscale;
    __device__ __forceinline__ void operator()(const f32x4 (&acc)[2][2][4][2], const Unit& u, int wr, int wc, int fr, int fq) const {
        const int row0 = u.pm * BM + wr * 64 + fr, col0 = u.pn * BM + wc * 32 + 8 * fq;
#pragma unroll
        for (int bj = 0; bj < 2; ++bj) { const f32x4 s0 = *(const f32x4*)(cscale + col0 + bj * HALF), s1 = *(const f32x4*)(cscale + col0 + bj * HALF + 4);
#pragma unroll
            for (int ai = 0; ai < 2; ++ai)
#pragma unroll
                for (int m = 0; m < 4; ++m) *(u32x4*)(O + (size_t)(row0 + ai * HALF + m * 16) * ldc + col0 + bj * HALF) = pack8(acc[ai][bj][m][0] * s0, acc[ai][bj][m][1] * s1);
            asm volatile("" ::: "memory"); }
    }
};
struct EpiSwiGLU {
    static constexpr bool PERM = true, AFTER_DRAIN = false;
    bf16_t* O; int ldc;
    __device__ __forceinline__ void operator()(const f32x4 (&acc)[2][2][4][2], const Unit& u, int wr, int wc, int fr, int fq) const {
        const int row0 = u.pm * BM + wr * 64 + fr, col0 = u.pn * HALF + wc * 32 + 8 * fq;
#pragma unroll
        for (int ai = 0; ai < 2; ++ai)
#pragma unroll
            for (int m = 0; m < 4; ++m) { f32x4 r[2];
#pragma unroll
                for (int n = 0; n < 2; ++n) { const f32x4 g = acc[ai][0][m][n], up = acc[ai][1][m][n];
#pragma unroll
                    for (int e = 0; e < 4; ++e) r[n][e] = g[e] * __builtin_amdgcn_rcpf(1.0f + __expf(-g[e])) * up[e]; }
                *(u32x4*)(O + (size_t)(row0 + ai * HALF + m * 16) * ldc + col0) = pack8(r[0], r[1]); }
    }
};
}
#define LAS __attribute__((address_space(3)))
typedef unsigned short bf16_t;
typedef short bf16x8 __attribute__((ext_vector_type(8)));
typedef float f32x4 __attribute__((ext_vector_type(4)));
typedef unsigned u32x4 __attribute__((ext_vector_type(4)));
typedef unsigned u32x2 __attribute__((ext_vector_type(2)));
constexpr int BATCH = 2, SEQ = 8192, DM = 2048, M = BATCH * SEQ, DFF = 5632, NADA = 6 * DM;
constexpr int ZC = 4096;
constexpr int ZO_CQ = 0, ZO_CKV = 512, ZO_QG = 768, ZO_KG = 1280, ZO_VG = 1792, ZO_RG = 2816, ZO_KR = 3840, ZO_AG = 3904;
constexpr int QC = 1536;
constexpr float RMS_EPS = 1e-6f;
constexpr float QSCALE = 0.07216878364870323f * 1.4426950408889634f;
constexpr int KS_ADA = 16;
constexpr size_t MiB = 1u << 20;
constexpr size_t WS_ADAP = 0, WS_ADA = 1536 * 1024, WS_RSTDQ = 1792 * 1024, WS_RSTDKV = 1856 * 1024, WS_DECAY = 2 * MiB, WS_CS = 3 * MiB, WS_KROPE = 7 * MiB;
constexpr size_t WS_WIN = 10 * MiB, WS_WUQ = 26 * MiB, WS_WUK = 28 * MiB, WS_WUV = 29 * MiB, WS_WOUT = 30 * MiB, WS_WGU = 38 * MiB, WS_WD = 82 * MiB;
constexpr size_t WS_XN = 104 * MiB;
constexpr size_t WS_Q = 168 * MiB, WS_KN = 216 * MiB, WS_VT = 248 * MiB, WS_QDEC = 280 * MiB, WS_OI = 296 * MiB, WS_ST = 328 * MiB;
constexpr size_t WS_O = 168 * MiB;
constexpr size_t WS_ACT = 232 * MiB, WS_CQN = 392 * MiB, WS_CKVN = 408 * MiB, WS_X1 = 416 * MiB, WS_END = 480 * MiB;
constexpr size_t WS_CTL = 9 * MiB, CTL_BYTES = 65536;
constexpr int NTHREADS = 512, LDS_BYTES = 147456, MISC_OFF = 131072 + 320;

__device__ const double INVF_REV[32] = {
    1.59154943091895346e-01,
    1.19349370211248862e-01,
    8.94994016088910133e-02,
    6.71150830052272551e-02,
    5.03292121044870353e-02,
    3.77415847174197711e-02,
    2.83021958306233987e-02,
    2.12236527647776604e-02,
    1.59154943091895339e-02,
    1.19349370211248862e-02,
    8.94994016088910237e-03,
    6.71150830052272534e-03,
    5.03292121044870370e-03,
    3.77415847174197719e-03,
    2.83021958306233987e-03,
    2.12236527647776622e-03,
    1.59154943091895356e-03,
    1.19349370211248849e-03,
    8.94994016088910237e-04,
    6.71150830052272599e-04,
    5.03292121044870326e-04,
    3.77415847174197741e-04,
    2.83021958306233954e-04,
    2.12236527647776605e-04,
    1.59154943091895351e-04,
    1.19349370211248862e-04,
    8.94994016088910182e-05,
    6.71150830052272545e-05,
    5.03292121044870354e-05,
    3.77415847174197768e-05,
    2.83021958306233961e-05,
    2.12236527647776592e-05

};

struct Params {
    const float *x, *c; const int* pos; const float *w_ada, *b_ada, *g_pre_mix, *g_post_mix, *w_in, *g_q, *w_uq, *g_kv, *w_uk, *w_uv, *w_gate_up, *b_gate, *g_gla, *w_out, *g_pre_ffn, *g_post_ffn, *w_fg, *w_fu, *w_fd;
    float* out; unsigned char* ws;
};

__device__ __forceinline__ int opaque_tid() { int t = threadIdx.x; asm volatile("" : "+v"(t)); return t; }
__device__ __forceinline__ float bf2f(unsigned short u) { return __uint_as_float((unsigned)u << 16); }
__device__ __forceinline__ unsigned short f2bf(float f) { unsigned u = __float_as_uint(f); return (unsigned short)((u + 0x7fffu + ((u >> 16) & 1u)) >> 16); }
__device__ __forceinline__ unsigned pk2(float lo, float hi) { return pg8::cvtpk(lo, hi); }
__device__ __forceinline__ float xsum16(float v) { const auto r = __builtin_amdgcn_permlane16_swap(__float_as_uint(v), __float_as_uint(v), false, false); return __uint_as_float(r[0]) + __uint_as_float(r[1]); }
__device__ __forceinline__ float xsum32(float v) { const auto r = __builtin_amdgcn_permlane32_swap(__float_as_uint(v), __float_as_uint(v), false, false); return __uint_as_float(r[0]) + __uint_as_float(r[1]); }
template <int CTRL> __device__ __forceinline__ float dpp_add(float v) { const int x = __float_as_int(v); return v + __int_as_float(__builtin_amdgcn_update_dpp(x, x, CTRL, 0xF, 0xF, false)); }
__device__ __forceinline__ float wave_sum(float v) {
    v = dpp_add<0xB1>(v); v = dpp_add<0x4E>(v); v = dpp_add<0x141>(v); v = dpp_add<0x140>(v);
    return xsum32(xsum16(v));
}
__device__ __forceinline__ float silu_f(float v) { return v * __builtin_amdgcn_rcpf(1.0f + __expf(-v)); }
#define MFMA16(a, b, c) __builtin_amdgcn_mfma_f32_16x16x32_bf16((a), (b), (c), 0, 0, 0)

struct MapIn { const float* W;
    __device__ __forceinline__ const float* col(int n, int& ld) const { ld = 3920; int s;
        if (n < 768) s = n; else if (n < 1280) s = 832 + (n - 768); else if (n < 1792) s = 1344 + (n - 1280); else if (n < 2816) s = 1856 + (n - 1792);
        else if (n < 3840) s = 2896 + (n - 2816); else if (n < 3904) s = 768 + (n - 3840); else if (n < 3920) s = 2880 + (n - 3904); else return nullptr;
        return W + s; } };
struct MapUq { const float* W;
    __device__ __forceinline__ const float* col(int n, int& ld) const { ld = 1536; int s;
        if (n < 1024) s = (n >> 7) * 192 + (n & 127);
        else { const int mm = n - 1024, tile = mm >> 8, w = mm & 255, half = w >> 7, hh = (w & 127) >> 5, i = w & 31; s = (tile * 4 + hh) * 192 + 128 + half * 32 + i; }
        return W + s; } };
struct MapId { const float* W; int ldw;
    __device__ __forceinline__ const float* col(int n, int& ld) const { ld = ldw; return W + n; } };
struct MapGU { const float* Wg; const float* Wu;
    __device__ __forceinline__ const float* col(int n, int& ld) const { ld = DFF; const int tile = n >> 8, w = n & 255; return (w < 128) ? (Wg + tile * 128 + w) : (Wu + tile * 128 + (w - 128)); } };
template <class Map>
__device__ __forceinline__ void transpose_item(const Map& mp, const float* gain, int K, bf16_t* WT, int item, int nblk, int lane, bool late = false) {
    const int kb = item / nblk, nb = item % nblk, k0 = 64 * kb, n0 = 64 * nb, kq = lane >> 4, nc = lane & 15;
    int ld; const float* src = mp.col(n0 + 4 * nc, ld);
    f32x4 v[16];
    if (src) { src += (size_t)(k0 + 16 * kq) * ld;
#pragma unroll
        for (int i = 0; i < 16; ++i) v[i] = __builtin_nontemporal_load((const f32x4*)(src + (size_t)i * ld));
    } else {
#pragma unroll
        for (int i = 0; i < 16; ++i) v[i] = (f32x4){0.f, 0.f, 0.f, 0.f};
    }
    if (gain) {
#pragma unroll
        for (int i = 0; i < 16; ++i) v[i] *= gain[k0 + 16 * kq + i];
    }
#pragma unroll
    for (int e = 0; e < 4; ++e) { bf16_t* dst = WT + (size_t)(n0 + 4 * nc + e) * K + k0 + 16 * kq;
        u32x4 w0, w1; w0.x = pk2(v[0][e], v[1][e]); w0.y = pk2(v[2][e], v[3][e]); w0.z = pk2(v[4][e], v[5][e]); w0.w = pk2(v[6][e], v[7][e]);
        w1.x = pk2(v[8][e], v[9][e]); w1.y = pk2(v[10][e], v[11][e]); w1.z = pk2(v[12][e], v[13][e]); w1.w = pk2(v[14][e], v[15][e]);
        if (late) { __builtin_nontemporal_store(w0, (u32x4*)dst); __builtin_nontemporal_store(w1, (u32x4*)(dst + 8)); }
        else { *(u32x4*)dst = w0; *(u32x4*)(dst + 8) = w1; } }
}

__device__ __forceinline__ void p0_prologue(const Params& P, LAS unsigned char* lds, int G) {
    const int tid = opaque_tid(), lane = tid & 63, wave = tid >> 6;
    unsigned char* ws = P.ws;
    const int gw = wave * G + blockIdx.x, NGW = G * 8;
    float* adap = (float*)(ws + WS_ADAP);
    for (int it = gw; it < 48 * KS_ADA; it += NGW) {
        const int nc = it % 48, ks = it / 48, n0 = nc * 256 + lane * 4;
        f32x4 a0 = {0.f, 0.f, 0.f, 0.f}, a1 = {0.f, 0.f, 0.f, 0.f};
#pragma unroll 16
        for (int kk = 0; kk < 128; ++kk) { const int k = ks * 128 + kk; const f32x4 w = __builtin_nontemporal_load((const f32x4*)(P.w_ada + (size_t)k * NADA + n0));
            const float s0 = silu_f(P.c[k]), s1 = silu_f(P.c[DM + k]); a0 += w * s0; a1 += w * s1; }
        *(f32x4*)(adap + (size_t)(ks * 2 + 0) * NADA + n0) = a0; *(f32x4*)(adap + (size_t)(ks * 2 + 1) * NADA + n0) = a1;
    }
    constexpr int I_IN = 32 * 64, I_UQ = 8 * 24, I_UK = 4 * 16, I_UV = 4 * 16, I_OUT = 32 * 32, I_GU = 32 * 176, I_D = 88 * 32;
    constexpr int NITEMS = I_IN + I_UQ + I_UK + I_UV + I_OUT + I_GU + I_D;
    for (int it = gw; it < NITEMS; it += NGW) {
        int r = it;
        if (r < I_IN) { transpose_item(MapIn{P.w_in}, nullptr, 2048, (bf16_t*)(ws + WS_WIN), r, 64, lane); continue; } r -= I_IN;
        if (r < I_UQ) { transpose_item(MapUq{P.w_uq}, P.g_q, 512, (bf16_t*)(ws + WS_WUQ), r, 24, lane); continue; } r -= I_UQ;
        if (r < I_UK) { transpose_item(MapId{P.w_uk, 1024}, P.g_kv, 256, (bf16_t*)(ws + WS_WUK), r, 16, lane); continue; } r -= I_UK;
        if (r < I_UV) { transpose_item(MapId{P.w_uv, 1024}, P.g_kv, 256, (bf16_t*)(ws + WS_WUV), r, 16, lane); continue; } r -= I_UV;
        if (r < I_OUT) { transpose_item(MapId{P.w_out, 2048}, nullptr, 2048, (bf16_t*)(ws + WS_WOUT), r, 32, lane, true); continue; } r -= I_OUT;
        if (r < I_GU) { transpose_item(MapGU{P.w_fg, P.w_fu}, nullptr, 2048, (bf16_t*)(ws + WS_WGU), r, 176, lane, true); continue; } r -= I_GU;
        transpose_item(MapId{P.w_fd, 2048}, nullptr, DFF, (bf16_t*)(ws + WS_WD), r, 32, lane, true);
    }
    float* cs = (float*)(ws + WS_CS);
    for (int idx = blockIdx.x * NTHREADS + tid; idx < M * 32; idx += G * NTHREADS) {
        const int m = idx >> 5, i = idx & 31; const double rev = (double)P.pos[m] * INVF_REV[i]; const float fr = (float)(rev - floor(rev));
        cs[2 * idx] = __builtin_amdgcn_cosf(fr); cs[2 * idx + 1] = __builtin_amdgcn_sinf(fr);
    }
}

__device__ __forceinline__ void p1_rows(const Params& P, LAS unsigned char* lds, int G) {
    const int tid = opaque_tid(), lane = tid & 63, wave = tid >> 6;
    const float* adap = (const float*)(P.ws + WS_ADAP); float* ada = (float*)(P.ws + WS_ADA);
    LAS float* TA = (LAS float*)lds;
    LAS float* TC = TA + 2 * DM;
    for (int idx = tid; idx < 2 * DM; idx += NTHREADS) { const int b = idx >> 11, col = idx & (DM - 1);
        float sh = P.b_ada[col], sc = P.b_ada[DM + col];
        for (int ks = 0; ks < KS_ADA; ++ks) { sh += adap[(size_t)(ks * 2 + b) * NADA + col]; sc += adap[(size_t)(ks * 2 + b) * NADA + DM + col]; }
        TA[idx] = P.g_pre_mix[col] * (1.0f + sc); TC[idx] = sh; }
    for (int idx = blockIdx.x * NTHREADS + tid; idx < 2 * NADA; idx += G * NTHREADS) { const int b = idx / NADA, n = idx % NADA; float v = P.b_ada[n];
        for (int ks = 0; ks < KS_ADA; ++ks) v += adap[(size_t)(ks * 2 + b) * NADA + n];
        ada[idx] = v; }
    __syncthreads();
    bf16_t* XN = (bf16_t*)(P.ws + WS_XN);
    for (int m = blockIdx.x * 8 + wave; m < M; m += G * 8) {
        const int b = m >> 13; const f32x4* xr = (const f32x4*)(P.x + (size_t)m * DM) + lane;
        f32x4 v[8]; float ss = 0.f;
#pragma unroll
        for (int j = 0; j < 8; ++j) { v[j] = __builtin_nontemporal_load(xr + 64 * j); ss += (v[j][0] * v[j][0] + v[j][1] * v[j][1]) + (v[j][2] * v[j][2] + v[j][3] * v[j][3]); }
        const float rstd = rsqrtf(wave_sum(ss) * (1.0f / DM) + RMS_EPS);
        u32x2* o = (u32x2*)(XN + (size_t)m * DM) + lane;
#pragma unroll
        for (int j = 0; j < 8; ++j) { const f32x4 a = *(const LAS f32x4*)(TA + b * DM + 256 * j + 4 * lane), c = *(const LAS f32x4*)(TC + b * DM + 256 * j + 4 * lane);
            const f32x4 h = v[j] * rstd * a + c; u32x2 w; w.x = pk2(h[0], h[1]); w.y = pk2(h[2], h[3]); o[64 * j] = w; }
    }
}
__device__ __forceinline__ void p2b_rows(const Params& P, int G) {
    const int tid = opaque_tid(), lane = tid & 63, wave = tid >> 6;
    const bf16_t* Z = (const bf16_t*)P.out; bf16_t* CQN = (bf16_t*)(P.ws + WS_CQN); bf16_t* CKVN = (bf16_t*)(P.ws + WS_CKVN);
    const float* cs = (const float*)(P.ws + WS_CS); bf16_t* KR = (bf16_t*)(P.ws + WS_KROPE);
    for (int m = blockIdx.x * 8 + wave; m < M; m += G * 8) {
        const bf16_t* zr = Z + (size_t)m * ZC;
        const u32x4 a = *(const u32x4*)(zr + ZO_CQ + 8 * lane); const u32x2 k = *(const u32x2*)(zr + ZO_CKV + 4 * lane);
        float s1 = 0.f, s2 = 0.f;
#pragma unroll
        for (int e = 0; e < 4; ++e) { const float lo = __uint_as_float(a[e] << 16), hi = __uint_as_float(a[e] & 0xffff0000u); s1 += lo * lo + hi * hi; }
#pragma unroll
        for (int e = 0; e < 2; ++e) { const float lo = __uint_as_float(k[e] << 16), hi = __uint_as_float(k[e] & 0xffff0000u); s2 += lo * lo + hi * hi; }
        s1 = wave_sum(s1); s2 = wave_sum(s2);
        const float r1 = rsqrtf(s1 * (1.0f / 512.0f) + RMS_EPS), r2 = rsqrtf(s2 * (1.0f / 256.0f) + RMS_EPS);
        { u32x4 w;
#pragma unroll
          for (int e = 0; e < 4; ++e) w[e] = pk2(__uint_as_float(a[e] << 16) * r1, __uint_as_float(a[e] & 0xffff0000u) * r1);
          *(u32x4*)(CQN + (size_t)m * 512 + 8 * lane) = w;
          u32x2 w2;
#pragma unroll
          for (int e = 0; e < 2; ++e) w2[e] = pk2(__uint_as_float(k[e] << 16) * r2, __uint_as_float(k[e] & 0xffff0000u) * r2);
          *(u32x2*)(CKVN + (size_t)m * 256 + 4 * lane) = w2; }
        if (lane < 32) { const float x1 = bf2f(zr[ZO_KR + lane]), x2 = bf2f(zr[ZO_KR + 32 + lane]); const float c = cs[(size_t)m * 64 + 2 * lane], s = cs[(size_t)m * 64 + 2 * lane + 1];
            KR[(size_t)m * 64 + lane] = f2bf(x1 * c - x2 * s); KR[(size_t)m * 64 + 32 + lane] = f2bf(x2 * c + x1 * s); }
    }
}
__device__ __forceinline__ void p7_rows(const Params& P, LAS unsigned char* lds, int G) {
    const int tid = opaque_tid(), lane = tid & 63, wave = tid >> 6;
    const float* ada = (const float*)(P.ws + WS_ADA);
    LAS float* TA = (LAS float*)lds; LAS float* TB = TA + 2 * DM; LAS float* TC = TB + 2 * DM;
    for (int idx = tid; idx < 2 * DM; idx += NTHREADS) { const int b = idx >> 11, col = idx & (DM - 1); const float* ab = ada + (size_t)b * NADA;
        TA[idx] = ab[2 * DM + col] * P.g_post_mix[col]; TB[idx] = P.g_pre_ffn[col] * (1.0f + ab[4 * DM + col]); TC[idx] = ab[3 * DM + col]; }
    __syncthreads();
    const bf16_t* O = (const bf16_t*)(P.ws + WS_O); bf16_t* XN = (bf16_t*)(P.ws + WS_XN);
    for (int m = blockIdx.x * 8 + wave; m < M; m += G * 8) {
        const int b = m >> 13; const f32x4* xr = (const f32x4*)(P.x + (size_t)m * DM) + lane; const u32x2* orow = (const u32x2*)(O + (size_t)m * DM) + lane;
        f32x4 v[8], xv[8]; float ss = 0.f;
#pragma unroll
        for (int j = 0; j < 8; ++j) xv[j] = __builtin_nontemporal_load(xr + 64 * j);
#pragma unroll
        for (int j = 0; j < 8; ++j) { const u32x2 w = __builtin_nontemporal_load(orow + 64 * j); v[j][0] = __uint_as_float(w.x << 16); v[j][1] = __uint_as_float(w.x & 0xffff0000u); v[j][2] = __uint_as_float(w.y << 16); v[j][3] = __uint_as_float(w.y & 0xffff0000u);
            ss += (v[j][0] * v[j][0] + v[j][1] * v[j][1]) + (v[j][2] * v[j][2] + v[j][3] * v[j][3]); }
        const float rstd = rsqrtf(wave_sum(ss) * (1.0f / DM) + RMS_EPS);
        float s2 = 0.f; u32x2* x1r = (u32x2*)((bf16_t*)(P.ws + WS_X1) + (size_t)m * DM) + lane;
#pragma unroll
        for (int j = 0; j < 8; ++j) { const f32x4 a = *(const LAS f32x4*)(TA + b * DM + 256 * j + 4 * lane); const f32x4 x1 = xv[j] + v[j] * rstd * a; v[j] = x1; { u32x2 w; w.x = pk2(x1[0], x1[1]); w.y = pk2(x1[2], x1[3]); __builtin_nontemporal_store(w, x1r + 64 * j); }
            s2 += (x1[0] * x1[0] + x1[1] * x1[1]) + (x1[2] * x1[2] + x1[3] * x1[3]); }
        const float rstd2 = rsqrtf(wave_sum(s2) * (1.0f / DM) + RMS_EPS);
        u32x2* o = (u32x2*)(XN + (size_t)m * DM) + lane;
#pragma unroll
        for (int j = 0; j < 8; ++j) { const f32x4 a = *(const LAS f32x4*)(TB + b * DM + 256 * j + 4 * lane), c = *(const LAS f32x4*)(TC + b * DM + 256 * j + 4 * lane);
            const f32x4 h = v[j] * rstd2 * a + c; u32x2 w; w.x = pk2(h[0], h[1]); w.y = pk2(h[2], h[3]); o[64 * j] = w; }
    }
}
__device__ __forceinline__ void p10_rows(const Params& P, LAS unsigned char* lds, int G) {
    const int tid = opaque_tid(), lane = tid & 63, wave = tid >> 6;
    const float* ada = (const float*)(P.ws + WS_ADA);
    LAS float* TA = (LAS float*)lds;
    for (int idx = tid; idx < 2 * DM; idx += NTHREADS) { const int b = idx >> 11, col = idx & (DM - 1); TA[idx] = ada[(size_t)b * NADA + 5 * DM + col] * P.g_post_ffn[col]; }
    __syncthreads();
    const bf16_t* F = (const bf16_t*)(P.ws + WS_O);
    for (int m = blockIdx.x * 8 + wave; m < M; m += G * 8) {
        const int b = m >> 13; const u32x2* fr = (const u32x2*)(F + (size_t)m * DM) + lane; f32x4* outr = (f32x4*)(P.out + (size_t)m * DM) + lane; const u32x2* x1r = (const u32x2*)((const bf16_t*)(P.ws + WS_X1) + (size_t)m * DM) + lane;
        f32x4 v[8]; u32x2 xw8[8]; float ss = 0.f;
#pragma unroll
        for (int j = 0; j < 8; ++j) xw8[j] = __builtin_nontemporal_load(x1r + 64 * j);
#pragma unroll
        for (int j = 0; j < 8; ++j) { const u32x2 w = __builtin_nontemporal_load(fr + 64 * j); v[j][0] = __uint_as_float(w.x << 16); v[j][1] = __uint_as_float(w.x & 0xffff0000u); v[j][2] = __uint_as_float(w.y << 16); v[j][3] = __uint_as_float(w.y & 0xffff0000u);
            ss += (v[j][0] * v[j][0] + v[j][1] * v[j][1]) + (v[j][2] * v[j][2] + v[j][3] * v[j][3]); }
        const float rstd = rsqrtf(wave_sum(ss) * (1.0f / DM) + RMS_EPS);
#pragma unroll
        for (int j = 0; j < 8; ++j) { const f32x4 a = *(const LAS f32x4*)(TA + b * DM + 256 * j + 4 * lane); const u32x2 xw = xw8[j]; f32x4 x1; x1[0] = __uint_as_float(xw.x << 16); x1[1] = __uint_as_float(xw.x & 0xffff0000u); x1[2] = __uint_as_float(xw.y << 16); x1[3] = __uint_as_float(xw.y & 0xffff0000u); __builtin_nontemporal_store(x1 + v[j] * rstd * a, outr + 64 * j); }
    }
}
constexpr int G1_AG = 0, G1_SEG = 4096, G1_QD = 8192, G1_KI = G1_QD + 64 * 272, G1_KDT = G1_KI + 64 * 272, G1_VT = G1_KDT + 128 * 144, G1_AT = G1_VT + 256 * 144, G1_END = G1_AT + 64 * 144;
static_assert(G1_END <= 131072, "G1 LDS");
__device__ __forceinline__ void gla_intra_unit(const Params& P, LAS unsigned char* lds, int unit) {
    const int tid = opaque_tid(), lane = tid & 63, wid = tid >> 6, fr = lane & 15, fq = lane >> 4;
    const int bh = unit >> 7, n = unit & 127, b = bh >> 2, h = bh & 3;
    const size_t t0 = (size_t)b * SEQ + 64 * n;
    const bf16_t* Z = (const bf16_t*)P.out;
    LAS float* ag = (LAS float*)(lds + G1_AG); LAS float* seg = (LAS float*)(lds + G1_SEG);
    LAS bf16_t* qd = (LAS bf16_t*)(lds + G1_QD); LAS bf16_t* ki = (LAS bf16_t*)(lds + G1_KI); LAS bf16_t* kdT = (LAS bf16_t*)(lds + G1_KDT);
    LAS bf16_t* vT = (LAS bf16_t*)(lds + G1_VT); LAS bf16_t* at = (LAS bf16_t*)(lds + G1_AT);
    bf16_t* qdec_g = (bf16_t*)(P.ws + WS_QDEC); float* decay_g = (float*)(P.ws + WS_DECAY); bf16_t* OI = (bf16_t*)(P.ws + WS_OI); bf16_t* DS = (bf16_t*)(P.ws + WS_XN);
    const int d_ = tid & 127, cgp_ = tid >> 7;
    float wg_[16];
#pragma unroll
    for (int r = 0; r < 16; ++r) wg_[r] = P.w_gate_up[r * 512 + 128 * h + d_];
    const float bias_ = P.b_gate[128 * h + d_];
    bf16_t qraw_[16], kraw_[16];
#pragma unroll
    for (int i = 0; i < 16; ++i) { const size_t zr = (t0 + cgp_ * 16 + i) * ZC; qraw_[i] = Z[zr + ZO_QG + 128 * h + d_]; kraw_[i] = Z[zr + ZO_KG + 128 * h + d_]; }
    { const int idx = tid * 2, c = idx >> 4, r = idx & 15; const unsigned w = *(const unsigned*)(Z + (t0 + c) * ZC + ZO_AG + r); ag[c * 16 + r] = __uint_as_float(w << 16); ag[c * 16 + r + 1] = __uint_as_float(w & 0xffff0000u); }
#pragma unroll
    for (int i = 0; i < 4; ++i) { const int id = tid + NTHREADS * i, c = id & 63, vc = id >> 6;
        const u32x4 w = *(const u32x4*)(Z + (t0 + c) * ZC + ZO_VG + 256 * h + 8 * vc);
#pragma unroll
        for (int e = 0; e < 4; ++e) { vT[(8 * vc + 2 * e) * 72 + c] = (bf16_t)(w[e] & 0xffffu); vT[(8 * vc + 2 * e + 1) * 72 + c] = (bf16_t)(w[e] >> 16); } }
    __syncthreads();
    { const int d = d_, cgp = cgp_;
      float (&w)[16] = wg_; const float bias = bias_;
      float bcv[16]; float run = 0.f;
#pragma unroll
      for (int i = 0; i < 16; ++i) { const int c = cgp * 16 + i; float xg = bias;
#pragma unroll
          for (int r4 = 0; r4 < 4; ++r4) { const f32x4 a = *(const LAS f32x4*)(ag + c * 16 + 4 * r4); xg += a[0] * w[4 * r4] + a[1] * w[4 * r4 + 1] + a[2] * w[4 * r4 + 2] + a[3] * w[4 * r4 + 3]; }
          const float ls = fminf(xg, 0.f) - __logf(1.0f + __expf(-fabsf(xg)));
          run += ls * (1.0f / 16.0f); bcv[i] = run; }
      seg[cgp * 128 + d] = run;
      __syncthreads();
      float off = 0.f, tot = 0.f;
#pragma unroll
      for (int g2 = 0; g2 < 4; ++g2) { const float sv = seg[g2 * 128 + d]; tot += sv; if (g2 < cgp) off += sv; }
      float kd_prev = 0.f;
#pragma unroll
      for (int i = 0; i < 16; ++i) { const int c = cgp * 16 + i; const float bc = bcv[i] + off;
          const float q = bf2f(qraw_[i]), k = bf2f(kraw_[i]);
          const bf16_t qv = f2bf(q * 0.08838834764831845f * __expf(bc));
          qd[c * 136 + d] = qv; ki[c * 136 + d] = f2bf(k * __expf(-bc));
          const float kdv = k * __expf(tot - bc);
          if (i & 1) *(LAS unsigned*)(kdT + d * 72 + c - 1) = pk2(kd_prev, kdv); else kd_prev = kdv; }
      if (cgp == 0) decay_g[(size_t)unit * 128 + d] = __expf(tot);
    }
    __syncthreads();
#pragma unroll
    for (int i = 0; i < 2; ++i) { const int id = tid + NTHREADS * i, c = id >> 4, ch = id & 15; *(u32x4*)(qdec_g + ((size_t)unit * 64 + c) * 128 + 8 * ch) = *(const LAS u32x4*)(qd + c * 136 + 8 * ch); }
    { const int cb = wid >> 1;
#pragma unroll
      for (int jj = 0; jj < 2; ++jj) { const int jb = (wid & 1) * 2 + jj; f32x4 acc = {0.f, 0.f, 0.f, 0.f};
          if (jb <= cb) {
#pragma unroll
              for (int ks = 0; ks < 4; ++ks) { const bf16x8 a = *(const LAS bf16x8*)(qd + (16 * cb + fr) * 136 + 32 * ks + 8 * fq), bb = *(const LAS bf16x8*)(ki + (16 * jb + fr) * 136 + 32 * ks + 8 * fq); acc = MFMA16(a, bb, acc); } }
#pragma unroll
          for (int e = 0; e < 4; ++e) { const int c = 16 * cb + 4 * fq + e, j = 16 * jb + fr; at[c * 72 + j] = f2bf(j <= c ? acc[e] : 0.f); } }
    }
    __syncthreads();
#pragma unroll
    for (int vbi = 0; vbi < 2; ++vbi) { const int vb = 2 * wid + vbi;
        bf16x8 vf[2];
#pragma unroll
        for (int ks = 0; ks < 2; ++ks) vf[ks] = *(const LAS bf16x8*)(vT + (16 * vb + fr) * 72 + 32 * ks + 8 * fq);
#pragma unroll
        for (int cb = 0; cb < 4; ++cb) { f32x4 acc = {0.f, 0.f, 0.f, 0.f};
#pragma unroll
            for (int ks = 0; ks < 2; ++ks) acc = MFMA16(vf[ks], *(const LAS bf16x8*)(at + (16 * cb + fr) * 72 + 32 * ks + 8 * fq), acc);
            u32x2 w; w.x = pk2(acc[0], acc[1]); w.y = pk2(acc[2], acc[3]);
            *(u32x2*)(OI + (t0 + 16 * cb + fr) * 1024 + 256 * h + 16 * vb + 4 * fq) = w; }
#pragma unroll
        for (int db = 0; db < 8; ++db) { f32x4 acc = {0.f, 0.f, 0.f, 0.f};
#pragma unroll
            for (int ks = 0; ks < 2; ++ks) acc = MFMA16(*(const LAS bf16x8*)(kdT + (16 * db + fr) * 72 + 32 * ks + 8 * fq), vf[ks], acc);
            u32x2 w; w.x = pk2(acc[0], acc[1]); w.y = pk2(acc[2], acc[3]);
            *(u32x2*)(DS + ((size_t)unit * 256 + 16 * vb + fr) * 128 + 16 * db + 4 * fq) = w; }
    }
    __syncthreads();
}
__device__ __forceinline__ void gla_scan(const Params& P, int G) {
    const bf16_t* DS = (const bf16_t*)(P.ws + WS_XN); bf16_t* ST = (bf16_t*)(P.ws + WS_ST); const float* decay_g = (const float*)(P.ws + WS_DECAY);
    if (threadIdx.x < 256) for (int gid = blockIdx.x * 256 + threadIdx.x; gid < 8 * 8192; gid += G * 256) {
        const int bh = gid >> 13, e4 = gid & 8191, d = (4 * e4) & 127;
        f32x4 st = {0.f, 0.f, 0.f, 0.f};
#pragma unroll 16
        for (int n = 0; n < 128; ++n) { const size_t unit = (size_t)bh * 128 + n;
            const u32x2 w = *(const u32x2*)(DS + unit * 32768 + 4 * e4); const f32x4 dd = *(const f32x4*)(decay_g + unit * 128 + d);
            u32x2 o; o.x = pk2(st[0], st[1]); o.y = pk2(st[2], st[3]); *(u32x2*)(ST + unit * 32768 + 4 * e4) = o;
            f32x4 in; in[0] = __uint_as_float(w.x << 16); in[1] = __uint_as_float(w.x & 0xffff0000u); in[2] = __uint_as_float(w.y << 16); in[3] = __uint_as_float(w.y & 0xffff0000u);
            st = dd * st + in; }
    }
}
__device__ __forceinline__ void gla_inter_unit(const Params& P, LAS unsigned char* lds, int unit) {
    const int tid = opaque_tid(), lane = tid & 63, wid = tid >> 6, fr = lane & 15, fq = lane >> 4;
    const int bh = unit >> 7, n = unit & 127, b = bh >> 2, h = bh & 3;
    const size_t t0 = (size_t)b * SEQ + 64 * n;
    const bf16_t* Z = (const bf16_t*)P.out; const bf16_t* qdec_g = (const bf16_t*)(P.ws + WS_QDEC); const bf16_t* OI = (const bf16_t*)(P.ws + WS_OI); const bf16_t* ST = (const bf16_t*)(P.ws + WS_ST);
    bf16_t* AO = (bf16_t*)(P.ws + WS_XN);
    LAS float* red = (LAS float*)lds;
    const int cb = wid & 3, vh = wid >> 2; const size_t trow = t0 + 16 * cb + fr;
    bf16x8 qf[4];
#pragma unroll
    for (int ks = 0; ks < 4; ++ks) qf[ks] = *(const bf16x8*)(qdec_g + ((size_t)unit * 64 + 16 * cb + fr) * 128 + 32 * ks + 8 * fq);
    f32x4 o[8]; float ss = 0.f;
    bf16x8 sf[8][4]; u32x2 oiw[8];
#pragma unroll
    for (int vbi = 0; vbi < 8; ++vbi) { const int vb = vh * 8 + vbi;
#pragma unroll
        for (int ks = 0; ks < 4; ++ks) sf[vbi][ks] = *(const bf16x8*)(ST + ((size_t)unit * 256 + 16 * vb + fr) * 128 + 32 * ks + 8 * fq);
        oiw[vbi] = *(const u32x2*)(OI + trow * 1024 + 256 * h + 16 * vb + 4 * fq); }
#pragma unroll
    for (int vbi = 0; vbi < 8; ++vbi) { f32x4 acc = {0.f, 0.f, 0.f, 0.f};
#pragma unroll
        for (int ks = 0; ks < 4; ++ks) acc = MFMA16(sf[vbi][ks], qf[ks], acc);
        const u32x2 w = oiw[vbi];
        acc[0] += __uint_as_float(w.x << 16); acc[1] += __uint_as_float(w.x & 0xffff0000u); acc[2] += __uint_as_float(w.y << 16); acc[3] += __uint_as_float(w.y & 0xffff0000u);
        o[vbi] = acc; ss += (acc[0] * acc[0] + acc[1] * acc[1]) + (acc[2] * acc[2] + acc[3] * acc[3]); }
    ss = xsum32(xsum16(ss));
    if (fq == 0) red[wid * 16 + fr] = ss;
    __syncthreads();
    const float tot = red[cb * 16 + fr] + red[(cb + 4) * 16 + fr];
    const float rstd = rsqrtf(tot * (1.0f / 256.0f) + RMS_EPS);
#pragma unroll
    for (int vbi = 0; vbi < 8; ++vbi) { const int vcol = 16 * (vh * 8 + vbi) + 4 * fq;
        const f32x4 g = *(const f32x4*)(P.g_gla + vcol); const u32x2 rw = *(const u32x2*)(Z + trow * ZC + ZO_RG + 256 * h + vcol);
        const float r0 = __uint_as_float(rw.x << 16), r1 = __uint_as_float(rw.x & 0xffff0000u), r2 = __uint_as_float(rw.y << 16), r3 = __uint_as_float(rw.y & 0xffff0000u);
        u32x2 w; w.x = pk2(o[vbi][0] * rstd * g[0] * silu_f(r0), o[vbi][1] * rstd * g[1] * silu_f(r1)); w.y = pk2(o[vbi][2] * rstd * g[2] * silu_f(r2), o[vbi][3] * rstd * g[3] * silu_f(r3));
        *(u32x2*)(AO + trow * DM + 1024 + 256 * h + vcol) = w; }
    __syncthreads();
}

constexpr int AT_KB = 64 * 512, AT_VB = 128 * 144, AT_BUF = AT_KB + AT_VB;
constexpr float AT_THR = 8.0f;
__device__ __forceinline__ float xmax16(float m) { const auto r = __builtin_amdgcn_permlane16_swap(__float_as_uint(m), __float_as_uint(m), false, false); return fmaxf(__uint_as_float(r[0]), __uint_as_float(r[1])); }
__device__ __forceinline__ float xmax32(float m) { const auto r = __builtin_amdgcn_permlane32_swap(__float_as_uint(m), __float_as_uint(m), false, false); return fmaxf(__uint_as_float(r[0]), __uint_as_float(r[1])); }
#ifndef AT_SGB
#define AT_SGB 1
#endif
#ifndef AT_QK_AHEAD
#define AT_QK_AHEAD 4
#endif
#ifndef AT_PV_AHEAD
#define AT_PV_AHEAD 4
#endif
#ifndef AT_SCHED
#define AT_SCHED
#endif
__device__ __forceinline__ void attn_unit(const Params& P, LAS unsigned char* lds, int bh, int qb) {
    const int tid = opaque_tid(), lane = tid & 63, wid = __builtin_amdgcn_readfirstlane(tid >> 6), fr = lane & 15, fq = lane >> 4;
    const int b = bh >> 3, h = bh & 7; const size_t rowb = (size_t)b * SEQ; const int q0 = qb * 256 + wid * 32;
    const bf16_t* Q = (const bf16_t*)(P.ws + WS_Q); const bf16_t* KN = (const bf16_t*)(P.ws + WS_KN); const bf16_t* KR = (const bf16_t*)(P.ws + WS_KROPE); const bf16_t* VT = (const bf16_t*)(P.ws + WS_VT);
    bf16_t* AO = (bf16_t*)(P.ws + WS_XN);
    bf16x8 qf[6][2];
#pragma unroll
    for (int qk = 0; qk < 2; ++qk) { const bf16_t* qp = Q + (rowb + q0 + 16 * qk + fr) * QC;
#pragma unroll
        for (int ks = 0; ks < 4; ++ks) qf[ks][qk] = *(const bf16x8*)(qp + 128 * h + 32 * ks + 8 * fq);
        qf[4][qk] = *(const bf16x8*)(qp + 1024 + (h >> 2) * 256 + (h & 3) * 32 + 8 * fq); qf[5][qk] = *(const bf16x8*)(qp + 1024 + (h >> 2) * 256 + 128 + (h & 3) * 32 + 8 * fq); }
    const int NT = (qb + 1) * 4;
    const bf16_t* KNh = KN + rowb * 1024 + 128 * h; const bf16_t* KRb = KR + rowb * 64; const bf16_t* VTh = VT + (size_t)(128 * h) * M + rowb;
    const unsigned char* dsrc[7]; unsigned dstr[7];
#pragma unroll
    for (int j_ = 0; j_ < 7; ++j_) { const int c_ = wid + 8 * j_; const int L_ = 1024 * c_ + 16 * lane; const bf16_t* src_ = KNh; unsigned st_ = 0;
        if (L_ < AT_KB) { const int row_ = L_ >> 9, pp_ = (L_ & 511) >> 4; int pc_ = (pp_ & 16) | ((pp_ & 15) ^ (row_ & 15)); if (pc_ >= 24) pc_ = 0;
            if (pc_ < 16) { src_ = KNh + (size_t)row_ * 1024 + 8 * pc_; st_ = 64u * 1024u * 2u; } else { src_ = KRb + (size_t)row_ * 64 + 8 * (pc_ - 16); st_ = 64u * 64u * 2u; } }
        else if (c_ < 50) { const int L2_ = L_ - AT_KB, dv_ = L2_ / 144, cb_ = L2_ - dv_ * 144; int pc_ = cb_ >> 4; if (pc_ >= 8) pc_ = 0; src_ = VTh + (size_t)dv_ * M + 8 * pc_; st_ = 128u; }
        dsrc[j_] = (const unsigned char*)src_; dstr[j_] = st_; }
#define AT_DMA(t, buf) do { _Pragma("unroll") for (int j_ = 0; j_ < 7; ++j_) { const int c_ = wid + 8 * j_; if (c_ < 50) { \
            __builtin_amdgcn_global_load_lds((const unsigned*)dsrc[j_], (LAS unsigned*)(lds + (buf) * AT_BUF + 1024 * c_), 16, 0, 0); dsrc[j_] += dstr[j_]; } } } while (0)
    int kxo[4];
#pragma unroll
    for (int j = 0; j < 4; ++j) kxo[j] = fr * 512 + (((4 * j + fq) ^ fr) << 4);
    float mrow[2] = {0.f, 0.f}; f32x4 lacc[2] = {(f32x4){0.f, 0.f, 0.f, 0.f}, (f32x4){0.f, 0.f, 0.f, 0.f}};
    const bf16x8 ones = {16256, 16256, 16256, 16256, 16256, 16256, 16256, 16256};
    f32x4 o[8][2];
#pragma unroll
    for (int dvb = 0; dvb < 8; ++dvb) { o[dvb][0] = (f32x4){0.f, 0.f, 0.f, 0.f}; o[dvb][1] = (f32x4){0.f, 0.f, 0.f, 0.f}; }
    AT_DMA(0, 0);
    asm volatile("s_waitcnt vmcnt(0)" ::: "memory"); __syncthreads();
#pragma clang loop unroll(disable)
    for (int t = 0; t < NT; ++t) {
        const int buf = t & 1; const bool more = (t + 1 < NT);
        if (more) AT_DMA(t + 1, buf ^ 1);
        const LAS unsigned char* Kl = lds + buf * AT_BUF; const LAS unsigned char* Vl = Kl + AT_KB;
        const int k0 = 64 * t;
        if (k0 <= q0) {
#define AT_SB __builtin_amdgcn_sched_barrier(0)
#define AT_KLD(dst, ks_) do { _Pragma("unroll") for (int kvb = 0; kvb < 4; ++kvb) dst[kvb] = *(const LAS bf16x8*)(Kl + kxo[(ks_) & 3] + ((ks_) >> 2) * 256 + kvb * (16 * 512)); } while (0)
#define AT_VLD(dst, g_) do { _Pragma("unroll") for (int i_ = 0; i_ < 4; ++i_) { const LAS unsigned char* vp = Vl + (16 * (4 * ((g_) & 1) + i_) + fr) * 144 + (32 * ((g_) >> 1) + 4 * fq) * 2; \
            const u32x2 lo = *(const LAS u32x2*)vp, hi = *(const LAS u32x2*)(vp + 32); u32x4 w; w.x = lo.x; w.y = lo.y; w.z = hi.x; w.w = hi.y; dst[i_] = __builtin_bit_cast(bf16x8, w); } } while (0)
            bf16x8 kc[4], kn[4];
            AT_KLD(kc, 0);
            f32x4 s[4][2];
#pragma unroll
            for (int kvb = 0; kvb < 4; ++kvb) { s[kvb][0] = (f32x4){-mrow[0], -mrow[0], -mrow[0], -mrow[0]}; s[kvb][1] = (f32x4){-mrow[1], -mrow[1], -mrow[1], -mrow[1]}; }
#pragma unroll
            for (int ks = 0; ks < 6; ++ks) {
                if (ks < 5) AT_KLD(kn, ks + 1);
                AT_SB;
#pragma unroll
                for (int kvb = 0; kvb < 4; ++kvb) { s[kvb][0] = MFMA16(kc[kvb], qf[ks][0], s[kvb][0]); s[kvb][1] = MFMA16(kc[kvb], qf[ks][1], s[kvb][1]); }
                AT_SB;
                if (ks < 5) {
#pragma unroll
                    for (int kvb = 0; kvb < 4; ++kvb) kc[kvb] = kn[kvb]; }
            }
            bf16x8 vc[4], vn[4];
            AT_VLD(vc, 0);
            AT_SB;
            if (k0 + 63 > q0) {
#pragma unroll
                for (int kvb = 0; kvb < 4; ++kvb)
#pragma unroll
                    for (int qk = 0; qk < 2; ++qk)
#pragma unroll
                        for (int e = 0; e < 4; ++e) { const int kv = k0 + 16 * kvb + 4 * fq + e, q = q0 + 16 * qk + fr; if (kv > q) s[kvb][qk][e] = -INFINITY; }
            }
            float mx[2];
#pragma unroll
            for (int qk = 0; qk < 2; ++qk) { float m_ = fmaxf(fmaxf(s[0][qk][0], s[0][qk][1]), fmaxf(s[0][qk][2], s[0][qk][3]));
#pragma unroll
                for (int kvb = 1; kvb < 4; ++kvb) m_ = fmaxf(m_, fmaxf(fmaxf(s[kvb][qk][0], s[kvb][qk][1]), fmaxf(s[kvb][qk][2], s[kvb][qk][3])));
                m_ = xmax16(m_); m_ = xmax32(m_); mx[qk] = m_; }
            if (t == 0 || __any((mx[0] > AT_THR) || (mx[1] > AT_THR))) {
#pragma unroll
                for (int qk = 0; qk < 2; ++qk) { const float dl = (t == 0) ? mx[qk] : fmaxf(mx[qk], 0.f), alpha = __builtin_amdgcn_exp2f(-dl); mrow[qk] += dl; lacc[qk] *= alpha;
#pragma unroll
                    for (int kvb = 0; kvb < 4; ++kvb) s[kvb][qk] -= dl;
#pragma unroll
                    for (int dvb = 0; dvb < 8; ++dvb) o[dvb][qk] *= alpha; }
            }
            bf16x8 pf[2][2];
#pragma unroll
            for (int qk = 0; qk < 2; ++qk) {
#pragma unroll
                for (int kvb = 0; kvb < 4; ++kvb)
#pragma unroll
                    for (int e = 0; e < 4; ++e) s[kvb][qk][e] = __builtin_amdgcn_exp2f(s[kvb][qk][e]);
#pragma unroll
                for (int s2 = 0; s2 < 2; ++s2) { u32x4 w; w.x = pk2(s[2 * s2][qk][0], s[2 * s2][qk][1]); w.y = pk2(s[2 * s2][qk][2], s[2 * s2][qk][3]);
                    w.z = pk2(s[2 * s2 + 1][qk][0], s[2 * s2 + 1][qk][1]); w.w = pk2(s[2 * s2 + 1][qk][2], s[2 * s2 + 1][qk][3]); pf[s2][qk] = __builtin_bit_cast(bf16x8, w); } }
            AT_SB;
#pragma unroll
            for (int g = 0; g < 4; ++g) {
                if (g < 3) AT_VLD(vn, g + 1);
                AT_SB;
                if ((g & 1) == 0) { lacc[0] = MFMA16(ones, pf[g >> 1][0], lacc[0]); lacc[1] = MFMA16(ones, pf[g >> 1][1], lacc[1]); }
#pragma unroll
                for (int i = 0; i < 4; ++i) { const int dvb = 4 * (g & 1) + i; o[dvb][0] = MFMA16(vc[i], pf[g >> 1][0], o[dvb][0]); o[dvb][1] = MFMA16(vc[i], pf[g >> 1][1], o[dvb][1]); }
                AT_SB;
                if (g < 3) {
#pragma unroll
                    for (int i = 0; i < 4; ++i) vc[i] = vn[i]; }
            }
#undef AT_SB
#undef AT_KLD
#undef AT_VLD
        }
        asm volatile("s_waitcnt vmcnt(0)" ::: "memory"); __syncthreads();
    }
#pragma unroll
    for (int qk = 0; qk < 2; ++qk) { const float rl = 1.0f / lacc[qk][0];
        bf16_t* op = AO + (rowb + q0 + 16 * qk + fr) * DM + 128 * h + 4 * fq;
#pragma unroll
        for (int dvb = 0; dvb < 8; ++dvb) { u32x2 w; w.x = pk2(o[dvb][qk][0] * rl, o[dvb][qk][1] * rl); w.y = pk2(o[dvb][qk][2] * rl, o[dvb][qk][3] * rl); *(u32x2*)(op + 16 * dvb) = w; } }
#undef AT_DMA
}

#define GAS __attribute__((address_space(1)))
typedef GAS unsigned gu32;
typedef GAS unsigned long long gu64;
#define RLX_AGENT __ATOMIC_RELAXED, __HIP_MEMORY_SCOPE_AGENT
#define LDS_WAIT() asm volatile("s_waitcnt lgkmcnt(0)" ::: "memory")
#define VM_WAIT() asm volatile("s_waitcnt vmcnt(0)" ::: "memory")
__device__ __forceinline__ unsigned long long rt() { return __builtin_amdgcn_s_memrealtime(); }

#define XB_TMO      128
#define XB_XCNT(j)  (256  + 64 * (j))
#define XB_XSUB(j)  (1280 + 64 * (j))
#define XB_XGEN(j)  (2304 + 64 * (j))
#define XB_TOP      3328
#define XB_TOPGEN   3392
#define XCD_BAR_WORDS 3456
#define XB_SPIN_CAP (1u << 18)

__device__ __forceinline__ unsigned xb_ld(unsigned* p)              { return __hip_atomic_load(p, __ATOMIC_RELAXED, __HIP_MEMORY_SCOPE_AGENT); }
__device__ __forceinline__ unsigned xb_add(unsigned* p, unsigned v) { return __hip_atomic_fetch_add(p, v, __ATOMIC_RELAXED, __HIP_MEMORY_SCOPE_AGENT); }
__device__ __forceinline__ unsigned xb_xcc_id() { return (unsigned)__builtin_amdgcn_s_getreg((3 << 11) | 20) & 0xFu; }
#define XB_SPIN(cond, bar) do { unsigned _sp = 0; while (cond) { __builtin_amdgcn_s_sleep(1); \
    if ((++_sp & 255u) == 0u) { if (xb_ld(&(bar)[XB_TMO])) break; if (_sp > XB_SPIN_CAP) { atomicAdd(&(bar)[XB_TMO], 1u); break; } } } } while (0)

struct XcdBarrier {
    unsigned* bar; unsigned x;
    volatile LAS unsigned* st;
};

__device__ __forceinline__ XcdBarrier xcd_barrier_post(unsigned* bar, volatile LAS unsigned* st) {
    XcdBarrier b; b.bar = bar; b.x = xb_xcc_id(); b.st = st;
    if (threadIdx.x == 0) (void)xb_add(&bar[XB_XCNT(b.x)], 1u);
    return b;
}
__device__ __forceinline__ void xcd_barrier_complete(unsigned* bar, unsigned x, unsigned& nloc, unsigned& nx) {
    const unsigned G = gridDim.x * gridDim.y * gridDim.z;
    unsigned sum, cnt, mine, sp = 0u;
    for (;;) {
        sum = 0u; cnt = 0u; mine = 0u;
#pragma unroll
        for (unsigned j = 0; j < 16; ++j) { const unsigned c = xb_ld(&bar[XB_XCNT(j)]); sum += c; cnt += (c > 0u) ? 1u : 0u; mine = (j == x) ? c : mine; }
        if (sum == G) break;
        __builtin_amdgcn_s_sleep(1);
        if ((++sp & 255u) == 0u) { if (xb_ld(&bar[XB_TMO])) break; if (sp > XB_SPIN_CAP) { atomicAdd(&bar[XB_TMO], 1u); break; } }
    }
    nloc = mine > 0u ? mine : 1u; nx = cnt > 0u ? cnt : 1u;
}

__device__ __forceinline__ void xcd_barrier(const XcdBarrier& b) {
    asm volatile("s_waitcnt vmcnt(0)" ::: "memory");
    __syncthreads();
    if (threadIdx.x == 0) {
        unsigned* bar = b.bar;
        __builtin_amdgcn_s_waitcnt(0);
        unsigned nloc = b.st[0], nx = b.st[1];
        if (nloc == 0u) { xcd_barrier_complete(bar, b.x, nloc, nx); b.st[0] = nloc; b.st[1] = nx; }
        const unsigned old = xb_add(&bar[XB_XSUB(b.x)], 1u);
        const unsigned gen = old / nloc;
        if (old + 1u == (gen + 1u) * nloc) {
            __builtin_amdgcn_fence(__ATOMIC_RELEASE, "agent");
            asm volatile("s_waitcnt vmcnt(0)" ::: "memory");
            const unsigned og = xb_add(&bar[XB_TOP], 1u);
            const unsigned tg = og / nx;
            if (og + 1u == (tg + 1u) * nx) xb_add(&bar[XB_TOPGEN], 1u);
            else XB_SPIN(xb_ld(&bar[XB_TOPGEN]) == tg, bar);
            __builtin_amdgcn_fence(__ATOMIC_ACQUIRE, "agent");
            xb_add(&bar[XB_XGEN(b.x)], 1u);
            asm volatile("s_waitcnt vmcnt(0)" ::: "memory");
        } else {
            XB_SPIN(xb_ld(&bar[XB_XGEN(b.x)]) == gen, bar);
            __builtin_amdgcn_fence(__ATOMIC_ACQUIRE, "agent");
            asm volatile("s_waitcnt vmcnt(0)" ::: "memory");
        }
    }
    __syncthreads();
}


#ifndef PHASES
#define PHASES 0xFFFF
#endif
#define PH(k) ((PHASES >> (k)) & 1)
#ifndef REP_ATT
#define REP_ATT 1
#endif
#ifndef REP_P0
#define REP_P0 1
#endif
#ifndef REP_GLA
#define REP_GLA 1
#endif
#ifndef REP_A
#define REP_A 1
#endif
#ifndef REP_B
#define REP_B 1
#endif
#ifndef REP_C
#define REP_C 1
#endif
#ifndef REP_D
#define REP_D 1
#endif
#ifndef P2_SP2
#define P2_SP2 true
#endif
#ifndef P2_ALIGN
#define P2_ALIGN true
#endif
#ifndef P69_ALIGN
#define P69_ALIGN true
#endif
#ifndef P3_ALIGN
#define P3_ALIGN false
#endif
#ifndef P3_SP2
#define P3_SP2 true
#endif
#ifndef REP_P8
#define REP_P8 1
#endif
#ifndef REP_ROWS
#define REP_ROWS 1
#endif
#ifndef REP_SYNC
#define REP_SYNC 1
#endif
__global__ void __launch_bounds__(NTHREADS, 2) hybrid_block_fwd(Params P) {
    extern __shared__ __attribute__((aligned(16))) unsigned char lds_raw[];
    LAS unsigned char* lds = (LAS unsigned char*)lds_raw;
    cg::grid_group grid = cg::this_grid();
    volatile LAS unsigned* MISC = (volatile LAS unsigned*)(lds + MISC_OFF);
    if (threadIdx.x < 32) MISC[threadIdx.x] = 0u;
    __syncthreads();
    XcdBarrier bar = xcd_barrier_post((unsigned*)(P.ws + WS_CTL), MISC + 8);
#define GSYNC() xcd_barrier(bar)
    const int G = gridDim.x, bx = blockIdx.x;
    unsigned char* ws = P.ws;
    bf16_t* Zb = (bf16_t*)P.out;
    if (PH(0)) for (int rep = 0; rep < REP_P0; ++rep) p0_prologue(P, lds, G);
    if (P.out == nullptr) grid.sync();
    GSYNC();
    if (PH(1)) p1_rows(P, lds, G);
#if defined(DUP_A)
    __syncthreads(); p1_rows(P, lds, G);
#endif
    for (int rep = 0; rep < REP_SYNC; ++rep) GSYNC();
    if (PH(2)) { pg8::Gemm g{(const bf16_t*)(ws + WS_XN), (const bf16_t*)(ws + WS_WIN), M, ZC, DM, DM, DM}; pg8::StaticOrder S; S.init(M, ZC, G, bx);
      pg8::EpiPlain E{Zb, ZC}; pg8::gemm_phase<pg8::EpiPlain, pg8::StaticOrder, P2_ALIGN, P2_SP2>(lds, g, S, E); }
#if defined(DUP_P2)
    if (PH(2)) { pg8::Gemm g{(const bf16_t*)(ws + WS_XN), (const bf16_t*)(ws + WS_WIN), M, ZC, DM, DM, DM}; pg8::StaticOrder S; S.init(M, ZC, G, bx);
      pg8::EpiPlain E{Zb, ZC}; pg8::gemm_phase<pg8::EpiPlain, pg8::StaticOrder, P2_ALIGN, P2_SP2>(lds, g, S, E); }
#endif
    GSYNC();
    if (PH(3)) p2b_rows(P, G);
#if defined(DUP_A)
    p2b_rows(P, G);
#endif
    GSYNC();
    if (PH(4)) { pg8::Gemm g{(const bf16_t*)(ws + WS_CQN), (const bf16_t*)(ws + WS_WUQ), M, QC, 512, 512, 512}; pg8::StaticOrder S; S.init(M, QC, G, bx);
      pg8::EpiRowScaleRope E{(bf16_t*)(ws + WS_Q), QC, QSCALE, 4, (const float*)(ws + WS_CS)};
      pg8::gemm_phase<pg8::EpiRowScaleRope, pg8::StaticOrder, P3_ALIGN, P3_SP2>(lds, g, S, E); }
    if (PH(5)) { pg8::Gemm g{(const bf16_t*)(ws + WS_CKVN), (const bf16_t*)(ws + WS_WUK), M, 1024, 256, 256, 256}; pg8::StaticOrder S; S.init(M, 1024, G, bx);
      pg8::EpiPlain E{(bf16_t*)(ws + WS_KN), 1024}; pg8::gemm_phase<pg8::EpiPlain, pg8::StaticOrder, P3_ALIGN, P3_SP2>(lds, g, S, E); }
    if (PH(6)) { pg8::Gemm g{(const bf16_t*)(ws + WS_WUV), (const bf16_t*)(ws + WS_CKVN), 1024, M, 256, 256, 256}; pg8::StaticOrder S; S.init(1024, M, G, bx);
      pg8::EpiPlain E{(bf16_t*)(ws + WS_VT), M}; pg8::gemm_phase<pg8::EpiPlain, pg8::StaticOrder, P3_ALIGN, P3_SP2>(lds, g, S, E); }
#if defined(DUP_P3)
    if (PH(4)) { pg8::Gemm g{(const bf16_t*)(ws + WS_CQN), (const bf16_t*)(ws + WS_WUQ), M, QC, 512, 512, 512}; pg8::StaticOrder S; S.init(M, QC, G, bx);
      pg8::EpiRowScaleRope E{(bf16_t*)(ws + WS_Q), QC, QSCALE, 4, (const float*)(ws + WS_CS)};
      pg8::gemm_phase<pg8::EpiRowScaleRope, pg8::StaticOrder, true, true>(lds, g, S, E); }
    if (PH(5)) { pg8::Gemm g{(const bf16_t*)(ws + WS_CKVN), (const bf16_t*)(ws + WS_WUK), M, 1024, 256, 256, 256}; pg8::StaticOrder S; S.init(M, 1024, G, bx);
      pg8::EpiPlain E{(bf16_t*)(ws + WS_KN), 1024}; pg8::gemm_phase<pg8::EpiPlain, pg8::StaticOrder, true, true>(lds, g, S, E); }
    if (PH(6)) { pg8::Gemm g{(const bf16_t*)(ws + WS_WUV), (const bf16_t*)(ws + WS_CKVN), 1024, M, 256, 256, 256}; pg8::StaticOrder S; S.init(1024, M, G, bx);
      pg8::EpiPlain E{(bf16_t*)(ws + WS_VT), M}; pg8::gemm_phase<pg8::EpiPlain, pg8::StaticOrder, true, true>(lds, g, S, E); }
#endif
    if (PH(7)) for (int rep = 0; rep < REP_GLA; ++rep) for (int u = bx; u < 1024; u += G) gla_intra_unit(P, lds, u);
    GSYNC();
    if (PH(8)) for (int rep = 0; rep < REP_B; ++rep) gla_scan(P, G);
    GSYNC();
    if (PH(9)) for (int u = bx; u < 1024; u += G) gla_inter_unit(P, lds, u);
#if defined(DUP_C)
    for (int u = bx; u < 1024; u += G) gla_inter_unit(P, lds, u);
#endif
    if (PH(10)) { const int vcu = (G % 8 == 0) ? (bx % 8) * (G / 8) + bx / 8 : bx;
      for (int rep = 0; rep < REP_ATT; ++rep) for (int p2 = 2 * vcu; p2 < 512; p2 += 2 * G) {
#pragma clang loop unroll(disable)
          for (int i2 = 0; i2 < 2; ++i2) { const int p = p2 >> 1, bh = p >> 4, s = p & 15; attn_unit(P, lds, bh, i2 ? s : 31 - s); } } }
    GSYNC();
    if (PH(11)) { pg8::Gemm g{(const bf16_t*)(ws + WS_XN), (const bf16_t*)(ws + WS_WOUT), M, DM, DM, DM, DM}; pg8::StaticOrder S; S.init(M, DM, G, bx);
      pg8::EpiPlain E{(bf16_t*)(ws + WS_O), DM}; pg8::gemm_phase<pg8::EpiPlain, pg8::StaticOrder, P69_ALIGN, true>(lds, g, S, E); }
#if defined(DUP_P6)
    if (PH(11)) { pg8::Gemm g{(const bf16_t*)(ws + WS_XN), (const bf16_t*)(ws + WS_WOUT), M, DM, DM, DM, DM}; pg8::StaticOrder S; S.init(M, DM, G, bx);
      pg8::EpiPlain E{(bf16_t*)(ws + WS_O), DM}; pg8::gemm_phase<pg8::EpiPlain, pg8::StaticOrder, P69_ALIGN, true>(lds, g, S, E); }
#endif
    GSYNC();
    if (PH(12)) for (int rep = 0; rep < REP_D; ++rep) { p7_rows(P, lds, G); __syncthreads(); }
    GSYNC();
    if (PH(13)) { pg8::Gemm g{(const bf16_t*)(ws + WS_XN), (const bf16_t*)(ws + WS_WGU), M, 2 * DFF, DM, DM, DM}; pg8::StaticOrder S; S.init(M, 2 * DFF, G, bx);
      pg8::EpiSwiGLU E{(bf16_t*)(ws + WS_ACT), DFF}; pg8::gemm_phase<pg8::EpiSwiGLU, pg8::StaticOrder, true, true>(lds, g, S, E); }
#if defined(DUP_P8)
    if (PH(13)) { pg8::Gemm g{(const bf16_t*)(ws + WS_XN), (const bf16_t*)(ws + WS_WGU), M, 2 * DFF, DM, DM, DM}; pg8::StaticOrder S; S.init(M, 2 * DFF, G, bx);
      pg8::EpiSwiGLU E{(bf16_t*)(ws + WS_ACT), DFF}; pg8::gemm_phase<pg8::EpiSwiGLU, pg8::StaticOrder, true, true>(lds, g, S, E); }
#endif
    GSYNC();
    if (PH(14)) { pg8::Gemm g{(const bf16_t*)(ws + WS_ACT), (const bf16_t*)(ws + WS_WD), M, DM, DFF, DFF, DFF}; pg8::StaticOrder S; S.init(M, DM, G, bx);
      pg8::EpiPlain E{(bf16_t*)(ws + WS_O), DM}; pg8::gemm_phase<pg8::EpiPlain, pg8::StaticOrder, P69_ALIGN, true>(lds, g, S, E); }
#if defined(DUP_P9)
    if (PH(14)) { pg8::Gemm g{(const bf16_t*)(ws + WS_ACT), (const bf16_t*)(ws + WS_WD), M, DM, DFF, DFF, DFF}; pg8::StaticOrder S; S.init(M, DM, G, bx);
      pg8::EpiPlain E{(bf16_t*)(ws + WS_O), DM}; pg8::gemm_phase<pg8::EpiPlain, pg8::StaticOrder, P69_ALIGN, true>(lds, g, S, E); }
#endif
    GSYNC();
    if (PH(15)) for (int rep = 0; rep < REP_D; ++rep) { p10_rows(P, lds, G); __syncthreads(); }
}

extern "C" void kernel_launch(void* const* d_in, const int* in_sizes, int n_in, void* d_out, int out_size, void* d_ws, size_t ws_size, hipStream_t stream) {
    static int grid = 0;
    if (grid == 0) {
        if (n_in != 22 || in_sizes[0] != M * DM || out_size != M * DM || ws_size < WS_END) { fprintf(stderr, "kernel_launch: unexpected shapes (n_in %d, in0 %d, out %d, ws %zu)\n", n_in, n_in > 0 ? in_sizes[0] : -1, out_size, ws_size); grid = -1; return; }
        int dev = 0, cus = 0, per_cu = 0;
        (void)hipGetDevice(&dev); (void)hipDeviceGetAttribute(&cus, hipDeviceAttributeMultiprocessorCount, dev);
        if (hipFuncSetAttribute((const void*)hybrid_block_fwd, hipFuncAttributeMaxDynamicSharedMemorySize, LDS_BYTES) != hipSuccess) { fprintf(stderr, "kernel_launch: hipFuncSetAttribute failed\n"); grid = -1; return; }
        if (hipOccupancyMaxActiveBlocksPerMultiprocessor(&per_cu, (const void*)hybrid_block_fwd, NTHREADS, LDS_BYTES) != hipSuccess || per_cu < 1) { fprintf(stderr, "kernel_launch: occupancy query failed (%d)\n", per_cu); (void)hipGetLastError(); grid = -1; return; }
        grid = cus;
    }
    if (grid < 0) return;
    Params p{};
    const float* const* fin = (const float* const*)d_in;
    p.x = fin[0]; p.c = fin[1]; p.pos = (const int*)d_in[2]; p.w_ada = fin[3]; p.b_ada = fin[4]; p.g_pre_mix = fin[5]; p.g_post_mix = fin[6]; p.w_in = fin[7]; p.g_q = fin[8]; p.w_uq = fin[9];
    p.g_kv = fin[10]; p.w_uk = fin[11]; p.w_uv = fin[12]; p.w_gate_up = fin[13]; p.b_gate = fin[14]; p.g_gla = fin[15]; p.w_out = fin[16]; p.g_pre_ffn = fin[17]; p.g_post_ffn = fin[18];
    p.w_fg = fin[19]; p.w_fu = fin[20]; p.w_fd = fin[21]; p.out = (float*)d_out; p.ws = (unsigned char*)d_ws;
    if (hipMemsetAsync((char*)d_ws + WS_CTL, 0, CTL_BYTES, stream) != hipSuccess) { fprintf(stderr, "kernel_launch: memset failed\n"); return; }
    void* args[] = {&p};
    hipError_t e = hipLaunchCooperativeKernel((const void*)hybrid_block_fwd, dim3(grid), dim3(NTHREADS), args, LDS_BYTES, stream);
    if (e != hipSuccess) fprintf(stderr, "cooperative launch failed: %s (grid %d)\n", hipGetErrorString(e), grid);
}
```
